# Optimizing an MI355X kernel written in HIP

```python
import jax, jax.numpy as jnp
from jax import lax
import numpy as np

D_MODEL = 1024
BATCH = 8
SEQ = 4096
DEPTH = 2
DEC_BATCH = 1
DEC_SEQ = 16384
PAST_LEN = 128

EPS = 1e-6
N_BRANCH = 4
BRANCH_WIDTH = 256
A_WIDTH = BRANCH_WIDTH
A_GROUPS = 4
CONV_WIDTH = 3
POOL_WIDTH = BRANCH_WIDTH
POOL_WINDOWS = (2, 4, 8, 16)
POOL_GROUPS = len(POOL_WINDOWS)
POOL_GDIM = POOL_WIDTH // POOL_GROUPS
SG_WIDTH = BRANCH_WIDTH
SG_GROUPS = 4
SG_GDIM = SG_WIDTH // SG_GROUPS
CHUNK = 128
N_Q_HEADS = 4
N_KV_HEADS = 2
GQA_GROUP = N_Q_HEADS // N_KV_HEADS
HEAD_DIM = 64
Q_DIM = N_Q_HEADS * HEAD_DIM
KV_DIM = N_KV_HEADS * HEAD_DIM
WINDOW = 128
ATTN_BLOCK = 128
NEG_BIG = -1e30
IN_A = 3 * A_WIDTH
IN_POOL = POOL_WIDTH
IN_SG = 2 * SG_WIDTH
IN_ATTN = Q_DIM + 2 * KV_DIM
D_IN = IN_A + IN_POOL + IN_SG + IN_ATTN
D_FF = ((8 * D_MODEL + 3 * 256 - 1) // (3 * 256)) * 256

kernel_name = "hybrid_gated_parallel_encoder"


def rms_norm(x, gain):
    xf = x.astype(jnp.float32)
    y = xf * lax.rsqrt(jnp.mean(xf * xf, axis=-1, keepdims=True) + EPS)
    return (y * gain.astype(jnp.float32)).astype(x.dtype)


def layer_norm(x, gain):
    xf = x.astype(jnp.float32)
    mu = jnp.mean(xf, axis=-1, keepdims=True)
    xc = xf - mu
    y = xc * lax.rsqrt(jnp.mean(xc * xc, axis=-1, keepdims=True) + EPS)
    return (y * gain.astype(jnp.float32)).astype(x.dtype)


def alibi_slopes():
    return jnp.exp2(-8.0 * (jnp.arange(N_Q_HEADS, dtype=jnp.float32) + 1.0) / N_Q_HEADS)


def short_conv_mixer(z, conv_w):
    b_gate, c_gate, xin = jnp.split(z, 3, axis=-1)
    u = c_gate * xin
    s = u.shape[1]
    up = jnp.pad(u, ((0, 0), (1, 1), (0, 0)))
    conv = conv_w[0] * up[:, :s] + conv_w[1] * up[:, 1:s + 1] + conv_w[2] * up[:, 2:]
    return b_gate * conv


def pool_mixer(z, pool_w, pool_scale):
    b, s, _ = z.shape
    zf = z.astype(jnp.float32)
    cs = jnp.concatenate([jnp.zeros((b, 1, POOL_WIDTH), jnp.float32), jnp.cumsum(zf, axis=1)], axis=1)
    pos = jnp.arange(s)
    outs = []
    for g, w in enumerate(POOL_WINDOWS):
        lo = jnp.clip(pos - w // 2, 0, s)
        hi = jnp.clip(pos + w // 2, 0, s)
        csg = cs[..., g * POOL_GDIM:(g + 1) * POOL_GDIM]
        total = jnp.take(csg, hi, axis=1) - jnp.take(csg, lo, axis=1)
        cnt = (hi - lo).astype(jnp.float32)[None, :, None]
        outs.append(total / cnt)
    pooled = (jnp.concatenate(outs, axis=-1) - zf).astype(z.dtype).reshape(b, s, POOL_GROUPS, POOL_GDIM)
    mixed = jnp.einsum('bsgc,gcd->bsgd', pooled, pool_w).reshape(b, s, POOL_WIDTH)
    return mixed * pool_scale


def spatial_gating_mixer(z, sg_norm, sg_w, sg_b):
    b, s, _ = z.shape
    u, v = jnp.split(z, 2, axis=-1)
    v = layer_norm(v, sg_norm).reshape(b, s // CHUNK, CHUNK, SG_GROUPS, SG_GDIM)
    mixed = jnp.einsum('gts,bnsgc->bntgc', sg_w, v) + jnp.transpose(sg_b)[None, None, :, :, None]
    return u * mixed.reshape(b, s, SG_WIDTH)


def windowed_gqa(z, sink):
    b, s, _ = z.shape
    q, k, v = jnp.split(z, [Q_DIM, Q_DIM + KV_DIM], axis=-1)
    nb = s // ATTN_BLOCK
    q = q.reshape(b, nb, ATTN_BLOCK, N_KV_HEADS, GQA_GROUP, HEAD_DIM)

    def band(t):
        tp = jnp.pad(t, ((0, 0), (ATTN_BLOCK, ATTN_BLOCK), (0, 0)))
        tp = tp.reshape(b, nb + 2, ATTN_BLOCK, N_KV_HEADS, HEAD_DIM)
        return jnp.concatenate([tp[:, :-2], tp[:, 1:-1], tp[:, 2:]], axis=2)

    kb, vb = band(k), band(v)
    scores = jnp.einsum('bnqkgd,bnskd->bnkgqs', q, kb).astype(jnp.float32) * (HEAD_DIM ** -0.5)
    qi = jnp.arange(ATTN_BLOCK)[:, None]
    kj = jnp.arange(3 * ATTN_BLOCK)[None, :]
    rel = qi - kj + ATTN_BLOCK
    key_pos = jnp.arange(nb)[:, None] * ATTN_BLOCK - ATTN_BLOCK + kj
    valid = (jnp.abs(rel) <= WINDOW)[None] & ((key_pos >= 0) & (key_pos < s))[:, None, :]
    slopes = alibi_slopes().reshape(N_KV_HEADS, GQA_GROUP)
    alibi = -slopes[:, :, None, None] * jnp.abs(rel).astype(jnp.float32)[None, None]
    scores = jnp.where(valid[None, :, None, None], scores + alibi[None, None], NEG_BIG)
    sink_l = sink.astype(jnp.float32).reshape(N_KV_HEADS, GQA_GROUP)[None, None, :, :, None, None]
    m = jnp.maximum(jnp.max(scores, axis=-1, keepdims=True), sink_l)
    p = jnp.exp(scores - m)
    denom = jnp.sum(p, axis=-1, keepdims=True) + jnp.exp(sink_l - m)
    probs = (p / denom).astype(vb.dtype)
    out = jnp.einsum('bnkgqs,bnskd->bnqkgd', probs, vb)
    return out.reshape(b, s, Q_DIM)


def trunk(x, norm_mix_pre, norm_mix_post, norm_ffn_pre, norm_ffn_post, w_in, conv_w,
          pool_w, pool_scale, sg_norm, sg_w, sg_b, attn_sink, w_branch, w_gate, b_gate,
          w_out, w_ffn_in, w_ffn_out):
    for l in range(DEPTH):
        h = rms_norm(x, norm_mix_pre[l])
        z = h @ w_in[l]
        z_a, z_p, z_s, z_d = jnp.split(z, [IN_A, IN_A + IN_POOL, IN_A + IN_POOL + IN_SG], axis=-1)
        branches = (
            short_conv_mixer(z_a, conv_w[l]),
            pool_mixer(z_p, pool_w[l], pool_scale[l]),
            spatial_gating_mixer(z_s, sg_norm[l], sg_w[l], sg_b[l]),
            windowed_gqa(z_d, attn_sink[l]),
        )
        merged = None
        for i, br in enumerate(branches):
            gate = jax.nn.sigmoid(h @ w_gate[l, i] + b_gate[l, i])
            term = gate * (br @ w_branch[l, i])
            merged = term if merged is None else merged + term
        x = x + rms_norm(merged @ w_out[l], norm_mix_post[l])
        h = rms_norm(x, norm_ffn_pre[l])
        a, g = jnp.split(h @ w_ffn_in[l], 2, axis=-1)
        x = x + rms_norm((jax.nn.silu(a) * g) @ w_ffn_out[l], norm_ffn_post[l])
    return x


def setup_inputs(seed: int = 0) -> dict:
    key = jax.random.key(seed)
    ks = jax.random.split(key, 24)
    f32 = jnp.float32

    def nrm(k, shape, scale):
        return jax.random.normal(k, shape, f32) * scale

    def gain(k, shape):
        return 1.0 + 0.1 * jax.random.normal(k, shape, f32)

    return {
        "x_prompt": nrm(ks[0], (BATCH, SEQ, D_MODEL), 1.0),
        "x_sample": nrm(ks[1], (DEC_BATCH, DEC_SEQ, D_MODEL), 1.0),
        "norm_mix_pre": gain(ks[2], (DEPTH, D_MODEL)),
        "norm_mix_post": gain(ks[3], (DEPTH, D_MODEL)),
        "norm_ffn_pre": gain(ks[4], (DEPTH, D_MODEL)),
        "norm_ffn_post": gain(ks[5], (DEPTH, D_MODEL)),
        "w_in": nrm(ks[6], (DEPTH, D_MODEL, D_IN), D_MODEL ** -0.5),
        "conv_w": nrm(ks[7], (DEPTH, CONV_WIDTH, A_WIDTH), CONV_WIDTH ** -0.5),
        "pool_w": nrm(ks[8], (DEPTH, POOL_GROUPS, POOL_GDIM, POOL_GDIM), POOL_GDIM ** -0.5),
        "pool_scale": gain(ks[9], (DEPTH, POOL_WIDTH)),
        "sg_norm": gain(ks[10], (DEPTH, SG_WIDTH)),
        "sg_w": nrm(ks[11], (DEPTH, SG_GROUPS, CHUNK, CHUNK), CHUNK ** -0.5),
        "sg_b": gain(ks[12], (DEPTH, SG_GROUPS, CHUNK)),
        "attn_sink": nrm(ks[13], (DEPTH, N_Q_HEADS), 1.0),
        "w_branch": nrm(ks[14], (DEPTH, N_BRANCH, BRANCH_WIDTH, D_MODEL), BRANCH_WIDTH ** -0.5),
        "w_gate": nrm(ks[15], (DEPTH, N_BRANCH, D_MODEL, D_MODEL), D_MODEL ** -0.5),
        "b_gate": nrm(ks[16], (DEPTH, N_BRANCH, D_MODEL), 0.1),
        "w_out": nrm(ks[17], (DEPTH, D_MODEL, D_MODEL), D_MODEL ** -0.5),
        "w_ffn_in": nrm(ks[18], (DEPTH, D_MODEL, 2 * D_FF), D_MODEL ** -0.5),
        "w_ffn_out": nrm(ks[19], (DEPTH, D_FF, D_MODEL), D_FF ** -0.5),
    }


def reference(x_prompt, x_sample, norm_mix_pre, norm_mix_post, norm_ffn_pre, norm_ffn_post,
              w_in, conv_w, pool_w, pool_scale, sg_norm, sg_w, sg_b, attn_sink, w_branch,
              w_gate, b_gate, w_out, w_ffn_in, w_ffn_out):
    y_prompt = trunk(x_prompt, norm_mix_pre, norm_mix_post, norm_ffn_pre, norm_ffn_post, w_in, conv_w,
                     pool_w, pool_scale, sg_norm, sg_w, sg_b, attn_sink, w_branch, w_gate, b_gate,
                     w_out, w_ffn_in, w_ffn_out)
    y_sample = trunk(x_sample, norm_mix_pre, norm_mix_post, norm_ffn_pre, norm_ffn_post, w_in, conv_w,
                     pool_w, pool_scale, sg_norm, sg_w, sg_b, attn_sink, w_branch, w_gate, b_gate,
                     w_out, w_ffn_in, w_ffn_out)
    return (y_prompt, y_sample)
```

```cpp
#include <hip/hip_runtime.h>
#include <hip/hip_cooperative_groups.h>
#include <cstdio>
#include <cstdint>
namespace cg = cooperative_groups;

#ifndef MK_LAUNCH_PER_PHASE
#define MK_LAUNCH_PER_PHASE 0
#endif

#define LAS __attribute__((address_space(3)))
typedef unsigned short bf16_t;
typedef short bf16x8 __attribute__((ext_vector_type(8)));
typedef short s16x4 __attribute__((ext_vector_type(4)));
typedef float f32x4 __attribute__((ext_vector_type(4)));
typedef unsigned u32x4 __attribute__((ext_vector_type(4)));
typedef unsigned u32x2 __attribute__((ext_vector_type(2)));

constexpr int M_TOK = 49152, M_PROMPT = 32768, DM = 1024, DIN = 2048, DFF = 2816, NFI = 5632, DEPTH = 2;
constexpr int NWAVES = 8, NTHR = 512;
constexpr float EPS = 1e-6f;
constexpr float LOG2E = 1.4426950408889634f;

constexpr size_t MiB = 1u << 20;
constexpr size_t W_IN = 0, W_G = 4 * MiB, W_B = 12 * MiB, W_OUT = 14 * MiB, W_FI = 16 * MiB, W_FO = 27 * MiB, W_SG = 32 * MiB + 512 * 1024, W_PW = W_SG + 128 * 1024, W_LAYER = 33 * MiB;
constexpr size_t WS_W = 0, WS_H = 66 * MiB, WS_Z = 162 * MiB, WS_BR = 354 * MiB, WS_END = 450 * MiB;
constexpr size_t WS_MERGED = WS_Z, WS_SCR = WS_Z + 96 * MiB, WS_Y = WS_Z + 96 * MiB, WS_ACT = WS_Z;
constexpr size_t SCR_PER_CU = 384 * 1024;

typedef float f32x2_t __attribute__((ext_vector_type(2))); typedef __bf16 bf16x2_t __attribute__((ext_vector_type(2)));
__device__ __forceinline__ unsigned cvt_pk_bf16(float lo, float hi) { f32x2_t v = {lo, hi}; bf16x2_t b = __builtin_convertvector(v, bf16x2_t); return __builtin_bit_cast(unsigned, b); }
__device__ __forceinline__ float bflo(unsigned w) { return __uint_as_float(w << 16); }
__device__ __forceinline__ float bfhi(unsigned w) { return __uint_as_float(w & 0xffff0000u); }
__device__ __forceinline__ float wave_sum(float v) {
#pragma unroll
    for (int o = 1; o < 64; o <<= 1) v += __shfl_xor(v, o);
    return v;
}
__device__ __forceinline__ float sigmoidf_(float x) { return __builtin_amdgcn_rcpf(1.0f + __builtin_amdgcn_exp2f(-x * LOG2E)); }
__device__ __forceinline__ void seq_bounds(int row, int& s0, int& s1) { if (row < M_PROMPT) { s0 = row & ~4095; s1 = s0 + 4096; } else { s0 = M_PROMPT; s1 = M_TOK; } }
__device__ __forceinline__ s16x4 tr_read(const LAS unsigned char* p) { return __builtin_bit_cast(s16x4, __builtin_amdgcn_ds_read_tr16_b64_v4i16((LAS s16x4*)p)); }

namespace gm {
constexpr int BM = 256, BK = 64, HALF = 128, HTB = HALF * BK * 2, STAGE_BYTES = 8 * HTB, NXCD = 8, WGM = 8;
__host__ __device__ __forceinline__ int lds_byte(int r, int c) { const int st = (r >> 4) * 2 + (c >> 5), rr = r & 15, cc = c & 31, ob = rr * 64 + cc * 2; return st * 1024 + (ob ^ (((ob >> 9) & 1) << 5)); }
__host__ __device__ __forceinline__ void stage_rc(int b, int& R, int& C) { const int st = b / 1024, sb = b % 1024, swz = sb ^ (((sb >> 9) & 1) << 5); R = (st >> 1) * 16 + swz / 64; C = (st & 1) * 32 + (swz % 64) / 2; }
__host__ __device__ __forceinline__ int perm32(int rho) { const int n = rho >> 4, i = rho & 15; return 8 * (i >> 2) + 4 * n + (i & 3); }

struct Unit { const char* A; const char* B; int nt, pm, pn, tag; };

__device__ __forceinline__ void tile_of(int L, int nM, int nN, int& pm, int& pn) {
    const int nwg = nM * nN; int wgid = L;
    { const int q = nwg / NXCD, r = nwg % NXCD, xcd = wgid % NXCD, off = wgid / NXCD; wgid = (xcd < r ? xcd * (q + 1) : r * (q + 1) + (xcd - r) * q) + off; }
    const int nig = WGM * nN, gid = wgid / nig, fm = gid * WGM, gsz = (nM - fm) < WGM ? (nM - fm) : WGM;
    pm = fm + ((wgid % nig) % gsz); pn = (wgid % nig) / gsz;
}
struct SchedPlain {
    const bf16_t* A; const bf16_t* B; int pitch, nM, nN, nt, G, c;
    __device__ __forceinline__ bool next(int i, Unit& u) const {
        const int L = i * G + c; if (L >= nM * nN) return false;
        tile_of(L, nM, nN, u.pm, u.pn);
        u.A = (const char*)(A + (size_t)u.pm * BM * pitch); u.B = (const char*)(B + (size_t)u.pn * BM * pitch); u.nt = nt; u.tag = 0; return true;
    }
};
struct SchedGate {
    const bf16_t* H; const bf16_t* BR; const bf16_t* WG; const bf16_t* WB; int nM, nN, G, c;
    __device__ __forceinline__ bool next(int i, Unit& u) const {
        const int ti = i >> 3, sub = i & 7; const int L = ti * G + c; if (L >= nM * nN) return false;
        tile_of(L, nM, nN, u.pm, u.pn);
        const int b = sub >> 1; u.tag = sub;
        if ((sub & 1) == 0) { u.A = (const char*)(H + (size_t)u.pm * BM * DM); u.B = (const char*)(WG + (size_t)b * DM * DM + (size_t)u.pn * BM * DM); u.nt = 16; }
        else { u.A = (const char*)(BR + (size_t)u.pm * BM * DM + 256 * b); u.B = (const char*)(WB + (size_t)u.pn * BM * DM + 256 * b); u.nt = 4; }
        return true;
    }
};

struct EpiStoreBf16 {
    bf16_t* O; int ldc;
    __device__ __forceinline__ void operator()(const f32x4 (&acc)[2][2][4][2], const Unit& u, int wr, int wc, int fr, int fq) const {
        const int row0 = u.pm * BM + wr * 64 + fr, col0 = u.pn * BM + wc * 32 + 8 * fq;
#pragma unroll
        for (int ai = 0; ai < 2; ++ai)
#pragma unroll
            for (int m = 0; m < 4; ++m) { bf16_t* rowp = O + (size_t)(row0 + ai * HALF + m * 16) * ldc + col0;
#pragma unroll
                for (int bj = 0; bj < 2; ++bj) { const f32x4 v0 = acc[ai][bj][m][0], v1 = acc[ai][bj][m][1];
                    u32x4 w; w.x = cvt_pk_bf16(v0[0], v0[1]); w.y = cvt_pk_bf16(v0[2], v0[3]); w.z = cvt_pk_bf16(v1[0], v1[1]); w.w = cvt_pk_bf16(v1[2], v1[3]);
                    *(u32x4*)(rowp + bj * HALF) = w; } }
    }
};
struct EpiSwiGLU {
    bf16_t* O;
    __device__ __forceinline__ void operator()(const f32x4 (&acc)[2][2][4][2], const Unit& u, int wr, int wc, int fr, int fq) const {
        const int row0 = u.pm * BM + wr * 64 + fr, col0 = u.pn * 128 + wc * 16 + 4 * fq;
#pragma unroll
        for (int ai = 0; ai < 2; ++ai)
#pragma unroll
            for (int m = 0; m < 4; ++m) { bf16_t* rowp = O + (size_t)(row0 + ai * HALF + m * 16) * DFF + col0;
#pragma unroll
                for (int bj = 0; bj < 2; ++bj) { const f32x4 a = acc[ai][bj][m][0], g = acc[ai][bj][m][1]; f32x4 o;
#pragma unroll
                    for (int e = 0; e < 4; ++e) o[e] = a[e] * sigmoidf_(a[e]) * g[e];
                    u32x2 w; w.x = cvt_pk_bf16(o[0], o[1]); w.y = cvt_pk_bf16(o[2], o[3]);
                    *(u32x2*)(rowp + bj * 64) = w; } }
    }
};
struct EpiGate {
    const float* bgate; bf16_t* O; unsigned char* gsc; unsigned char* msc;
    __device__ __forceinline__ void operator()(const f32x4 (&acc)[2][2][4][2], const Unit& u, int wr, int wc, int fr, int fq) const {
        const int tid = threadIdx.x; const int b = u.tag >> 1, kind = u.tag & 1;
        const int row0 = u.pm * BM + wr * 64 + fr, col0 = u.pn * BM + wc * 32 + 8 * fq;
        unsigned char* gp = gsc + tid * 32; unsigned char* mp = msc + tid * 64;
        if (kind == 0) {
            f32x4 bv[2][2];
#pragma unroll
            for (int bj = 0; bj < 2; ++bj)
#pragma unroll
                for (int n = 0; n < 2; ++n) bv[bj][n] = *(const f32x4*)(bgate + b * DM + col0 + bj * HALF + 4 * n);
#pragma unroll
            for (int ai = 0; ai < 2; ++ai)
#pragma unroll
                for (int m = 0; m < 4; ++m) {
                    asm volatile("" : "+v"(gp));
#pragma unroll
                    for (int bj = 0; bj < 2; ++bj) { const f32x4 v0 = acc[ai][bj][m][0] + bv[bj][0], v1 = acc[ai][bj][m][1] + bv[bj][1];
                        u32x4 w; w.x = cvt_pk_bf16(sigmoidf_(v0[0]), sigmoidf_(v0[1])); w.y = cvt_pk_bf16(sigmoidf_(v0[2]), sigmoidf_(v0[3]));
                        w.z = cvt_pk_bf16(sigmoidf_(v1[0]), sigmoidf_(v1[1])); w.w = cvt_pk_bf16(sigmoidf_(v1[2]), sigmoidf_(v1[3]));
                        *(u32x4*)(gp + bj * 16) = w; }
                    gp += 16384; }
        } else {
#pragma unroll
            for (int ai = 0; ai < 2; ++ai)
#pragma unroll
                for (int m = 0; m < 4; ++m) { bf16_t* rowp = O + (size_t)(row0 + ai * HALF + m * 16) * DM + col0;
                    asm volatile("" : "+v"(gp), "+v"(mp));
#pragma unroll
                    for (int bj = 0; bj < 2; ++bj) { const u32x4 gw = *(const u32x4*)(gp + bj * 16);
                        const f32x4 g0 = (f32x4){bflo(gw.x), bfhi(gw.x), bflo(gw.y), bfhi(gw.y)}, g1 = (f32x4){bflo(gw.z), bfhi(gw.z), bflo(gw.w), bfhi(gw.w)};
                        f32x4 t0 = g0 * acc[ai][bj][m][0], t1 = g1 * acc[ai][bj][m][1];
                        if (b != 0) { t0 += *(const f32x4*)(mp + bj * 32); t1 += *(const f32x4*)(mp + bj * 32 + 16); }
                        if (b != 3) { *(f32x4*)(mp + bj * 32) = t0; *(f32x4*)(mp + bj * 32 + 16) = t1; }
                        else { u32x4 w; w.x = cvt_pk_bf16(t0[0], t0[1]); w.y = cvt_pk_bf16(t0[2], t0[3]); w.z = cvt_pk_bf16(t1[0], t1[1]); w.w = cvt_pk_bf16(t1[2], t1[3]);
                            *(u32x4*)(rowp + bj * HALF) = w; } }
                    gp += 16384; mp += 32768; }
        }
    }
};

template <bool PERM, class Sched, class Epi>
__device__ __forceinline__ void gemm_phase(LAS unsigned char* lds, const int K, const Sched& S, const Epi& E) {
    int tid_ = threadIdx.x; asm volatile("" : "+v"(tid_));
    const int tid = tid_, wid = __builtin_amdgcn_readfirstlane(tid >> 6), lane = tid & 63, wr = wid >> 2, wc = wid & 3, fr = lane & 15, fq = lane >> 4;
    unsigned voffA[2], voffB[2];
#pragma unroll
    for (int i = 0; i < 2; ++i) { int R, C; stage_rc(tid * 16 + i * 8192, R, C); const int Rb = PERM ? ((R & ~31) + perm32(R & 31)) : R;
        voffA[i] = (unsigned)(R * K + C) * 2u; voffB[i] = (unsigned)(Rb * K + C) * 2u; }
    const size_t kstep = (size_t)(BK * 2);
    const size_t hstep = (size_t)HALF * K * 2;
    const unsigned ldsw = (unsigned)wid * 1024u;
    const int aoff = lds_byte(wr * 64 + fr, fq * 8), boff = lds_byte(wc * 32 + fr, fq * 8);
#define PG8_SA(b, h) (((b) * 2 + (h)) * HTB)
#define PG8_SB(b, h) ((4 + (b) * 2 + (h)) * HTB)
#define PG8_STAGE(bufoff, gbase, voff) do { _Pragma("unroll") for (int _i = 0; _i < 2; ++_i) \
        __builtin_amdgcn_global_load_lds((const unsigned*)((const char*)(gbase) + (voff)[_i]), (LAS unsigned*)(lds + (bufoff) + ldsw + _i * 8192), 16, 0, 0); } while (0)
#define PG8_LDA(dst, b, h) do { _Pragma("unroll") for (int m = 0; m < 4; ++m) _Pragma("unroll") for (int k = 0; k < 2; ++k) dst[m][k] = *(const LAS bf16x8*)(lds + PG8_SA(b, h) + aoff + m * 2048 + k * 1024); } while (0)
#define PG8_LDB(dst, b, h) do { _Pragma("unroll") for (int n = 0; n < 2; ++n) _Pragma("unroll") for (int k = 0; k < 2; ++k) dst[n][k] = *(const LAS bf16x8*)(lds + PG8_SB(b, h) + boff + n * 2048 + k * 1024); } while (0)
#define PG8_MMA(ai, bj, At, Bt) do { __builtin_amdgcn_s_setprio(1); _Pragma("unroll") for (int m = 0; m < 4; ++m) _Pragma("unroll") for (int n = 0; n < 2; ++n) _Pragma("unroll") for (int k = 0; k < 2; ++k) \
        acc[ai][bj][m][n] = __builtin_amdgcn_mfma_f32_16x16x32_bf16(Bt[n][k], At[m][k], acc[ai][bj][m][n], 0, 0, 0); __builtin_amdgcn_s_setprio(0); } while (0)
#define PG8_WAIT_V(n) asm volatile("s_waitcnt vmcnt(" #n ")" ::: "memory")
#define PG8_WAIT_L(n) asm volatile("s_waitcnt lgkmcnt(" #n ")" ::: "memory")
#define PG8_BAR __builtin_amdgcn_s_barrier()
#define PG8_SCHED __builtin_amdgcn_sched_barrier(0)
    Unit cur, nxt; int ui = 0;
    if (!S.next(0, cur)) return;
    f32x4 acc[2][2][4][2];
#pragma unroll
    for (int a = 0; a < 2; ++a)
#pragma unroll
        for (int b = 0; b < 2; ++b)
#pragma unroll
            for (int m = 0; m < 4; ++m)
#pragma unroll
                for (int n = 0; n < 2; ++n) acc[a][b][m][n] = (f32x4){0.f, 0.f, 0.f, 0.f};
    bf16x8 At[4][2], B0[2][2], B1[2][2];
    const char* cA = cur.A; const char* cB = cur.B;
    PG8_STAGE(PG8_SB(0, 0), cB, voffB); PG8_STAGE(PG8_SB(0, 1), cB + hstep, voffB); PG8_STAGE(PG8_SA(0, 0), cA, voffA); PG8_STAGE(PG8_SA(0, 1), cA + hstep, voffA);
    if (wr == 1) PG8_BAR;
    PG8_WAIT_V(2); PG8_BAR;
    PG8_STAGE(PG8_SB(1, 0), cB + kstep, voffB); PG8_STAGE(PG8_SA(1, 0), cA + kstep, voffA); PG8_STAGE(PG8_SB(1, 1), cB + hstep + kstep, voffB);
    PG8_WAIT_V(6); PG8_BAR;
    for (;;) {
        const bool has_next = S.next(ui + 1, nxt);
        const char* nA = has_next ? nxt.A : cA; const char* nB = has_next ? nxt.B : cB;
        const int nt = cur.nt;
        for (int t = 0; t < nt; t += 2) {
            const bool last = (t == nt - 2);
            const char* a1 = cA + (size_t)(t + 1) * kstep;
            const char* a2 = last ? nA : cA + (size_t)(t + 2) * kstep; const char* b2 = last ? nB : cB + (size_t)(t + 2) * kstep;
            const char* a3 = a2 + kstep; const char* b3 = b2 + kstep;
            PG8_LDB(B0, 0, 0); PG8_LDB(B1, 0, 1); PG8_SCHED; PG8_LDA(At, 0, 0); PG8_STAGE(PG8_SA(1, 1), a1 + hstep, voffA);
            PG8_WAIT_V(8); PG8_WAIT_L(0); PG8_BAR; PG8_MMA(0, 0, At, B0); PG8_MMA(0, 1, At, B1); PG8_BAR; PG8_SCHED;
            PG8_LDA(At, 0, 1); PG8_STAGE(PG8_SB(0, 0), b2, voffB); PG8_STAGE(PG8_SB(0, 1), b2 + hstep, voffB); PG8_STAGE(PG8_SA(0, 0), a2, voffA);
            PG8_WAIT_V(8); PG8_WAIT_L(0); PG8_BAR; PG8_MMA(1, 0, At, B0); PG8_MMA(1, 1, At, B1); PG8_BAR; PG8_SCHED;
            PG8_LDB(B0, 1, 0); PG8_LDB(B1, 1, 1); PG8_SCHED; PG8_LDA(At, 1, 0); PG8_STAGE(PG8_SA(0, 1), a2 + hstep, voffA);
            PG8_WAIT_V(8); PG8_WAIT_L(0); PG8_BAR; PG8_MMA(0, 0, At, B0); PG8_MMA(0, 1, At, B1); PG8_BAR; PG8_SCHED;
            PG8_LDA(At, 1, 1); PG8_STAGE(PG8_SB(1, 0), b3, voffB); PG8_STAGE(PG8_SB(1, 1), b3 + hstep, voffB); PG8_STAGE(PG8_SA(1, 0), a3, voffA);
            PG8_WAIT_V(8); PG8_WAIT_L(0); PG8_BAR; PG8_MMA(1, 0, At, B0); PG8_MMA(1, 1, At, B1); PG8_BAR; PG8_SCHED;
        }
        if (wr == 0) PG8_BAR;
        E(acc, cur, wr, wc, fr, fq);
        if (!has_next) break;
#pragma unroll
        for (int a = 0; a < 2; ++a)
#pragma unroll
            for (int b = 0; b < 2; ++b)
#pragma unroll
                for (int m = 0; m < 4; ++m)
#pragma unroll
                    for (int n = 0; n < 2; ++n) acc[a][b][m][n] = (f32x4){0.f, 0.f, 0.f, 0.f};
        cur = nxt; cA = nA; cB = nB; ++ui;
        if (wr == 1) PG8_BAR;
    }
    PG8_WAIT_V(0);
    PG8_BAR;
#undef PG8_SA
#undef PG8_SB
#undef PG8_STAGE
#undef PG8_LDA
#undef PG8_LDB
#undef PG8_MMA
#undef PG8_WAIT_V
#undef PG8_WAIT_L
#undef PG8_BAR
#undef PG8_SCHED
}
}

struct Args {
    const float* x_prompt; const float* x_sample; const float* norm_mix_pre; const float* norm_mix_post; const float* norm_ffn_pre; const float* norm_ffn_post;
    const float* w_in; const float* conv_w; const float* pool_w; const float* pool_scale; const float* sg_norm; const float* sg_w; const float* sg_b; const float* attn_sink;
    const float* w_branch; const float* w_gate; const float* b_gate; const float* w_out; const float* w_ffn_in; const float* w_ffn_out;
    float* out; unsigned char* ws; int ph_lo, ph_hi, coop, pad;
};

template <int MODE>
__device__ __forceinline__ void transpose_item(const float* W, int ldw, int N, bf16_t* WT, int ldt, LAS float* scr, int item, int lane) {
    const int nblk = N / 32, kb = item / nblk, nb = item % nblk, k0 = 64 * kb, n0 = 32 * nb;
#pragma unroll 8
    for (int i = 0; i < 32; ++i) { const int kk = 2 * i + (lane >> 5); scr[kk * 33 + (lane & 31)] = W[(size_t)(k0 + kk) * ldw + n0 + (lane & 31)]; }
    asm volatile("s_waitcnt lgkmcnt(0)" ::: "memory");
    const int c = lane & 7;
#pragma unroll
    for (int j = 0; j < 4; ++j) { const int n = (lane >> 3) + 8 * j; const LAS float* s = scr + (8 * c) * 33 + n;
        u32x4 o; o.x = cvt_pk_bf16(s[0 * 33], s[1 * 33]); o.y = cvt_pk_bf16(s[2 * 33], s[3 * 33]); o.z = cvt_pk_bf16(s[4 * 33], s[5 * 33]); o.w = cvt_pk_bf16(s[6 * 33], s[7 * 33]);
        int drow = n0 + n;
        if (MODE == 1) { const int sc = n0 + n, isg = sc >= DFF ? 1 : 0, f = sc - isg * DFF; drow = 256 * (f >> 7) + 128 * ((f >> 6) & 1) + 32 * ((f >> 4) & 3) + 16 * isg + (f & 15); }
        *(u32x4*)(WT + (size_t)drow * ldt + k0 + 8 * c) = o; }
    asm volatile("s_waitcnt lgkmcnt(0)" ::: "memory");
}

__device__ __forceinline__ void phase_prologue(const Args& a, LAS unsigned char* lds, int wid, int lane) {
    LAS float* scr = (LAS float*)(lds + wid * 16384);
    const int gw = blockIdx.x * NWAVES + wid, NGW = gridDim.x * NWAVES;
    constexpr int I_IN = 16 * 64, I_G = 16 * 32, I_B = 16 * 32, I_O = 16 * 32, I_FI = 16 * 176, I_FO = 44 * 32, I_PW = 2;
    constexpr int I_LAYER = I_IN + 4 * I_G + I_B + I_O + I_FI + I_FO + 4 * I_PW;
    for (int it = gw; it < DEPTH * I_LAYER; it += NGW) {
        const int l = it / I_LAYER; int r = it % I_LAYER;
        unsigned char* wl = a.ws + WS_W + (size_t)l * W_LAYER;
        if (r < I_IN) { transpose_item<0>(a.w_in + (size_t)l * DM * DIN, DIN, DIN, (bf16_t*)(wl + W_IN), DM, scr, r, lane); continue; } r -= I_IN;
        if (r < 4 * I_G) { const int b = r / I_G; transpose_item<0>(a.w_gate + ((size_t)l * 4 + b) * DM * DM, DM, DM, (bf16_t*)(wl + W_G) + (size_t)b * DM * DM, DM, scr, r % I_G, lane); continue; } r -= 4 * I_G;
        if (r < I_B) { transpose_item<0>(a.w_branch + (size_t)l * DM * DM, DM, DM, (bf16_t*)(wl + W_B), DM, scr, r, lane); continue; } r -= I_B;
        if (r < I_O) { transpose_item<0>(a.w_out + (size_t)l * DM * DM, DM, DM, (bf16_t*)(wl + W_OUT), DM, scr, r, lane); continue; } r -= I_O;
        if (r < I_FI) { transpose_item<1>(a.w_ffn_in + (size_t)l * DM * NFI, NFI, NFI, (bf16_t*)(wl + W_FI), DM, scr, r, lane); continue; } r -= I_FI;
        if (r < I_FO) { transpose_item<0>(a.w_ffn_out + (size_t)l * DFF * DM, DM, DM, (bf16_t*)(wl + W_FO), DFF, scr, r, lane); continue; } r -= I_FO;
        { const int g = r / I_PW; transpose_item<0>(a.pool_w + ((size_t)l * 4 + g) * 4096, 64, 64, (bf16_t*)(wl + W_PW) + g * 4096, 64, scr, r % I_PW, lane); }
    }
    const int gt = blockIdx.x * NTHR + threadIdx.x, NGT = gridDim.x * NTHR;
    for (int i = gt; i < DEPTH * 65536 / 4; i += NGT) { const int l = (i * 4) / 65536, o = (i * 4) % 65536;
        const f32x4 v = *(const f32x4*)(a.sg_w + (size_t)l * 65536 + o); u32x2 w; w.x = cvt_pk_bf16(v[0], v[1]); w.y = cvt_pk_bf16(v[2], v[3]);
        *(u32x2*)((bf16_t*)(a.ws + WS_W + (size_t)l * W_LAYER + W_SG) + o) = w; }
    bf16_t* H = (bf16_t*)(a.ws + WS_H);
    for (int row = gw; row < M_TOK; row += NGW) {
        const float* xr = row < M_PROMPT ? a.x_prompt + (size_t)row * DM : a.x_sample + (size_t)(row - M_PROMPT) * DM;
        f32x4 v[4]; float ss = 0.f;
#pragma unroll
        for (int j = 0; j < 4; ++j) { v[j] = ((const f32x4*)xr)[lane + 64 * j]; ss += (v[j][0] * v[j][0] + v[j][1] * v[j][1]) + (v[j][2] * v[j][2] + v[j][3] * v[j][3]); }
        const float rstd = __builtin_amdgcn_rsqf(wave_sum(ss) * (1.f / DM) + EPS);
#pragma unroll
        for (int j = 0; j < 4; ++j) { const f32x4 g = ((const f32x4*)a.norm_mix_pre)[lane + 64 * j]; u32x2 w; w.x = cvt_pk_bf16(v[j][0] * rstd * g[0], v[j][1] * rstd * g[1]); w.y = cvt_pk_bf16(v[j][2] * rstd * g[2], v[j][3] * rstd * g[3]);
            ((u32x2*)(H + (size_t)row * DM))[lane + 64 * j] = w; }
    }
}

__device__ __forceinline__ void phase_resnorm(const Args& a, const bf16_t* Y, const float* gpost, const float* gnext, bool first_x, bf16_t* H, int wid, int lane) {
    const int gw = blockIdx.x * NWAVES + wid, NGW = gridDim.x * NWAVES;
    for (int row = gw; row < M_TOK; row += NGW) {
        const float* xr = first_x ? (row < M_PROMPT ? a.x_prompt + (size_t)row * DM : a.x_sample + (size_t)(row - M_PROMPT) * DM) : a.out + (size_t)row * DM;
        f32x4 xv[4], yv[4]; float ss = 0.f;
#pragma unroll
        for (int j = 0; j < 4; ++j) { const u32x2 w = ((const u32x2*)(Y + (size_t)row * DM))[lane + 64 * j]; yv[j] = (f32x4){bflo(w.x), bfhi(w.x), bflo(w.y), bfhi(w.y)};
            xv[j] = ((const f32x4*)xr)[lane + 64 * j]; ss += (yv[j][0] * yv[j][0] + yv[j][1] * yv[j][1]) + (yv[j][2] * yv[j][2] + yv[j][3] * yv[j][3]); }
        const float rstd = __builtin_amdgcn_rsqf(wave_sum(ss) * (1.f / DM) + EPS);
        float sx = 0.f;
#pragma unroll
        for (int j = 0; j < 4; ++j) { const f32x4 g = ((const f32x4*)gpost)[lane + 64 * j]; xv[j] = xv[j] + yv[j] * rstd * g;
            ((f32x4*)(a.out + (size_t)row * DM))[lane + 64 * j] = xv[j]; sx += (xv[j][0] * xv[j][0] + xv[j][1] * xv[j][1]) + (xv[j][2] * xv[j][2] + xv[j][3] * xv[j][3]); }
        if (gnext) {
            const float rx = __builtin_amdgcn_rsqf(wave_sum(sx) * (1.f / DM) + EPS);
#pragma unroll
            for (int j = 0; j < 4; ++j) { const f32x4 g = ((const f32x4*)gnext)[lane + 64 * j]; u32x2 w; w.x = cvt_pk_bf16(xv[j][0] * rx * g[0], xv[j][1] * rx * g[1]); w.y = cvt_pk_bf16(xv[j][2] * rx * g[2], xv[j][3] * rx * g[3]);
                ((u32x2*)(H + (size_t)row * DM))[lane + 64 * j] = w; }
        }
    }
}

__device__ __forceinline__ void mixer_conv_pool(const bf16_t* Z, bf16_t* BR, const float* conv_w, const bf16_t* pwT, const float* pool_scale, int row0, int wid, int lane) {
    int s0, s1; seq_bounds(row0, s0, s1);
    const int tid = threadIdx.x;
    for (int it = tid; it < 128 * 32; it += NTHR) {
        const int t = it >> 5, c8 = (it & 31) * 8, row = row0 + t;
        const u32x4 bg = *(const u32x4*)(Z + (size_t)row * DIN + c8);
        float cv[8];
#pragma unroll
        for (int j = 0; j < 8; ++j) cv[j] = 0.f;
#pragma unroll
        for (int d = 0; d < 3; ++d) { const int r2 = row + d - 1;
            if (r2 >= s0 && r2 < s1) { const u32x4 cgv = *(const u32x4*)(Z + (size_t)r2 * DIN + 256 + c8), xv = *(const u32x4*)(Z + (size_t)r2 * DIN + 512 + c8);
                const f32x4 w0 = *(const f32x4*)(conv_w + d * 256 + c8), w1 = *(const f32x4*)(conv_w + d * 256 + c8 + 4);
#pragma unroll
                for (int q = 0; q < 4; ++q) { cv[2 * q] += (q < 2 ? w0[2 * q] : w1[2 * q - 4]) * bflo(cgv[q]) * bflo(xv[q]); cv[2 * q + 1] += (q < 2 ? w0[2 * q + 1] : w1[2 * q - 3]) * bfhi(cgv[q]) * bfhi(xv[q]); } } }
        u32x4 o;
#pragma unroll
        for (int q = 0; q < 4; ++q) o[q] = cvt_pk_bf16(bflo(bg[q]) * cv[2 * q], bfhi(bg[q]) * cv[2 * q + 1]);
        *(u32x4*)(BR + (size_t)row * DM + c8) = o;
    }
    const int fr = lane & 15, fq = lane >> 4; const int row = row0 + 16 * wid + fr;
#pragma unroll 1
    for (int g = 0; g < 4; ++g) {
        const int half = 1 << g; const int lo = max(row - half, s0), hi = min(row + half, s1); const float inv = 1.0f / (float)(hi - lo);
        f32x4 acc[4];
#pragma unroll
        for (int d = 0; d < 4; ++d) acc[d] = (f32x4){0.f, 0.f, 0.f, 0.f};
#pragma unroll
        for (int kk = 0; kk < 2; ++kk) {
            const int c = 768 + 64 * g + 32 * kk + 8 * fq;
            float s[8];
#pragma unroll
            for (int j = 0; j < 8; ++j) s[j] = 0.f;
            for (int dr = -half; dr < half; ++dr) { const int r2 = row + dr;
                if (r2 >= s0 && r2 < s1) { const u32x4 v = *(const u32x4*)(Z + (size_t)r2 * DIN + c);
#pragma unroll
                    for (int q = 0; q < 4; ++q) { s[2 * q] += bflo(v[q]); s[2 * q + 1] += bfhi(v[q]); } } }
            const u32x4 sv = *(const u32x4*)(Z + (size_t)row * DIN + c);
            u32x4 pw;
#pragma unroll
            for (int q = 0; q < 4; ++q) pw[q] = cvt_pk_bf16(s[2 * q] * inv - bflo(sv[q]), s[2 * q + 1] * inv - bfhi(sv[q]));
            const bf16x8 bfrag = __builtin_bit_cast(bf16x8, pw);
#pragma unroll
            for (int d = 0; d < 4; ++d) { const bf16x8 afrag = *(const bf16x8*)(pwT + g * 4096 + (16 * d + fr) * 64 + 32 * kk + 8 * fq);
                acc[d] = __builtin_amdgcn_mfma_f32_16x16x32_bf16(afrag, bfrag, acc[d], 0, 0, 0); }
        }
#pragma unroll
        for (int d = 0; d < 4; ++d) { const int dc = 64 * g + 16 * d + 4 * fq; const f32x4 sc = *(const f32x4*)(pool_scale + dc);
            u32x2 w; w.x = cvt_pk_bf16(acc[d][0] * sc[0], acc[d][1] * sc[1]); w.y = cvt_pk_bf16(acc[d][2] * sc[2], acc[d][3] * sc[3]);
            *(u32x2*)(BR + (size_t)row * DM + 256 + dc) = w; }
    }
}

constexpr int VLN_PITCH = 264;
__device__ __forceinline__ void mixer_spatial(const bf16_t* Z, bf16_t* BR, const float* sg_norm, const bf16_t* sgw, const float* sg_b, LAS unsigned char* lds, int row0, int wid, int lane) {
    const f32x4 gn = *(const f32x4*)(sg_norm + 4 * lane);
    for (int i = 0; i < 16; ++i) { const int t = 16 * wid + i; const u32x2 w = *(const u32x2*)(Z + (size_t)(row0 + t) * DIN + 1280 + 4 * lane);
        f32x4 v = (f32x4){bflo(w.x), bfhi(w.x), bflo(w.y), bfhi(w.y)};
        const float mean = wave_sum((v[0] + v[1]) + (v[2] + v[3])) * (1.f / 256.f); v = v - mean;
        const float var = wave_sum((v[0] * v[0] + v[1] * v[1]) + (v[2] * v[2] + v[3] * v[3])) * (1.f / 256.f);
        const float rstd = __builtin_amdgcn_rsqf(var + EPS);
        u32x2 o; o.x = cvt_pk_bf16(v[0] * rstd * gn[0], v[1] * rstd * gn[1]); o.y = cvt_pk_bf16(v[2] * rstd * gn[2], v[3] * rstd * gn[3]);
        *(LAS u32x2*)(lds + (t * VLN_PITCH + 4 * lane) * 2) = o; }
    __syncthreads();
    const int fr = lane & 15, fq = lane >> 4, l16 = lane & 15, tq = l16 >> 2, tp = l16 & 3;
    const int t = 16 * wid + fr, row = row0 + t;
#pragma unroll 1
    for (int g = 0; g < 4; ++g) {
        bf16x8 wf[4];
#pragma unroll
        for (int kk = 0; kk < 4; ++kk) wf[kk] = *(const bf16x8*)(sgw + g * 16384 + t * 128 + 32 * kk + 8 * fq);
        const float bias = sg_b[g * 128 + t];
#pragma unroll
        for (int ct = 0; ct < 4; ++ct) { const int c0 = 64 * g + 16 * ct; f32x4 acc = (f32x4){0.f, 0.f, 0.f, 0.f};
#pragma unroll
            for (int kk = 0; kk < 4; ++kk) { const LAS unsigned char* p = lds + ((32 * kk + 8 * fq + tq) * VLN_PITCH + c0 + 4 * tp) * 2;
                const s16x4 lo = tr_read(p), hi = tr_read(p + 4 * VLN_PITCH * 2);
                const bf16x8 af = (bf16x8){lo[0], lo[1], lo[2], lo[3], hi[0], hi[1], hi[2], hi[3]};
                acc = __builtin_amdgcn_mfma_f32_16x16x32_bf16(af, wf[kk], acc, 0, 0, 0); }
            const u32x2 uw = *(const u32x2*)(Z + (size_t)row * DIN + 1024 + c0 + 4 * fq);
            u32x2 o; o.x = cvt_pk_bf16(bflo(uw.x) * (acc[0] + bias), bfhi(uw.x) * (acc[1] + bias)); o.y = cvt_pk_bf16(bflo(uw.y) * (acc[2] + bias), bfhi(uw.y) * (acc[3] + bias));
            *(u32x2*)(BR + (size_t)row * DM + 512 + c0 + 4 * fq) = o; }
    }
    __syncthreads();
}

constexpr int KV_PITCH = 72, KV_ROWS = 400, KV_BYTES = KV_ROWS * KV_PITCH * 2;
__device__ __forceinline__ void mixer_attn(const bf16_t* Z, bf16_t* BR, const float* sink, LAS unsigned char* lds, int row0, int kvh, int wid, int lane) {
    int s0, s1; seq_bounds(row0, s0, s1);
    const int tid = threadIdx.x;
    LAS unsigned char* Kl = lds; LAS unsigned char* Vl = lds + KV_BYTES;
    for (int it = tid; it < KV_ROWS * 8; it += NTHR) { const int r = it >> 3, c8 = (it & 7) * 8; const int grow = row0 - 144 + r;
        u32x4 kv = (u32x4){0u, 0u, 0u, 0u}, vv = kv;
        if (grow >= s0 && grow < s1) { kv = *(const u32x4*)(Z + (size_t)grow * DIN + 1792 + kvh * 64 + c8); vv = *(const u32x4*)(Z + (size_t)grow * DIN + 1920 + kvh * 64 + c8); }
        *(LAS u32x4*)(Kl + (r * KV_PITCH + c8) * 2) = kv; *(LAS u32x4*)(Vl + (r * KV_PITCH + c8) * 2) = vv; }
    __syncthreads();
    const int fr = lane & 15, fq = lane >> 4, tq = fr >> 2, tp = fr & 3;
    const int qrow = row0 + 16 * wid + fr;
    float frel0 = (float)(fr + 144 - 4 * fq), frlo = (float)max(-128, qrow - s1 + 1), frhi = (float)min(128, qrow - s0);
#pragma unroll 1
    for (int g = 0; g < 2; ++g) {
        asm volatile("" : "+v"(frel0), "+v"(frlo), "+v"(frhi));
        const int hq = kvh * 2 + g;
        const float slope = __builtin_amdgcn_exp2f(-2.0f * (float)(hq + 1)) * LOG2E;
        const float sk = sink[hq] * LOG2E;
        bf16x8 qf[2];
#pragma unroll
        for (int kk = 0; kk < 2; ++kk) qf[kk] = *(const bf16x8*)(Z + (size_t)qrow * DIN + 1536 + hq * 64 + 32 * kk + 8 * fq);
        f32x4 sc[18];
#pragma unroll
        for (int kt = 0; kt < 18; ++kt) { f32x4 acc = (f32x4){0.f, 0.f, 0.f, 0.f};
#pragma unroll
            for (int kk = 0; kk < 2; ++kk) { const bf16x8 kf = *(const LAS bf16x8*)(Kl + ((16 * wid + 16 * kt + fr) * KV_PITCH + 32 * kk + 8 * fq) * 2);
                acc = __builtin_amdgcn_mfma_f32_16x16x32_bf16(kf, qf[kk], acc, 0, 0, 0); }
            sc[kt] = acc; if (kt & 1) __builtin_amdgcn_sched_barrier(0); }
        float mx = sk;
#pragma unroll
        for (int kt = 0; kt < 18; ++kt)
#pragma unroll
            for (int e = 0; e < 4; ++e) { const float t = frel0 - (float)(16 * kt + e);
                float v = __builtin_fmaf(__builtin_fabsf(t), -slope, sc[kt][e] * (0.125f * LOG2E));
                const float df = t - __builtin_amdgcn_fmed3f(t, frlo, frhi);
                v = __builtin_fmaf(__builtin_fabsf(df), -1e30f, v);
                sc[kt][e] = v; mx = fmaxf(mx, v); }
        mx = fmaxf(mx, __shfl_xor(mx, 16)); mx = fmaxf(mx, __shfl_xor(mx, 32));
        float sum = 0.f;
#pragma unroll
        for (int kt = 0; kt < 18; ++kt)
#pragma unroll
            for (int e = 0; e < 4; ++e) { const float p = __builtin_amdgcn_exp2f(sc[kt][e] - mx); sc[kt][e] = p; sum += p; }
        sum += __shfl_xor(sum, 16); sum += __shfl_xor(sum, 32);
        const float rden = __builtin_amdgcn_rcpf(sum + __builtin_amdgcn_exp2f(sk - mx));
        f32x4 o[4];
#pragma unroll
        for (int d = 0; d < 4; ++d) o[d] = (f32x4){0.f, 0.f, 0.f, 0.f};
#pragma unroll
        for (int j = 0; j < 9; ++j) {
            u32x4 pw; pw.x = cvt_pk_bf16(sc[2 * j][0], sc[2 * j][1]); pw.y = cvt_pk_bf16(sc[2 * j][2], sc[2 * j][3]); pw.z = cvt_pk_bf16(sc[2 * j + 1][0], sc[2 * j + 1][1]); pw.w = cvt_pk_bf16(sc[2 * j + 1][2], sc[2 * j + 1][3]);
            const bf16x8 pf = __builtin_bit_cast(bf16x8, pw);
#pragma unroll
            for (int d = 0; d < 4; ++d) { const LAS unsigned char* p = Vl + ((16 * wid + 32 * j + 4 * fq + tq) * KV_PITCH + 16 * d + 4 * tp) * 2;
                const s16x4 lo = tr_read(p), hi = tr_read(p + 16 * KV_PITCH * 2);
                const bf16x8 vf = (bf16x8){lo[0], lo[1], lo[2], lo[3], hi[0], hi[1], hi[2], hi[3]};
                o[d] = __builtin_amdgcn_mfma_f32_16x16x32_bf16(vf, pf, o[d], 0, 0, 0); }
            __builtin_amdgcn_sched_barrier(0);
        }
#pragma unroll
        for (int d = 0; d < 4; ++d) { u32x2 w; w.x = cvt_pk_bf16(o[d][0] * rden, o[d][1] * rden); w.y = cvt_pk_bf16(o[d][2] * rden, o[d][3] * rden);
            *(u32x2*)(BR + (size_t)qrow * DM + 768 + hq * 64 + 16 * d + 4 * fq) = w; }
    }
    __syncthreads();
}

constexpr int LDS_BYTES = 131072 + 1024;
constexpr int N_PHASES = 1 + 8 * DEPTH;

__global__ void __launch_bounds__(NTHR) fwd_megakernel(Args a) {
    extern __shared__ __attribute__((aligned(16))) unsigned char lds_raw[];
    LAS unsigned char* lds = (LAS unsigned char*)lds_raw;
    cg::grid_group grid = cg::this_grid();
    const int tid = threadIdx.x, lane = tid & 63, wid = __builtin_amdgcn_readfirstlane(tid >> 6);
    const int G = gridDim.x, bx = blockIdx.x;
    unsigned char* ws = a.ws;
    bf16_t* H = (bf16_t*)(ws + WS_H); bf16_t* Z = (bf16_t*)(ws + WS_Z); bf16_t* BR = (bf16_t*)(ws + WS_BR);
    bf16_t* MERGED = (bf16_t*)(ws + WS_MERGED); bf16_t* Y = (bf16_t*)(ws + WS_Y); bf16_t* ACT = (bf16_t*)(ws + WS_ACT);
    const int lo = a.ph_lo, hi = a.ph_hi;
#define IN(k) (lo <= (k) && (k) < hi)
#define SEAM(k) do { if (a.coop && IN((k) + 1)) grid.sync(); } while (0)

    if (lo == 99) {
        const bf16_t* src = (const bf16_t*)(ws + (size_t)a.pad * MiB);
        for (size_t i = (size_t)bx * NTHR + tid; i < (size_t)M_TOK * DM; i += (size_t)G * NTHR) a.out[i] = __uint_as_float((unsigned)src[i] << 16);
        return;
    }
    if (IN(0)) { phase_prologue(a, lds, wid, lane); SEAM(0); }

#pragma unroll 1
    for (int l = 0; l < DEPTH; ++l) {
        const int p0 = 1 + 8 * l;
        int tl = threadIdx.x; asm volatile("" : "+v"(tl)); const int lane = tl & 63, wid = __builtin_amdgcn_readfirstlane(tl >> 6);
        const unsigned char* wl = ws + WS_W + (size_t)l * W_LAYER;
        const bf16_t* Win = (const bf16_t*)(wl + W_IN); const bf16_t* Wg = (const bf16_t*)(wl + W_G); const bf16_t* Wb = (const bf16_t*)(wl + W_B);
        const bf16_t* Wout = (const bf16_t*)(wl + W_OUT); const bf16_t* Wfi = (const bf16_t*)(wl + W_FI); const bf16_t* Wfo = (const bf16_t*)(wl + W_FO);
        const bf16_t* sgw = (const bf16_t*)(wl + W_SG); const bf16_t* pwT = (const bf16_t*)(wl + W_PW);

        if (IN(p0 + 0)) {
            gm::SchedPlain S{H, Win, DM, M_TOK / 256, DIN / 256, DM / 64, G, bx}; gm::EpiStoreBf16 E{Z, DIN};
            gm::gemm_phase<true>(lds, DM, S, E);
            SEAM(p0 + 0);
        }
        if (IN(p0 + 1)) {
            for (int u = bx; u < 4 * 384; u += G) { const int part = u / 384, chunk = u % 384, row0 = chunk * 128;
                if (part == 0) mixer_conv_pool(Z, BR, a.conv_w + l * 768, pwT, a.pool_scale + l * 256, row0, wid, lane);
                else if (part == 1) mixer_spatial(Z, BR, a.sg_norm + l * 256, sgw, a.sg_b + l * 512, lds, row0, wid, lane);
                else mixer_attn(Z, BR, a.attn_sink + l * 4, lds, row0, part - 2, wid, lane);
            }
            SEAM(p0 + 1);
        }
        if (IN(p0 + 2)) {
            gm::SchedGate S{H, BR, Wg, Wb, M_TOK / 256, DM / 256, G, bx};
            unsigned char* scr = ws + WS_SCR + (size_t)bx * SCR_PER_CU;
            gm::EpiGate E{a.b_gate + l * 4 * DM, MERGED, scr, scr + 128 * 1024};
            gm::gemm_phase<true>(lds, DM, S, E);
            SEAM(p0 + 2);
        }
        if (IN(p0 + 3)) {
            gm::SchedPlain S{MERGED, Wout, DM, M_TOK / 256, DM / 256, DM / 64, G, bx}; gm::EpiStoreBf16 E{Y, DM};
            gm::gemm_phase<true>(lds, DM, S, E);
            SEAM(p0 + 3);
        }
        if (IN(p0 + 4)) { phase_resnorm(a, Y, a.norm_mix_post + l * DM, a.norm_ffn_pre + l * DM, l == 0, H, wid, lane); SEAM(p0 + 4); }
        if (IN(p0 + 5)) {
            gm::SchedPlain S{H, Wfi, DM, M_TOK / 256, NFI / 256, DM / 64, G, bx}; gm::EpiSwiGLU E{ACT};
            gm::gemm_phase<false>(lds, DM, S, E);
            SEAM(p0 + 5);
        }
        if (IN(p0 + 6)) {
            gm::SchedPlain S{ACT, Wfo, DFF, M_TOK / 256, DM / 256, DFF / 64, G, bx}; gm::EpiStoreBf16 E{H, DM};
            gm::gemm_phase<true>(lds, DFF, S, E);
            SEAM(p0 + 6);
        }
        if (IN(p0 + 7)) { phase_resnorm(a, H, a.norm_ffn_post + l * DM, (l + 1 < DEPTH) ? a.norm_mix_pre + (l + 1) * DM : nullptr, false, H, wid, lane); SEAM(p0 + 7); }
    }
#undef IN
#undef SEAM
}

extern "C" void kernel_launch(void* const* d_in, const int* in_sizes, int n_in, void* d_out, int out_size, void* d_ws, size_t ws_size, hipStream_t stream) {
    static int grid = 0;
    if (grid == 0) {
        if (n_in != 20 || out_size != M_TOK * DM || ws_size < WS_END) { fprintf(stderr, "kernel_launch: unexpected shapes (n_in %d out %d ws %zu)\n", n_in, out_size, ws_size); grid = -1; return; }
        int dev = 0, cus = 0, per_cu = 0;
        hipGetDevice(&dev); hipDeviceGetAttribute(&cus, hipDeviceAttributeMultiprocessorCount, dev);
        if (hipFuncSetAttribute((const void*)fwd_megakernel, hipFuncAttributeMaxDynamicSharedMemorySize, LDS_BYTES) != hipSuccess) { fprintf(stderr, "kernel_launch: hipFuncSetAttribute failed\n"); grid = -1; return; }
        if (hipOccupancyMaxActiveBlocksPerMultiprocessor(&per_cu, (const void*)fwd_megakernel, NTHR, LDS_BYTES) != hipSuccess || per_cu < 1) { fprintf(stderr, "kernel_launch: occupancy query says %d\n", per_cu); per_cu = 1; }
        (void)hipGetLastError();
        grid = cus * 1;
    }
    if (grid < 0) return;
    Args a{};
    const float** fp = (const float**)&a;
    for (int i = 0; i < 20; ++i) fp[i] = (const float*)d_in[i];
    a.out = (float*)d_out; a.ws = (unsigned char*)d_ws; a.pad = 0;
#if MK_LAUNCH_PER_PHASE
#ifdef DUMP_AFTER
    for (int p = 0; p <= DUMP_AFTER; ++p) { a.ph_lo = p; a.ph_hi = p + 1; a.coop = 0;
        hipLaunchKernelGGL(fwd_megakernel, dim3(grid), dim3(NTHR), LDS_BYTES, stream, a); }
    a.ph_lo = 99; a.ph_hi = 100; a.pad = DUMP_MIB;
    hipLaunchKernelGGL(fwd_megakernel, dim3(grid), dim3(NTHR), LDS_BYTES, stream, a);
#else
    for (int p = 0; p < N_PHASES; ++p) { a.ph_lo = p; a.ph_hi = p + 1; a.coop = 0;
        hipLaunchKernelGGL(fwd_megakernel, dim3(grid), dim3(NTHR), LDS_BYTES, stream, a); }
#endif
#else
    a.ph_lo = 0; a.ph_hi = N_PHASES; a.coop = 1;
    void* args[] = {&a};
    hipError_t e = hipLaunchCooperativeKernel((const void*)fwd_megakernel, dim3(grid), dim3(NTHR), args, LDS_BYTES, stream);
    if (e != hipSuccess) fprintf(stderr, "cooperative launch failed: %s (grid %d)\n", hipGetErrorString(e), grid);
#endif
}
```

```cpp
#include <hip/hip_runtime.h>
#include <hip/hip_cooperative_groups.h>
#include <cstdio>
#include <cstdint>
namespace cg = cooperative_groups;

#ifndef MK_LAUNCH_PER_PHASE
#define MK_LAUNCH_PER_PHASE 0
#endif

#define LAS __attribute__((address_space(3)))
typedef unsigned short bf16_t;
typedef short bf16x8 __attribute__((ext_vector_type(8)));
typedef short s16x4 __attribute__((ext_vector_type(4)));
typedef float f32x4 __attribute__((ext_vector_type(4)));
typedef unsigned u32x4 __attribute__((ext_vector_type(4)));
typedef unsigned u32x2 __attribute__((ext_vector_type(2)));

constexpr int M_TOK = 49152, M_PROMPT = 32768, DM = 1024, DIN = 2048, DFF = 2816, NFI = 5632, DEPTH = 2;
constexpr int NWAVES = 8, NTHR = 512;
constexpr float EPS = 1e-6f;
constexpr float LOG2E = 1.4426950408889634f;

constexpr size_t MiB = 1u << 20;
constexpr size_t W_IN = 0, W_G = 4 * MiB, W_B = 12 * MiB, W_OUT = 14 * MiB, W_FI = 16 * MiB, W_FO = 27 * MiB, W_SG = 32 * MiB + 512 * 1024, W_PW = W_SG + 128 * 1024, W_LAYER = 33 * MiB;
constexpr size_t WS_W = 0, WS_H = 66 * MiB, WS_Z = 162 * MiB, WS_BR = 354 * MiB, WS_END = 450 * MiB;
constexpr size_t WS_MERGED = WS_Z, WS_SCR = WS_Z + 96 * MiB, WS_Y = WS_Z + 96 * MiB, WS_ACT = WS_Z;
constexpr size_t SCR_PER_CU = 256 * 1024;

typedef float f32x2_t __attribute__((ext_vector_type(2))); typedef __bf16 bf16x2_t __attribute__((ext_vector_type(2)));
__device__ __forceinline__ unsigned cvt_pk_bf16(float lo, float hi) { f32x2_t v = {lo, hi}; bf16x2_t b = __builtin_convertvector(v, bf16x2_t); return __builtin_bit_cast(unsigned, b); }
__device__ __forceinline__ float bflo(unsigned w) { return __uint_as_float(w << 16); }
__device__ __forceinline__ float bfhi(unsigned w) { return __uint_as_float(w & 0xffff0000u); }
__device__ __forceinline__ float wave_sum(float v) {
#pragma unroll
    for (int o = 1; o < 64; o <<= 1) v += __shfl_xor(v, o);
    return v;
}
__device__ __forceinline__ float sigmoidf_(float x) { return __builtin_amdgcn_rcpf(1.0f + __builtin_amdgcn_exp2f(-x * LOG2E)); }
__device__ __forceinline__ void seq_bounds(int row, int& s0, int& s1) { if (row < M_PROMPT) { s0 = row & ~4095; s1 = s0 + 4096; } else { s0 = M_PROMPT; s1 = M_TOK; } }
__device__ __forceinline__ s16x4 tr_read(const LAS unsigned char* p) { return __builtin_bit_cast(s16x4, __builtin_amdgcn_ds_read_tr16_b64_v4i16((LAS s16x4*)p)); }

namespace gm {
constexpr int BM = 256, BK = 64, HALF = 128, HTB = HALF * BK * 2, STAGE_BYTES = 8 * HTB, NXCD = 8, WGM = 8;
__host__ __device__ __forceinline__ int lds_byte(int r, int c) { const int st = (r >> 4) * 2 + (c >> 5), rr = r & 15, cc = c & 31, ob = rr * 64 + cc * 2; return st * 1024 + (ob ^ (((ob >> 9) & 1) << 5)); }
__host__ __device__ __forceinline__ void stage_rc(int b, int& R, int& C) { const int st = b / 1024, sb = b % 1024, swz = sb ^ (((sb >> 9) & 1) << 5); R = (st >> 1) * 16 + swz / 64; C = (st & 1) * 32 + (swz % 64) / 2; }
__host__ __device__ __forceinline__ int perm32(int rho) { const int n = rho >> 4, i = rho & 15; return 8 * (i >> 2) + 4 * n + (i & 3); }

struct Unit { const char* A; const char* B; int nt, pm, pn, tag; };

__device__ __forceinline__ void tile_of(int L, int nM, int nN, int& pm, int& pn) {
    const int nwg = nM * nN; int wgid = L;
    { const int q = nwg / NXCD, r = nwg % NXCD, xcd = wgid % NXCD, off = wgid / NXCD; wgid = (xcd < r ? xcd * (q + 1) : r * (q + 1) + (xcd - r) * q) + off; }
    const int nig = WGM * nN, gid = wgid / nig, fm = gid * WGM, gsz = (nM - fm) < WGM ? (nM - fm) : WGM;
    pm = fm + ((wgid % nig) % gsz); pn = (wgid % nig) / gsz;
}
struct SchedPlain {
    const bf16_t* A; const bf16_t* B; int pitch, nM, nN, nt, G, c;
    __device__ __forceinline__ bool next(int i, Unit& u) const {
        const int L = i * G + c; if (L >= nM * nN) return false;
        tile_of(L, nM, nN, u.pm, u.pn);
        u.A = (const char*)(A + (size_t)u.pm * BM * pitch); u.B = (const char*)(B + (size_t)u.pn * BM * pitch); u.nt = nt; u.tag = 0; return true;
    }
};
struct SchedGate {
    const bf16_t* H; const bf16_t* BR; const bf16_t* WG; const bf16_t* WB; int nM, nN, G, c;
    __device__ __forceinline__ bool next(int i, Unit& u) const {
        const int ti = i >> 3, sub = i & 7; const int L = ti * G + c; if (L >= nM * nN) return false;
        tile_of(L, nM, nN, u.pm, u.pn);
        const int b = sub >> 1; u.tag = sub;
        if ((sub & 1) == 0) { u.A = (const char*)(H + (size_t)u.pm * BM * DM); u.B = (const char*)(WG + (size_t)b * DM * DM + (size_t)u.pn * BM * DM); u.nt = 16; }
        else { u.A = (const char*)(BR + (size_t)u.pm * BM * DM + 256 * b); u.B = (const char*)(WB + (size_t)u.pn * BM * DM + 256 * b); u.nt = 4; }
        return true;
    }
};

struct EpiStoreBf16 {
    bf16_t* O; int ldc;
    __device__ __forceinline__ void operator()(const f32x4 (&acc)[2][2][4][2], const Unit& u, int wr, int wc, int fr, int fq) const {
        const int row0 = u.pm * BM + wr * 64 + fr, col0 = u.pn * BM + wc * 32 + 8 * fq;
#pragma unroll
        for (int ai = 0; ai < 2; ++ai)
#pragma unroll
            for (int m = 0; m < 4; ++m) { bf16_t* rowp = O + (size_t)(row0 + ai * HALF + m * 16) * ldc + col0;
#pragma unroll
                for (int bj = 0; bj < 2; ++bj) { const f32x4 v0 = acc[ai][bj][m][0], v1 = acc[ai][bj][m][1];
                    u32x4 w; w.x = cvt_pk_bf16(v0[0], v0[1]); w.y = cvt_pk_bf16(v0[2], v0[3]); w.z = cvt_pk_bf16(v1[0], v1[1]); w.w = cvt_pk_bf16(v1[2], v1[3]);
                    *(u32x4*)(rowp + bj * HALF) = w; } }
    }
};
struct EpiSwiGLU {
    bf16_t* O;
    __device__ __forceinline__ void operator()(const f32x4 (&acc)[2][2][4][2], const Unit& u, int wr, int wc, int fr, int fq) const {
        const int row0 = u.pm * BM + wr * 64 + fr, col0 = u.pn * 128 + wc * 16 + 4 * fq;
#pragma unroll
        for (int ai = 0; ai < 2; ++ai)
#pragma unroll
            for (int m = 0; m < 4; ++m) { bf16_t* rowp = O + (size_t)(row0 + ai * HALF + m * 16) * DFF + col0;
#pragma unroll
                for (int bj = 0; bj < 2; ++bj) { const f32x4 a = acc[ai][bj][m][0], g = acc[ai][bj][m][1]; f32x4 o;
#pragma unroll
                    for (int e = 0; e < 4; ++e) o[e] = a[e] * sigmoidf_(a[e]) * g[e];
                    u32x2 w; w.x = cvt_pk_bf16(o[0], o[1]); w.y = cvt_pk_bf16(o[2], o[3]);
                    *(u32x2*)(rowp + bj * 64) = w; } }
    }
};
#define GAS __attribute__((address_space(1)))
struct EpiGate {
    const float* bgate; bf16_t* O; GAS unsigned char* gsc; GAS unsigned char* msc;
    __device__ __forceinline__ void operator()(const f32x4 (&acc)[2][2][4][2], const Unit& u, int wr, int wc, int fr, int fq) const {
        const int tid = threadIdx.x; const int b = u.tag >> 1, kind = u.tag & 1;
        const int row0 = u.pm * BM + wr * 64 + fr, col0 = u.pn * BM + wc * 32 + 8 * fq;
        unsigned off = (unsigned)tid * 32u;
        if (kind == 0) {
            f32x4 bv[2][2];
#pragma unroll
            for (int bj = 0; bj < 2; ++bj)
#pragma unroll
                for (int n = 0; n < 2; ++n) bv[bj][n] = *(const f32x4*)(bgate + b * DM + col0 + bj * HALF + 4 * n);
#pragma unroll
            for (int ai = 0; ai < 2; ++ai)
#pragma unroll
                for (int m = 0; m < 4; ++m) {
                    asm volatile("" : "+v"(off));
#pragma unroll
                    for (int bj = 0; bj < 2; ++bj) { const f32x4 v0 = acc[ai][bj][m][0] + bv[bj][0], v1 = acc[ai][bj][m][1] + bv[bj][1];
                        u32x4 w; w.x = cvt_pk_bf16(sigmoidf_(v0[0]), sigmoidf_(v0[1])); w.y = cvt_pk_bf16(sigmoidf_(v0[2]), sigmoidf_(v0[3]));
                        w.z = cvt_pk_bf16(sigmoidf_(v1[0]), sigmoidf_(v1[1])); w.w = cvt_pk_bf16(sigmoidf_(v1[2]), sigmoidf_(v1[3]));
                        *(GAS u32x4*)(gsc + off + bj * 16) = w; }
                    off += 16384u; }
        } else {
#pragma unroll
            for (int ai = 0; ai < 2; ++ai) {
                asm volatile("" : "+v"(off));
                u32x4 gw[4][2], mw[4][2];
#pragma unroll
                for (int m = 0; m < 4; ++m)
#pragma unroll
                    for (int bj = 0; bj < 2; ++bj) gw[m][bj] = *(const GAS u32x4*)(gsc + off + m * 16384 + bj * 16);
                if (b != 0) {
#pragma unroll
                    for (int m = 0; m < 4; ++m)
#pragma unroll
                        for (int bj = 0; bj < 2; ++bj) mw[m][bj] = *(const GAS u32x4*)(msc + off + m * 16384 + bj * 16);
                } else {
#pragma unroll
                    for (int m = 0; m < 4; ++m)
#pragma unroll
                        for (int bj = 0; bj < 2; ++bj) mw[m][bj] = (u32x4){0u, 0u, 0u, 0u};
                }
#pragma unroll
                for (int m = 0; m < 4; ++m) { bf16_t* rowp = O + (size_t)(row0 + ai * HALF + m * 16) * DM + col0;
#pragma unroll
                    for (int bj = 0; bj < 2; ++bj) { const u32x4 g = gw[m][bj], q = mw[m][bj];
                        const f32x4 a0 = acc[ai][bj][m][0], a1 = acc[ai][bj][m][1];
                        u32x4 w;
                        w.x = cvt_pk_bf16(bflo(g.x) * a0[0] + bflo(q.x), bfhi(g.x) * a0[1] + bfhi(q.x)); w.y = cvt_pk_bf16(bflo(g.y) * a0[2] + bflo(q.y), bfhi(g.y) * a0[3] + bfhi(q.y));
                        w.z = cvt_pk_bf16(bflo(g.z) * a1[0] + bflo(q.z), bfhi(g.z) * a1[1] + bfhi(q.z)); w.w = cvt_pk_bf16(bflo(g.w) * a1[2] + bflo(q.w), bfhi(g.w) * a1[3] + bfhi(q.w));
                        if (b != 3) *(GAS u32x4*)(msc + off + m * 16384 + bj * 16) = w;
                        else *(u32x4*)(rowp + bj * HALF) = w; } }
                off += 65536u; }
        }
    }
};

template <bool PERM, class Sched, class Epi>
__device__ __forceinline__ void gemm_phase(LAS unsigned char* lds, const int K, const Sched& S, const Epi& E) {
    int tid_ = threadIdx.x; asm volatile("" : "+v"(tid_));
    const int tid = tid_, wid = __builtin_amdgcn_readfirstlane(tid >> 6), lane = tid & 63, wr = wid >> 2, wc = wid & 3, fr = lane & 15, fq = lane >> 4;
    unsigned voffA[2], voffB[2];
#pragma unroll
    for (int i = 0; i < 2; ++i) { int R, C; stage_rc(tid * 16 + i * 8192, R, C); const int Rb = PERM ? ((R & ~31) + perm32(R & 31)) : R;
        voffA[i] = (unsigned)(R * K + C) * 2u; voffB[i] = (unsigned)(Rb * K + C) * 2u; }
    const size_t kstep = (size_t)(BK * 2);
    const size_t hstep = (size_t)HALF * K * 2;
    const unsigned ldsw = (unsigned)wid * 1024u;
    const int aoff = lds_byte(wr * 64 + fr, fq * 8), boff = lds_byte(wc * 32 + fr, fq * 8);
#define PG8_SA(b, h) (((b) * 2 + (h)) * HTB)
#define PG8_SB(b, h) ((4 + (b) * 2 + (h)) * HTB)
#define PG8_STAGE(bufoff, gbase, voff) do { _Pragma("unroll") for (int _i = 0; _i < 2; ++_i) \
        __builtin_amdgcn_global_load_lds((const unsigned*)((const char*)(gbase) + (voff)[_i]), (LAS unsigned*)(lds + (bufoff) + ldsw + _i * 8192), 16, 0, 0); } while (0)
#define PG8_LDA(dst, b, h) do { _Pragma("unroll") for (int m = 0; m < 4; ++m) _Pragma("unroll") for (int k = 0; k < 2; ++k) dst[m][k] = *(const LAS bf16x8*)(lds + PG8_SA(b, h) + aoff + m * 2048 + k * 1024); } while (0)
#define PG8_LDB(dst, b, h) do { _Pragma("unroll") for (int n = 0; n < 2; ++n) _Pragma("unroll") for (int k = 0; k < 2; ++k) dst[n][k] = *(const LAS bf16x8*)(lds + PG8_SB(b, h) + boff + n * 2048 + k * 1024); } while (0)
#define PG8_MMA(ai, bj, At, Bt) do { __builtin_amdgcn_s_setprio(1); _Pragma("unroll") for (int m = 0; m < 4; ++m) _Pragma("unroll") for (int n = 0; n < 2; ++n) _Pragma("unroll") for (int k = 0; k < 2; ++k) \
        acc[ai][bj][m][n] = __builtin_amdgcn_mfma_f32_16x16x32_bf16(Bt[n][k], At[m][k], acc[ai][bj][m][n], 0, 0, 0); __builtin_amdgcn_s_setprio(0); } while (0)
#define PG8_WAIT_V(n) asm volatile("s_waitcnt vmcnt(" #n ")" ::: "memory")
#define PG8_WAIT_L(n) asm volatile("s_waitcnt lgkmcnt(" #n ")" ::: "memory")
#define PG8_BAR __builtin_amdgcn_s_barrier()
#define PG8_SCHED __builtin_amdgcn_sched_barrier(0)
    Unit cur, nxt; int ui = 0;
    if (!S.next(0, cur)) return;
    f32x4 acc[2][2][4][2];
#pragma unroll
    for (int a = 0; a < 2; ++a)
#pragma unroll
        for (int b = 0; b < 2; ++b)
#pragma unroll
            for (int m = 0; m < 4; ++m)
#pragma unroll
                for (int n = 0; n < 2; ++n) acc[a][b][m][n] = (f32x4){0.f, 0.f, 0.f, 0.f};
    bf16x8 At[4][2], B0[2][2], B1[2][2];
    const char* cA = cur.A; const char* cB = cur.B;
    PG8_STAGE(PG8_SB(0, 0), cB, voffB); PG8_STAGE(PG8_SB(0, 1), cB + hstep, voffB); PG8_STAGE(PG8_SA(0, 0), cA, voffA); PG8_STAGE(PG8_SA(0, 1), cA + hstep, voffA);
    if (wr == 1) PG8_BAR;
    PG8_WAIT_V(2); PG8_BAR;
    PG8_STAGE(PG8_SB(1, 0), cB + kstep, voffB); PG8_STAGE(PG8_SA(1, 0), cA + kstep, voffA); PG8_STAGE(PG8_SB(1, 1), cB + hstep + kstep, voffB);
    PG8_WAIT_V(6); PG8_BAR;
    for (;;) {
        const bool has_next = S.next(ui + 1, nxt);
        const char* nA = has_next ? nxt.A : cA; const char* nB = has_next ? nxt.B : cB;
        const int nt = cur.nt;
        for (int t = 0; t < nt; t += 2) {
            const bool last = (t == nt - 2);
            const char* a1 = cA + (size_t)(t + 1) * kstep;
            const char* a2 = last ? nA : cA + (size_t)(t + 2) * kstep; const char* b2 = last ? nB : cB + (size_t)(t + 2) * kstep;
            const char* a3 = a2 + kstep; const char* b3 = b2 + kstep;
            PG8_LDB(B0, 0, 0); PG8_LDB(B1, 0, 1); PG8_SCHED; PG8_LDA(At, 0, 0); PG8_STAGE(PG8_SA(1, 1), a1 + hstep, voffA);
            PG8_WAIT_V(8); PG8_WAIT_L(0); PG8_BAR; PG8_MMA(0, 0, At, B0); PG8_MMA(0, 1, At, B1); PG8_BAR; PG8_SCHED;
            PG8_LDA(At, 0, 1); PG8_STAGE(PG8_SB(0, 0), b2, voffB); PG8_STAGE(PG8_SB(0, 1), b2 + hstep, voffB); PG8_STAGE(PG8_SA(0, 0), a2, voffA);
            PG8_WAIT_V(8); PG8_WAIT_L(0); PG8_BAR; PG8_MMA(1, 0, At, B0); PG8_MMA(1, 1, At, B1); PG8_BAR; PG8_SCHED;
            PG8_LDB(B0, 1, 0); PG8_LDB(B1, 1, 1); PG8_SCHED; PG8_LDA(At, 1, 0); PG8_STAGE(PG8_SA(0, 1), a2 + hstep, voffA);
            PG8_WAIT_V(8); PG8_WAIT_L(0); PG8_BAR; PG8_MMA(0, 0, At, B0); PG8_MMA(0, 1, At, B1); PG8_BAR; PG8_SCHED;
            PG8_LDA(At, 1, 1); PG8_STAGE(PG8_SB(1, 0), b3, voffB); PG8_STAGE(PG8_SB(1, 1), b3 + hstep, voffB); PG8_STAGE(PG8_SA(1, 0), a3, voffA);
            PG8_WAIT_V(8); PG8_WAIT_L(0); PG8_BAR; PG8_MMA(1, 0, At, B0); PG8_MMA(1, 1, At, B1); PG8_BAR; PG8_SCHED;
        }
        if (wr == 0) PG8_BAR;
        E(acc, cur, wr, wc, fr, fq);
        if (!has_next) break;
#pragma unroll
        for (int a = 0; a < 2; ++a)
#pragma unroll
            for (int b = 0; b < 2; ++b)
#pragma unroll
                for (int m = 0; m < 4; ++m)
#pragma unroll
                    for (int n = 0; n < 2; ++n) acc[a][b][m][n] = (f32x4){0.f, 0.f, 0.f, 0.f};
        cur = nxt; cA = nA; cB = nB; ++ui;
        if (wr == 1) PG8_BAR;
    }
    PG8_WAIT_V(0);
    PG8_BAR;
#undef PG8_SA
#undef PG8_SB
#undef PG8_STAGE
#undef PG8_LDA
#undef PG8_LDB
#undef PG8_MMA
#undef PG8_WAIT_V
#undef PG8_WAIT_L
#undef PG8_BAR
#undef PG8_SCHED
}
}

struct Args {
    const float* x_prompt; const float* x_sample; const float* norm_mix_pre; const float* norm_mix_post; const float* norm_ffn_pre; const float* norm_ffn_post;
    const float* w_in; const float* conv_w; const float* pool_w; const float* pool_scale; const float* sg_norm; const float* sg_w; const float* sg_b; const float* attn_sink;
    const float* w_branch; const float* w_gate; const float* b_gate; const float* w_out; const float* w_ffn_in; const float* w_ffn_out;
    float* out; unsigned char* ws; int ph_lo, ph_hi, coop, pad;
};

template <int MODE>
__device__ __forceinline__ void transpose_item(const float* W, int ldw, int N, bf16_t* WT, int ldt, LAS float* scr, int item, int lane) {
    const int nblk = N / 32, kb = item / nblk, nb = item % nblk, k0 = 64 * kb, n0 = 32 * nb;
#pragma unroll 8
    for (int i = 0; i < 32; ++i) { const int kk = 2 * i + (lane >> 5); scr[kk * 33 + (lane & 31)] = W[(size_t)(k0 + kk) * ldw + n0 + (lane & 31)]; }
    asm volatile("s_waitcnt lgkmcnt(0)" ::: "memory");
    const int c = lane & 7;
#pragma unroll
    for (int j = 0; j < 4; ++j) { const int n = (lane >> 3) + 8 * j; const LAS float* s = scr + (8 * c) * 33 + n;
        u32x4 o; o.x = cvt_pk_bf16(s[0 * 33], s[1 * 33]); o.y = cvt_pk_bf16(s[2 * 33], s[3 * 33]); o.z = cvt_pk_bf16(s[4 * 33], s[5 * 33]); o.w = cvt_pk_bf16(s[6 * 33], s[7 * 33]);
        int drow = n0 + n;
        if (MODE == 1) { const int sc = n0 + n, isg = sc >= DFF ? 1 : 0, f = sc - isg * DFF; drow = 256 * (f >> 7) + 128 * ((f >> 6) & 1) + 32 * ((f >> 4) & 3) + 16 * isg + (f & 15); }
        *(u32x4*)(WT + (size_t)drow * ldt + k0 + 8 * c) = o; }
    asm volatile("s_waitcnt lgkmcnt(0)" ::: "memory");
}

__device__ __forceinline__ void phase_prologue(const Args& a, LAS unsigned char* lds, int wid, int lane) {
    LAS float* scr = (LAS float*)(lds + wid * 16384);
    const int gw = blockIdx.x * NWAVES + wid, NGW = gridDim.x * NWAVES;
    constexpr int I_IN = 16 * 64, I_G = 16 * 32, I_B = 16 * 32, I_O = 16 * 32, I_FI = 16 * 176, I_FO = 44 * 32, I_PW = 2;
    constexpr int I_LAYER = I_IN + 4 * I_G + I_B + I_O + I_FI + I_FO + 4 * I_PW;
    for (int it = gw; it < DEPTH * I_LAYER; it += NGW) {
        const int l = it / I_LAYER; int r = it % I_LAYER;
        unsigned char* wl = a.ws + WS_W + (size_t)l * W_LAYER;
        if (r < I_IN) { transpose_item<0>(a.w_in + (size_t)l * DM * DIN, DIN, DIN, (bf16_t*)(wl + W_IN), DM, scr, r, lane); continue; } r -= I_IN;
        if (r < 4 * I_G) { const int b = r / I_G; transpose_item<0>(a.w_gate + ((size_t)l * 4 + b) * DM * DM, DM, DM, (bf16_t*)(wl + W_G) + (size_t)b * DM * DM, DM, scr, r % I_G, lane); continue; } r -= 4 * I_G;
        if (r < I_B) { transpose_item<0>(a.w_branch + (size_t)l * DM * DM, DM, DM, (bf16_t*)(wl + W_B), DM, scr, r, lane); continue; } r -= I_B;
        if (r < I_O) { transpose_item<0>(a.w_out + (size_t)l * DM * DM, DM, DM, (bf16_t*)(wl + W_OUT), DM, scr, r, lane); continue; } r -= I_O;
        if (r < I_FI) { transpose_item<1>(a.w_ffn_in + (size_t)l * DM * NFI, NFI, NFI, (bf16_t*)(wl + W_FI), DM, scr, r, lane); continue; } r -= I_FI;
        if (r < I_FO) { transpose_item<0>(a.w_ffn_out + (size_t)l * DFF * DM, DM, DM, (bf16_t*)(wl + W_FO), DFF, scr, r, lane); continue; } r -= I_FO;
        { const int g = r / I_PW; transpose_item<0>(a.pool_w + ((size_t)l * 4 + g) * 4096, 64, 64, (bf16_t*)(wl + W_PW) + g * 4096, 64, scr, r % I_PW, lane); }
    }
    const int gt = blockIdx.x * NTHR + threadIdx.x, NGT = gridDim.x * NTHR;
    for (int i = gt; i < DEPTH * 65536 / 4; i += NGT) { const int l = (i * 4) / 65536, o = (i * 4) % 65536;
        const f32x4 v = *(const f32x4*)(a.sg_w + (size_t)l * 65536 + o); u32x2 w; w.x = cvt_pk_bf16(v[0], v[1]); w.y = cvt_pk_bf16(v[2], v[3]);
        *(u32x2*)((bf16_t*)(a.ws + WS_W + (size_t)l * W_LAYER + W_SG) + o) = w; }
    bf16_t* H = (bf16_t*)(a.ws + WS_H);
    for (int row = gw; row < M_TOK; row += NGW) {
        const float* xr = row < M_PROMPT ? a.x_prompt + (size_t)row * DM : a.x_sample + (size_t)(row - M_PROMPT) * DM;
        f32x4 v[4]; float ss = 0.f;
#pragma unroll
        for (int j = 0; j < 4; ++j) { v[j] = ((const f32x4*)xr)[lane + 64 * j]; ss += (v[j][0] * v[j][0] + v[j][1] * v[j][1]) + (v[j][2] * v[j][2] + v[j][3] * v[j][3]); }
        const float rstd = __builtin_amdgcn_rsqf(wave_sum(ss) * (1.f / DM) + EPS);
#pragma unroll
        for (int j = 0; j < 4; ++j) { const f32x4 g = ((const f32x4*)a.norm_mix_pre)[lane + 64 * j]; u32x2 w; w.x = cvt_pk_bf16(v[j][0] * rstd * g[0], v[j][1] * rstd * g[1]); w.y = cvt_pk_bf16(v[j][2] * rstd * g[2], v[j][3] * rstd * g[3]);
            ((u32x2*)(H + (size_t)row * DM))[lane + 64 * j] = w; }
    }
}

__device__ __forceinline__ void phase_resnorm(const Args& a, const bf16_t* Y, const float* gpost, const float* gnext, bool first_x, bf16_t* H, int wid, int lane) {
    const int gw = blockIdx.x * NWAVES + wid, NGW = gridDim.x * NWAVES;
    for (int row = gw; row < M_TOK; row += NGW) {
        const float* xr = first_x ? (row < M_PROMPT ? a.x_prompt + (size_t)row * DM : a.x_sample + (size_t)(row - M_PROMPT) * DM) : a.out + (size_t)row * DM;
        f32x4 xv[4], yv[4]; float ss = 0.f;
#pragma unroll
        for (int j = 0; j < 4; ++j) { const u32x2 w = ((const u32x2*)(Y + (size_t)row * DM))[lane + 64 * j]; yv[j] = (f32x4){bflo(w.x), bfhi(w.x), bflo(w.y), bfhi(w.y)};
            xv[j] = ((const f32x4*)xr)[lane + 64 * j]; ss += (yv[j][0] * yv[j][0] + yv[j][1] * yv[j][1]) + (yv[j][2] * yv[j][2] + yv[j][3] * yv[j][3]); }
        const float rstd = __builtin_amdgcn_rsqf(wave_sum(ss) * (1.f / DM) + EPS);
        float sx = 0.f;
#pragma unroll
        for (int j = 0; j < 4; ++j) { const f32x4 g = ((const f32x4*)gpost)[lane + 64 * j]; xv[j] = xv[j] + yv[j] * rstd * g;
            ((f32x4*)(a.out + (size_t)row * DM))[lane + 64 * j] = xv[j]; sx += (xv[j][0] * xv[j][0] + xv[j][1] * xv[j][1]) + (xv[j][2] * xv[j][2] + xv[j][3] * xv[j][3]); }
        if (gnext) {
            const float rx = __builtin_amdgcn_rsqf(wave_sum(sx) * (1.f / DM) + EPS);
#pragma unroll
            for (int j = 0; j < 4; ++j) { const f32x4 g = ((const f32x4*)gnext)[lane + 64 * j]; u32x2 w; w.x = cvt_pk_bf16(xv[j][0] * rx * g[0], xv[j][1] * rx * g[1]); w.y = cvt_pk_bf16(xv[j][2] * rx * g[2], xv[j][3] * rx * g[3]);
                ((u32x2*)(H + (size_t)row * DM))[lane + 64 * j] = w; }
        }
    }
}

__device__ __forceinline__ void mixer_conv_pool(const bf16_t* Z, bf16_t* BR, const float* conv_w, const bf16_t* pwT, const float* pool_scale, int row0, int wid, int lane) {
    int s0, s1; seq_bounds(row0, s0, s1);
    const int tid = threadIdx.x;
    for (int it = tid; it < 128 * 32; it += NTHR) {
        const int t = it >> 5, c8 = (it & 31) * 8, row = row0 + t;
        const u32x4 bg = *(const u32x4*)(Z + (size_t)row * DIN + c8);
        float cv[8];
#pragma unroll
        for (int j = 0; j < 8; ++j) cv[j] = 0.f;
#pragma unroll
        for (int d = 0; d < 3; ++d) { const int r2 = row + d - 1;
            if (r2 >= s0 && r2 < s1) { const u32x4 cgv = *(const u32x4*)(Z + (size_t)r2 * DIN + 256 + c8), xv = *(const u32x4*)(Z + (size_t)r2 * DIN + 512 + c8);
                const f32x4 w0 = *(const f32x4*)(conv_w + d * 256 + c8), w1 = *(const f32x4*)(conv_w + d * 256 + c8 + 4);
#pragma unroll
                for (int q = 0; q < 4; ++q) { cv[2 * q] += (q < 2 ? w0[2 * q] : w1[2 * q - 4]) * bflo(cgv[q]) * bflo(xv[q]); cv[2 * q + 1] += (q < 2 ? w0[2 * q + 1] : w1[2 * q - 3]) * bfhi(cgv[q]) * bfhi(xv[q]); } } }
        u32x4 o;
#pragma unroll
        for (int q = 0; q < 4; ++q) o[q] = cvt_pk_bf16(bflo(bg[q]) * cv[2 * q], bfhi(bg[q]) * cv[2 * q + 1]);
        *(u32x4*)(BR + (size_t)row * DM + c8) = o;
    }
    const int fr = lane & 15, fq = lane >> 4; const int row = row0 + 16 * wid + fr;
#pragma unroll 1
    for (int g = 0; g < 4; ++g) {
        const int half = 1 << g; const int lo = max(row - half, s0), hi = min(row + half, s1); const float inv = 1.0f / (float)(hi - lo);
        f32x4 acc[4];
#pragma unroll
        for (int d = 0; d < 4; ++d) acc[d] = (f32x4){0.f, 0.f, 0.f, 0.f};
#pragma unroll
        for (int kk = 0; kk < 2; ++kk) {
            const int c = 768 + 64 * g + 32 * kk + 8 * fq;
            float s[8];
#pragma unroll
            for (int j = 0; j < 8; ++j) s[j] = 0.f;
            for (int dr = -half; dr < half; ++dr) { const int r2 = row + dr;
                if (r2 >= s0 && r2 < s1) { const u32x4 v = *(const u32x4*)(Z + (size_t)r2 * DIN + c);
#pragma unroll
                    for (int q = 0; q < 4; ++q) { s[2 * q] += bflo(v[q]); s[2 * q + 1] += bfhi(v[q]); } } }
            const u32x4 sv = *(const u32x4*)(Z + (size_t)row * DIN + c);
            u32x4 pw;
#pragma unroll
            for (int q = 0; q < 4; ++q) pw[q] = cvt_pk_bf16(s[2 * q] * inv - bflo(sv[q]), s[2 * q + 1] * inv - bfhi(sv[q]));
            const bf16x8 bfrag = __builtin_bit_cast(bf16x8, pw);
#pragma unroll
            for (int d = 0; d < 4; ++d) { const bf16x8 afrag = *(const bf16x8*)(pwT + g * 4096 + (16 * d + fr) * 64 + 32 * kk + 8 * fq);
                acc[d] = __builtin_amdgcn_mfma_f32_16x16x32_bf16(afrag, bfrag, acc[d], 0, 0, 0); }
        }
#pragma unroll
        for (int d = 0; d < 4; ++d) { const int dc = 64 * g + 16 * d + 4 * fq; const f32x4 sc = *(const f32x4*)(pool_scale + dc);
            u32x2 w; w.x = cvt_pk_bf16(acc[d][0] * sc[0], acc[d][1] * sc[1]); w.y = cvt_pk_bf16(acc[d][2] * sc[2], acc[d][3] * sc[3]);
            *(u32x2*)(BR + (size_t)row * DM + 256 + dc) = w; }
    }
}

constexpr int VLN_PITCH = 264;
__device__ __forceinline__ void mixer_spatial(const bf16_t* Z, bf16_t* BR, const float* sg_norm, const bf16_t* sgw, const float* sg_b, LAS unsigned char* lds, int row0, int wid, int lane) {
    const f32x4 gn = *(const f32x4*)(sg_norm + 4 * lane);
    for (int i = 0; i < 16; ++i) { const int t = 16 * wid + i; const u32x2 w = *(const u32x2*)(Z + (size_t)(row0 + t) * DIN + 1280 + 4 * lane);
        f32x4 v = (f32x4){bflo(w.x), bfhi(w.x), bflo(w.y), bfhi(w.y)};
        const float mean = wave_sum((v[0] + v[1]) + (v[2] + v[3])) * (1.f / 256.f); v = v - mean;
        const float var = wave_sum((v[0] * v[0] + v[1] * v[1]) + (v[2] * v[2] + v[3] * v[3])) * (1.f / 256.f);
        const float rstd = __builtin_amdgcn_rsqf(var + EPS);
        u32x2 o; o.x = cvt_pk_bf16(v[0] * rstd * gn[0], v[1] * rstd * gn[1]); o.y = cvt_pk_bf16(v[2] * rstd * gn[2], v[3] * rstd * gn[3]);
        *(LAS u32x2*)(lds + (t * VLN_PITCH + 4 * lane) * 2) = o; }
    __syncthreads();
    const int fr = lane & 15, fq = lane >> 4, l16 = lane & 15, tq = l16 >> 2, tp = l16 & 3;
    const int t = 16 * wid + fr, row = row0 + t;
#pragma unroll 1
    for (int g = 0; g < 4; ++g) {
        bf16x8 wf[4];
#pragma unroll
        for (int kk = 0; kk < 4; ++kk) wf[kk] = *(const bf16x8*)(sgw + g * 16384 + t * 128 + 32 * kk + 8 * fq);
        const float bias = sg_b[g * 128 + t];
#pragma unroll
        for (int ct = 0; ct < 4; ++ct) { const int c0 = 64 * g + 16 * ct; f32x4 acc = (f32x4){0.f, 0.f, 0.f, 0.f};
#pragma unroll
            for (int kk = 0; kk < 4; ++kk) { const LAS unsigned char* p = lds + ((32 * kk + 8 * fq + tq) * VLN_PITCH + c0 + 4 * tp) * 2;
                const s16x4 lo = tr_read(p), hi = tr_read(p + 4 * VLN_PITCH * 2);
                const bf16x8 af = (bf16x8){lo[0], lo[1], lo[2], lo[3], hi[0], hi[1], hi[2], hi[3]};
                acc = __builtin_amdgcn_mfma_f32_16x16x32_bf16(af, wf[kk], acc, 0, 0, 0); }
            const u32x2 uw = *(const u32x2*)(Z + (size_t)row * DIN + 1024 + c0 + 4 * fq);
            u32x2 o; o.x = cvt_pk_bf16(bflo(uw.x) * (acc[0] + bias), bfhi(uw.x) * (acc[1] + bias)); o.y = cvt_pk_bf16(bflo(uw.y) * (acc[2] + bias), bfhi(uw.y) * (acc[3] + bias));
            *(u32x2*)(BR + (size_t)row * DM + 512 + c0 + 4 * fq) = o; }
    }
    __syncthreads();
}

constexpr int KV_PITCH = 72, KV_ROWS = 400, KV_BYTES = KV_ROWS * KV_PITCH * 2;
__device__ __forceinline__ void mixer_attn(const bf16_t* Z, bf16_t* BR, const float* sink, LAS unsigned char* lds, int row0, int kvh, int wid, int lane) {
    int s0, s1; seq_bounds(row0, s0, s1);
    const int tid = threadIdx.x;
    LAS unsigned char* Kl = lds; LAS unsigned char* Vl = lds + KV_BYTES;
    for (int it = tid; it < KV_ROWS * 8; it += NTHR) { const int r = it >> 3, c8 = (it & 7) * 8; const int grow = row0 - 144 + r;
        u32x4 kv = (u32x4){0u, 0u, 0u, 0u}, vv = kv;
        if (grow >= s0 && grow < s1) { kv = *(const u32x4*)(Z + (size_t)grow * DIN + 1792 + kvh * 64 + c8); vv = *(const u32x4*)(Z + (size_t)grow * DIN + 1920 + kvh * 64 + c8); }
        *(LAS u32x4*)(Kl + (r * KV_PITCH + c8) * 2) = kv; *(LAS u32x4*)(Vl + (r * KV_PITCH + c8) * 2) = vv; }
    __syncthreads();
    const int fr = lane & 15, fq = lane >> 4, tq = fr >> 2, tp = fr & 3;
    const int qrow = row0 + 16 * wid + fr;
    float frel0 = (float)(fr + 144 - 4 * fq), frlo = (float)max(-128, qrow - s1 + 1), frhi = (float)min(128, qrow - s0);
#pragma unroll 1
    for (int g = 0; g < 2; ++g) {
        asm volatile("" : "+v"(frel0), "+v"(frlo), "+v"(frhi));
        const int hq = kvh * 2 + g;
        const float slope = __builtin_amdgcn_exp2f(-2.0f * (float)(hq + 1)) * LOG2E;
        const float sk = sink[hq] * LOG2E;
        bf16x8 qf[2];
#pragma unroll
        for (int kk = 0; kk < 2; ++kk) qf[kk] = *(const bf16x8*)(Z + (size_t)qrow * DIN + 1536 + hq * 64 + 32 * kk + 8 * fq);
        f32x4 sc[18];
#pragma unroll
        for (int kt = 0; kt < 18; ++kt) { f32x4 acc = (f32x4){0.f, 0.f, 0.f, 0.f};
#pragma unroll
            for (int kk = 0; kk < 2; ++kk) { const bf16x8 kf = *(const LAS bf16x8*)(Kl + ((16 * wid + 16 * kt + fr) * KV_PITCH + 32 * kk + 8 * fq) * 2);
                acc = __builtin_amdgcn_mfma_f32_16x16x32_bf16(kf, qf[kk], acc, 0, 0, 0); }
            sc[kt] = acc; if (kt & 1) __builtin_amdgcn_sched_barrier(0); }
        float mx = sk;
#pragma unroll
        for (int kt = 0; kt < 18; ++kt)
#pragma unroll
            for (int e = 0; e < 4; ++e) { const float t = frel0 - (float)(16 * kt + e);
                float v = __builtin_fmaf(__builtin_fabsf(t), -slope, sc[kt][e] * (0.125f * LOG2E));
                const float df = t - __builtin_amdgcn_fmed3f(t, frlo, frhi);
                v = __builtin_fmaf(__builtin_fabsf(df), -1e30f, v);
                sc[kt][e] = v; mx = fmaxf(mx, v); }
        mx = fmaxf(mx, __shfl_xor(mx, 16)); mx = fmaxf(mx, __shfl_xor(mx, 32));
        float sum = 0.f;
#pragma unroll
        for (int kt = 0; kt < 18; ++kt)
#pragma unroll
            for (int e = 0; e < 4; ++e) { const float p = __builtin_amdgcn_exp2f(sc[kt][e] - mx); sc[kt][e] = p; sum += p; }
        sum += __shfl_xor(sum, 16); sum += __shfl_xor(sum, 32);
        const float rden = __builtin_amdgcn_rcpf(sum + __builtin_amdgcn_exp2f(sk - mx));
        f32x4 o[4];
#pragma unroll
        for (int d = 0; d < 4; ++d) o[d] = (f32x4){0.f, 0.f, 0.f, 0.f};
#pragma unroll
        for (int j = 0; j < 9; ++j) {
            u32x4 pw; pw.x = cvt_pk_bf16(sc[2 * j][0], sc[2 * j][1]); pw.y = cvt_pk_bf16(sc[2 * j][2], sc[2 * j][3]); pw.z = cvt_pk_bf16(sc[2 * j + 1][0], sc[2 * j + 1][1]); pw.w = cvt_pk_bf16(sc[2 * j + 1][2], sc[2 * j + 1][3]);
            const bf16x8 pf = __builtin_bit_cast(bf16x8, pw);
#pragma unroll
            for (int d = 0; d < 4; ++d) { const LAS unsigned char* p = Vl + ((16 * wid + 32 * j + 4 * fq + tq) * KV_PITCH + 16 * d + 4 * tp) * 2;
                const s16x4 lo = tr_read(p), hi = tr_read(p + 16 * KV_PITCH * 2);
                const bf16x8 vf = (bf16x8){lo[0], lo[1], lo[2], lo[3], hi[0], hi[1], hi[2], hi[3]};
                o[d] = __builtin_amdgcn_mfma_f32_16x16x32_bf16(vf, pf, o[d], 0, 0, 0); }
            __builtin_amdgcn_sched_barrier(0);
        }
#pragma unroll
        for (int d = 0; d < 4; ++d) { u32x2 w; w.x = cvt_pk_bf16(o[d][0] * rden, o[d][1] * rden); w.y = cvt_pk_bf16(o[d][2] * rden, o[d][3] * rden);
            *(u32x2*)(BR + (size_t)qrow * DM + 768 + hq * 64 + 16 * d + 4 * fq) = w; }
    }
    __syncthreads();
}

constexpr int LDS_BYTES = 131072 + 1024;
constexpr int N_PHASES = 1 + 8 * DEPTH;

__global__ void __launch_bounds__(NTHR) fwd_megakernel(Args a) {
    extern __shared__ __attribute__((aligned(16))) unsigned char lds_raw[];
    LAS unsigned char* lds = (LAS unsigned char*)lds_raw;
    cg::grid_group grid = cg::this_grid();
    const int tid = threadIdx.x, lane = tid & 63, wid = __builtin_amdgcn_readfirstlane(tid >> 6);
    const int G = gridDim.x, bx = blockIdx.x;
    unsigned char* ws = a.ws;
    bf16_t* H = (bf16_t*)(ws + WS_H); bf16_t* Z = (bf16_t*)(ws + WS_Z); bf16_t* BR = (bf16_t*)(ws + WS_BR);
    bf16_t* MERGED = (bf16_t*)(ws + WS_MERGED); bf16_t* Y = (bf16_t*)(ws + WS_Y); bf16_t* ACT = (bf16_t*)(ws + WS_ACT);
    const int lo = a.ph_lo, hi = a.ph_hi;
#define IN(k) (lo <= (k) && (k) < hi)
#define SEAM(k) do { if (a.coop && IN((k) + 1)) grid.sync(); } while (0)

    if (lo == 99) {
        const bf16_t* src = (const bf16_t*)(ws + (size_t)a.pad * MiB);
        for (size_t i = (size_t)bx * NTHR + tid; i < (size_t)M_TOK * DM; i += (size_t)G * NTHR) a.out[i] = __uint_as_float((unsigned)src[i] << 16);
        return;
    }
    if (IN(0)) { phase_prologue(a, lds, wid, lane); SEAM(0); }

#pragma unroll 1
    for (int l = 0; l < DEPTH; ++l) {
        const int p0 = 1 + 8 * l;
        int tl = threadIdx.x; asm volatile("" : "+v"(tl)); const int lane = tl & 63, wid = __builtin_amdgcn_readfirstlane(tl >> 6);
        const unsigned char* wl = ws + WS_W + (size_t)l * W_LAYER;
        const bf16_t* Win = (const bf16_t*)(wl + W_IN); const bf16_t* Wg = (const bf16_t*)(wl + W_G); const bf16_t* Wb = (const bf16_t*)(wl + W_B);
        const bf16_t* Wout = (const bf16_t*)(wl + W_OUT); const bf16_t* Wfi = (const bf16_t*)(wl + W_FI); const bf16_t* Wfo = (const bf16_t*)(wl + W_FO);
        const bf16_t* sgw = (const bf16_t*)(wl + W_SG); const bf16_t* pwT = (const bf16_t*)(wl + W_PW);

        if (IN(p0 + 0)) {
            gm::SchedPlain S{H, Win, DM, M_TOK / 256, DIN / 256, DM / 64, G, bx}; gm::EpiStoreBf16 E{Z, DIN};
            gm::gemm_phase<true>(lds, DM, S, E);
            SEAM(p0 + 0);
        }
        if (IN(p0 + 1)) {
            for (int u = bx; u < 4 * 384; u += G) { const int part = u / 384, chunk = u % 384, row0 = chunk * 128;
                if (part == 0) mixer_conv_pool(Z, BR, a.conv_w + l * 768, pwT, a.pool_scale + l * 256, row0, wid, lane);
                else if (part == 1) mixer_spatial(Z, BR, a.sg_norm + l * 256, sgw, a.sg_b + l * 512, lds, row0, wid, lane);
                else mixer_attn(Z, BR, a.attn_sink + l * 4, lds, row0, part - 2, wid, lane);
            }
            SEAM(p0 + 1);
        }
        if (IN(p0 + 2)) {
            gm::SchedGate S{H, BR, Wg, Wb, M_TOK / 256, DM / 256, G, bx};
            unsigned char* scr = ws + WS_SCR + (size_t)bx * SCR_PER_CU;
            gm::EpiGate E{a.b_gate + l * 4 * DM, MERGED, (GAS unsigned char*)scr, (GAS unsigned char*)(scr + 128 * 1024)};
            gm::gemm_phase<true>(lds, DM, S, E);
            SEAM(p0 + 2);
        }
        if (IN(p0 + 3)) {
            gm::SchedPlain S{MERGED, Wout, DM, M_TOK / 256, DM / 256, DM / 64, G, bx}; gm::EpiStoreBf16 E{Y, DM};
            gm::gemm_phase<true>(lds, DM, S, E);
            SEAM(p0 + 3);
        }
        if (IN(p0 + 4)) { phase_resnorm(a, Y, a.norm_mix_post + l * DM, a.norm_ffn_pre + l * DM, l == 0, H, wid, lane); SEAM(p0 + 4); }
        if (IN(p0 + 5)) {
            gm::SchedPlain S{H, Wfi, DM, M_TOK / 256, NFI / 256, DM / 64, G, bx}; gm::EpiSwiGLU E{ACT};
            gm::gemm_phase<false>(lds, DM, S, E);
            SEAM(p0 + 5);
        }
        if (IN(p0 + 6)) {
            gm::SchedPlain S{ACT, Wfo, DFF, M_TOK / 256, DM / 256, DFF / 64, G, bx}; gm::EpiStoreBf16 E{H, DM};
            gm::gemm_phase<true>(lds, DFF, S, E);
            SEAM(p0 + 6);
        }
        if (IN(p0 + 7)) { phase_resnorm(a, H, a.norm_ffn_post + l * DM, (l + 1 < DEPTH) ? a.norm_mix_pre + (l + 1) * DM : nullptr, false, H, wid, lane); SEAM(p0 + 7); }
    }
#undef IN
#undef SEAM
}

extern "C" void kernel_launch(void* const* d_in, const int* in_sizes, int n_in, void* d_out, int out_size, void* d_ws, size_t ws_size, hipStream_t stream) {
    static int grid = 0;
    if (grid == 0) {
        if (n_in != 20 || out_size != M_TOK * DM || ws_size < WS_END) { fprintf(stderr, "kernel_launch: unexpected shapes (n_in %d out %d ws %zu)\n", n_in, out_size, ws_size); grid = -1; return; }
        int dev = 0, cus = 0, per_cu = 0;
        hipGetDevice(&dev); hipDeviceGetAttribute(&cus, hipDeviceAttributeMultiprocessorCount, dev);
        if (hipFuncSetAttribute((const void*)fwd_megakernel, hipFuncAttributeMaxDynamicSharedMemorySize, LDS_BYTES) != hipSuccess) { fprintf(stderr, "kernel_launch: hipFuncSetAttribute failed\n"); grid = -1; return; }
        if (hipOccupancyMaxActiveBlocksPerMultiprocessor(&per_cu, (const void*)fwd_megakernel, NTHR, LDS_BYTES) != hipSuccess || per_cu < 1) { fprintf(stderr, "kernel_launch: occupancy query says %d\n", per_cu); per_cu = 1; }
        (void)hipGetLastError();
        grid = cus * 1;
    }
    if (grid < 0) return;
    Args a{};
    const float** fp = (const float**)&a;
    for (int i = 0; i < 20; ++i) fp[i] = (const float*)d_in[i];
    a.out = (float*)d_out; a.ws = (unsigned char*)d_ws; a.pad = 0;
#if MK_LAUNCH_PER_PHASE
#ifdef DUMP_AFTER
    for (int p = 0; p <= DUMP_AFTER; ++p) { a.ph_lo = p; a.ph_hi = p + 1; a.coop = 0;
        hipLaunchKernelGGL(fwd_megakernel, dim3(grid), dim3(NTHR), LDS_BYTES, stream, a); }
    a.ph_lo = 99; a.ph_hi = 100; a.pad = DUMP_MIB;
    hipLaunchKernelGGL(fwd_megakernel, dim3(grid), dim3(NTHR), LDS_BYTES, stream, a);
#else
    for (int p = 0; p < N_PHASES; ++p) { a.ph_lo = p; a.ph_hi = p + 1; a.coop = 0;
        hipLaunchKernelGGL(fwd_megakernel, dim3(grid), dim3(NTHR), LDS_BYTES, stream, a); }
#endif
#else
    a.ph_lo = 0; a.ph_hi = N_PHASES; a.coop = 1;
    void* args[] = {&a};
    hipError_t e = hipLaunchCooperativeKernel((const void*)fwd_megakernel, dim3(grid), dim3(NTHR), args, LDS_BYTES, stream);
    if (e != hipSuccess) fprintf(stderr, "cooperative launch failed: %s (grid %d)\n", hipGetErrorString(e), grid);
#endif
}
```

```cpp
#include <hip/hip_runtime.h>
#include <hip/hip_cooperative_groups.h>
#include <cstdio>
#include <cstdint>
namespace cg = cooperative_groups;

#ifndef PROBE_MIX_REPS
#define PROBE_MIX_REPS 1
#endif
#ifndef PROBE_G4_REPS
#define PROBE_G4_REPS 1
#endif
#ifndef PROBE_G2_REPS
#define PROBE_G2_REPS 1
#endif
#ifndef MK_LAUNCH_PER_PHASE
#define MK_LAUNCH_PER_PHASE 0
#endif

#define LAS __attribute__((address_space(3)))
typedef unsigned short bf16_t;
typedef short bf16x8 __attribute__((ext_vector_type(8)));
typedef short s16x4 __attribute__((ext_vector_type(4)));
typedef float f32x4 __attribute__((ext_vector_type(4)));
typedef unsigned u32x4 __attribute__((ext_vector_type(4)));
typedef unsigned u32x2 __attribute__((ext_vector_type(2)));

constexpr int M_TOK = 49152, M_PROMPT = 32768, DM = 1024, DIN = 2048, DFF = 2816, NFI = 5632, DEPTH = 2;
constexpr int NWAVES = 8, NTHR = 512;
constexpr float EPS = 1e-6f;
constexpr float LOG2E = 1.4426950408889634f;

constexpr size_t MiB = 1u << 20;
constexpr size_t W_IN = 0, W_G = 4 * MiB, W_B = 12 * MiB, W_OUT = 14 * MiB, W_FI = 16 * MiB, W_FO = 27 * MiB, W_SG = 32 * MiB + 512 * 1024, W_PW = W_SG + 128 * 1024, W_LAYER = 33 * MiB;
constexpr size_t WS_W = 0, WS_H = 66 * MiB, WS_Z = 162 * MiB, WS_BR = 354 * MiB, WS_X = 450 * MiB, WS_END = 546 * MiB;
constexpr size_t WS_MERGED = WS_Z, WS_SCR = WS_Z + 96 * MiB, WS_Y = WS_Z + 96 * MiB, WS_ACT = WS_Z;
constexpr size_t SCR_PER_CU = 256 * 1024;

typedef float f32x2_t __attribute__((ext_vector_type(2))); typedef __bf16 bf16x2_t __attribute__((ext_vector_type(2)));
__device__ __forceinline__ unsigned cvt_pk_bf16(float lo, float hi) { f32x2_t v = {lo, hi}; bf16x2_t b = __builtin_convertvector(v, bf16x2_t); return __builtin_bit_cast(unsigned, b); }
__device__ __forceinline__ float bflo(unsigned w) { return __uint_as_float(w << 16); }
__device__ __forceinline__ float bfhi(unsigned w) { return __uint_as_float(w & 0xffff0000u); }
__device__ __forceinline__ float wave_sum(float v) {
#pragma unroll
    for (int o = 1; o < 64; o <<= 1) v += __shfl_xor(v, o);
    return v;
}
__device__ __forceinline__ float sigmoidf_(float x) { return __builtin_amdgcn_rcpf(1.0f + __builtin_amdgcn_exp2f(-x * LOG2E)); }
__device__ __forceinline__ void seq_bounds(int row, int& s0, int& s1) { if (row < M_PROMPT) { s0 = row & ~4095; s1 = s0 + 4096; } else { s0 = M_PROMPT; s1 = M_TOK; } }
__device__ __forceinline__ s16x4 tr_read(const LAS unsigned char* p) { return __builtin_bit_cast(s16x4, __builtin_amdgcn_ds_read_tr16_b64_v4i16((LAS s16x4*)p)); }

namespace gm {
constexpr int BM = 256, BK = 64, HALF = 128, HTB = HALF * BK * 2, STAGE_BYTES = 8 * HTB, NXCD = 8, WGM = 8;
__host__ __device__ __forceinline__ int lds_byte(int r, int c) { const int st = (r >> 4) * 2 + (c >> 5), rr = r & 15, cc = c & 31, ob = rr * 64 + cc * 2; return st * 1024 + (ob ^ (((ob >> 9) & 1) << 5)); }
__host__ __device__ __forceinline__ void stage_rc(int b, int& R, int& C) { const int st = b / 1024, sb = b % 1024, swz = sb ^ (((sb >> 9) & 1) << 5); R = (st >> 1) * 16 + swz / 64; C = (st & 1) * 32 + (swz % 64) / 2; }
__host__ __device__ __forceinline__ int perm32(int rho) { const int n = rho >> 4, i = rho & 15; return 8 * (i >> 2) + 4 * n + (i & 3); }

struct Unit { const char* A; const char* B; int nt, pm, pn, tag; };

__device__ __forceinline__ void tile_of(int L, int nM, int nN, int& pm, int& pn) {
    const int nwg = nM * nN; int wgid = L;
    { const int q = nwg / NXCD, r = nwg % NXCD, xcd = wgid % NXCD, off = wgid / NXCD; wgid = (xcd < r ? xcd * (q + 1) : r * (q + 1) + (xcd - r) * q) + off; }
    const int nig = WGM * nN, gid = wgid / nig, fm = gid * WGM, gsz = (nM - fm) < WGM ? (nM - fm) : WGM;
    pm = fm + ((wgid % nig) % gsz); pn = (wgid % nig) / gsz;
}
struct SchedPlain {
    const bf16_t* A; const bf16_t* B; int pitch, nM, nN, nt, G, c;
    __device__ __forceinline__ bool next(int i, Unit& u) const {
        const int L = i * G + c; if (L >= nM * nN) return false;
        tile_of(L, nM, nN, u.pm, u.pn);
        u.A = (const char*)(A + (size_t)u.pm * BM * pitch); u.B = (const char*)(B + (size_t)u.pn * BM * pitch); u.nt = nt; u.tag = 0; return true;
    }
};
struct SchedGate {
    const bf16_t* H; const bf16_t* BR; const bf16_t* WG; const bf16_t* WB; int nM, nN, G, c;
    __device__ __forceinline__ bool next(int i, Unit& u) const {
        const int ti = i >> 3, sub = i & 7; const int L = ti * G + c; if (L >= nM * nN) return false;
        tile_of(L, nM, nN, u.pm, u.pn);
        const int b = sub >> 1; u.tag = sub;
        if ((sub & 1) == 0) { u.A = (const char*)(H + (size_t)u.pm * BM * DM); u.B = (const char*)(WG + (size_t)b * DM * DM + (size_t)u.pn * BM * DM); u.nt = 16; }
        else { u.A = (const char*)(BR + (size_t)u.pm * BM * DM + 256 * b); u.B = (const char*)(WB + (size_t)u.pn * BM * DM + 256 * b); u.nt = 4; }
        return true;
    }
};

struct EpiStoreBf16 {
    bf16_t* O; int ldc;
    __device__ __forceinline__ void operator()(const f32x4 (&acc)[2][2][4][2], const Unit& u, int wr, int wc, int fr, int fq) const {
        const int row0 = u.pm * BM + wr * 64 + fr, col0 = u.pn * BM + wc * 32 + 8 * fq;
#pragma unroll
        for (int ai = 0; ai < 2; ++ai)
#pragma unroll
            for (int m = 0; m < 4; ++m) { bf16_t* rowp = O + (size_t)(row0 + ai * HALF + m * 16) * ldc + col0;
#pragma unroll
                for (int bj = 0; bj < 2; ++bj) { const f32x4 v0 = acc[ai][bj][m][0], v1 = acc[ai][bj][m][1];
                    u32x4 w; w.x = cvt_pk_bf16(v0[0], v0[1]); w.y = cvt_pk_bf16(v0[2], v0[3]); w.z = cvt_pk_bf16(v1[0], v1[1]); w.w = cvt_pk_bf16(v1[2], v1[3]);
                    *(u32x4*)(rowp + bj * HALF) = w; } }
    }
};
struct EpiSwiGLU {
    bf16_t* O;
    __device__ __forceinline__ void operator()(const f32x4 (&acc)[2][2][4][2], const Unit& u, int wr, int wc, int fr, int fq) const {
        const int row0 = u.pm * BM + wr * 64 + fr, col0 = u.pn * 128 + wc * 16 + 4 * fq;
#pragma unroll
        for (int ai = 0; ai < 2; ++ai)
#pragma unroll
            for (int m = 0; m < 4; ++m) { bf16_t* rowp = O + (size_t)(row0 + ai * HALF + m * 16) * DFF + col0;
#pragma unroll
                for (int bj = 0; bj < 2; ++bj) { const f32x4 a = acc[ai][bj][m][0], g = acc[ai][bj][m][1]; f32x4 o;
#pragma unroll
                    for (int e = 0; e < 4; ++e) o[e] = a[e] * sigmoidf_(a[e]) * g[e];
                    u32x2 w; w.x = cvt_pk_bf16(o[0], o[1]); w.y = cvt_pk_bf16(o[2], o[3]);
                    *(u32x2*)(rowp + bj * 64) = w; } }
    }
};
#define GAS __attribute__((address_space(1)))
struct EpiGate {
    const float* bgate; bf16_t* O; GAS unsigned char* gsc; GAS unsigned char* msc;
    __device__ __forceinline__ void operator()(const f32x4 (&acc)[2][2][4][2], const Unit& u, int wr, int wc, int fr, int fq) const {
        const int tid = threadIdx.x; const int b = u.tag >> 1, kind = u.tag & 1;
        const int row0 = u.pm * BM + wr * 64 + fr, col0 = u.pn * BM + wc * 32 + 8 * fq;
        unsigned off = (unsigned)tid * 32u;
        if (kind == 0) {
            f32x4 bv[2][2];
#pragma unroll
            for (int bj = 0; bj < 2; ++bj)
#pragma unroll
                for (int n = 0; n < 2; ++n) bv[bj][n] = *(const f32x4*)(bgate + b * DM + col0 + bj * HALF + 4 * n);
#pragma unroll
            for (int ai = 0; ai < 2; ++ai)
#pragma unroll
                for (int m = 0; m < 4; ++m) {
                    asm volatile("" : "+v"(off));
#pragma unroll
                    for (int bj = 0; bj < 2; ++bj) { const f32x4 v0 = acc[ai][bj][m][0] + bv[bj][0], v1 = acc[ai][bj][m][1] + bv[bj][1];
                        u32x4 w; w.x = cvt_pk_bf16(sigmoidf_(v0[0]), sigmoidf_(v0[1])); w.y = cvt_pk_bf16(sigmoidf_(v0[2]), sigmoidf_(v0[3]));
                        w.z = cvt_pk_bf16(sigmoidf_(v1[0]), sigmoidf_(v1[1])); w.w = cvt_pk_bf16(sigmoidf_(v1[2]), sigmoidf_(v1[3]));
                        *(GAS u32x4*)(gsc + off + bj * 16) = w; }
                    off += 16384u; }
        } else {
#pragma unroll
            for (int ai = 0; ai < 2; ++ai) {
                asm volatile("" : "+v"(off));
                u32x4 gw[4][2], mw[4][2];
#pragma unroll
                for (int m = 0; m < 4; ++m)
#pragma unroll
                    for (int bj = 0; bj < 2; ++bj) gw[m][bj] = *(const GAS u32x4*)(gsc + off + m * 16384 + bj * 16);
                if (b != 0) {
#pragma unroll
                    for (int m = 0; m < 4; ++m)
#pragma unroll
                        for (int bj = 0; bj < 2; ++bj) mw[m][bj] = *(const GAS u32x4*)(msc + off + m * 16384 + bj * 16);
                } else {
#pragma unroll
                    for (int m = 0; m < 4; ++m)
#pragma unroll
                        for (int bj = 0; bj < 2; ++bj) mw[m][bj] = (u32x4){0u, 0u, 0u, 0u};
                }
#pragma unroll
                for (int m = 0; m < 4; ++m) { bf16_t* rowp = O + (size_t)(row0 + ai * HALF + m * 16) * DM + col0;
#pragma unroll
                    for (int bj = 0; bj < 2; ++bj) { const u32x4 g = gw[m][bj], q = mw[m][bj];
                        const f32x4 a0 = acc[ai][bj][m][0], a1 = acc[ai][bj][m][1];
                        u32x4 w;
                        w.x = cvt_pk_bf16(bflo(g.x) * a0[0] + bflo(q.x), bfhi(g.x) * a0[1] + bfhi(q.x)); w.y = cvt_pk_bf16(bflo(g.y) * a0[2] + bflo(q.y), bfhi(g.y) * a0[3] + bfhi(q.y));
                        w.z = cvt_pk_bf16(bflo(g.z) * a1[0] + bflo(q.z), bfhi(g.z) * a1[1] + bfhi(q.z)); w.w = cvt_pk_bf16(bflo(g.w) * a1[2] + bflo(q.w), bfhi(g.w) * a1[3] + bfhi(q.w));
                        if (b != 3) *(GAS u32x4*)(msc + off + m * 16384 + bj * 16) = w;
                        else *(u32x4*)(rowp + bj * HALF) = w; } }
                off += 65536u; }
        }
    }
};

template <bool PERM, class Sched, class Epi>
__device__ __forceinline__ void gemm_phase(LAS unsigned char* lds, const int K, const Sched& S, const Epi& E) {
    int tid_ = threadIdx.x; asm volatile("" : "+v"(tid_));
    const int tid = tid_, wid = __builtin_amdgcn_readfirstlane(tid >> 6), lane = tid & 63, wr = wid >> 2, wc = wid & 3, fr = lane & 15, fq = lane >> 4;
    unsigned voffA[2], voffB[2];
#pragma unroll
    for (int i = 0; i < 2; ++i) { int R, C; stage_rc(tid * 16 + i * 8192, R, C); const int Rb = PERM ? ((R & ~31) + perm32(R & 31)) : R;
        voffA[i] = (unsigned)(R * K + C) * 2u; voffB[i] = (unsigned)(Rb * K + C) * 2u; }
    const size_t kstep = (size_t)(BK * 2);
    const size_t hstep = (size_t)HALF * K * 2;
    const unsigned ldsw = (unsigned)wid * 1024u;
    const int aoff = lds_byte(wr * 64 + fr, fq * 8), boff = lds_byte(wc * 32 + fr, fq * 8);
#define PG8_SA(b, h) (((b) * 2 + (h)) * HTB)
#define PG8_SB(b, h) ((4 + (b) * 2 + (h)) * HTB)
#define PG8_STAGE(bufoff, gbase, voff) do { _Pragma("unroll") for (int _i = 0; _i < 2; ++_i) \
        __builtin_amdgcn_global_load_lds((const unsigned*)((const char*)(gbase) + (voff)[_i]), (LAS unsigned*)(lds + (bufoff) + ldsw + _i * 8192), 16, 0, 0); } while (0)
#define PG8_LDA(dst, b, h) do { _Pragma("unroll") for (int m = 0; m < 4; ++m) _Pragma("unroll") for (int k = 0; k < 2; ++k) dst[m][k] = *(const LAS bf16x8*)(lds + PG8_SA(b, h) + aoff + m * 2048 + k * 1024); } while (0)
#define PG8_LDB(dst, b, h) do { _Pragma("unroll") for (int n = 0; n < 2; ++n) _Pragma("unroll") for (int k = 0; k < 2; ++k) dst[n][k] = *(const LAS bf16x8*)(lds + PG8_SB(b, h) + boff + n * 2048 + k * 1024); } while (0)
#define PG8_MMA(ai, bj, At, Bt) do { __builtin_amdgcn_s_setprio(1); _Pragma("unroll") for (int m = 0; m < 4; ++m) _Pragma("unroll") for (int n = 0; n < 2; ++n) _Pragma("unroll") for (int k = 0; k < 2; ++k) \
        acc[ai][bj][m][n] = __builtin_amdgcn_mfma_f32_16x16x32_bf16(Bt[n][k], At[m][k], acc[ai][bj][m][n], 0, 0, 0); __builtin_amdgcn_s_setprio(0); } while (0)
#define PG8_WAIT_V(n) asm volatile("s_waitcnt vmcnt(" #n ")" ::: "memory")
#define PG8_WAIT_L(n) asm volatile("s_waitcnt lgkmcnt(" #n ")" ::: "memory")
#define PG8_BAR __builtin_amdgcn_s_barrier()
#define PG8_SCHED __builtin_amdgcn_sched_barrier(0)
    Unit cur, nxt; int ui = 0;
    if (!S.next(0, cur)) return;
    f32x4 acc[2][2][4][2];
#pragma unroll
    for (int a = 0; a < 2; ++a)
#pragma unroll
        for (int b = 0; b < 2; ++b)
#pragma unroll
            for (int m = 0; m < 4; ++m)
#pragma unroll
                for (int n = 0; n < 2; ++n) acc[a][b][m][n] = (f32x4){0.f, 0.f, 0.f, 0.f};
    bf16x8 At[4][2], B0[2][2], B1[2][2];
    const char* cA = cur.A; const char* cB = cur.B;
    PG8_STAGE(PG8_SB(0, 0), cB, voffB); PG8_STAGE(PG8_SB(0, 1), cB + hstep, voffB); PG8_STAGE(PG8_SA(0, 0), cA, voffA); PG8_STAGE(PG8_SA(0, 1), cA + hstep, voffA);
    if (wr == 1) PG8_BAR;
    PG8_WAIT_V(2); PG8_BAR;
    PG8_STAGE(PG8_SB(1, 0), cB + kstep, voffB); PG8_STAGE(PG8_SA(1, 0), cA + kstep, voffA); PG8_STAGE(PG8_SB(1, 1), cB + hstep + kstep, voffB);
    PG8_WAIT_V(6); PG8_BAR;
    for (;;) {
        const bool has_next = S.next(ui + 1, nxt);
        const char* nA = has_next ? nxt.A : cA; const char* nB = has_next ? nxt.B : cB;
        const int nt = cur.nt;
        for (int t = 0; t < nt; t += 2) {
            const bool last = (t == nt - 2);
            const char* a1 = cA + (size_t)(t + 1) * kstep;
            const char* a2 = last ? nA : cA + (size_t)(t + 2) * kstep; const char* b2 = last ? nB : cB + (size_t)(t + 2) * kstep;
            const char* a3 = a2 + kstep; const char* b3 = b2 + kstep;
            PG8_LDB(B0, 0, 0); PG8_LDB(B1, 0, 1); PG8_SCHED; PG8_LDA(At, 0, 0); PG8_STAGE(PG8_SA(1, 1), a1 + hstep, voffA);
            PG8_WAIT_V(8); PG8_WAIT_L(0); PG8_BAR; PG8_MMA(0, 0, At, B0); PG8_MMA(0, 1, At, B1); PG8_BAR; PG8_SCHED;
            PG8_LDA(At, 0, 1); PG8_STAGE(PG8_SB(0, 0), b2, voffB); PG8_STAGE(PG8_SB(0, 1), b2 + hstep, voffB); PG8_STAGE(PG8_SA(0, 0), a2, voffA);
            PG8_WAIT_V(8); PG8_WAIT_L(0); PG8_BAR; PG8_MMA(1, 0, At, B0); PG8_MMA(1, 1, At, B1); PG8_BAR; PG8_SCHED;
            PG8_LDB(B0, 1, 0); PG8_LDB(B1, 1, 1); PG8_SCHED; PG8_LDA(At, 1, 0); PG8_STAGE(PG8_SA(0, 1), a2 + hstep, voffA);
            PG8_WAIT_V(8); PG8_WAIT_L(0); PG8_BAR; PG8_MMA(0, 0, At, B0); PG8_MMA(0, 1, At, B1); PG8_BAR; PG8_SCHED;
            PG8_LDA(At, 1, 1); PG8_STAGE(PG8_SB(1, 0), b3, voffB); PG8_STAGE(PG8_SB(1, 1), b3 + hstep, voffB); PG8_STAGE(PG8_SA(1, 0), a3, voffA);
            PG8_WAIT_V(8); PG8_WAIT_L(0); PG8_BAR; PG8_MMA(1, 0, At, B0); PG8_MMA(1, 1, At, B1); PG8_BAR; PG8_SCHED;
        }
        if (wr == 0) PG8_BAR;
        E(acc, cur, wr, wc, fr, fq);
        if (!has_next) break;
#pragma unroll
        for (int a = 0; a < 2; ++a)
#pragma unroll
            for (int b = 0; b < 2; ++b)
#pragma unroll
                for (int m = 0; m < 4; ++m)
#pragma unroll
                    for (int n = 0; n < 2; ++n) acc[a][b][m][n] = (f32x4){0.f, 0.f, 0.f, 0.f};
        cur = nxt; cA = nA; cB = nB; ++ui;
        if (wr == 1) PG8_BAR;
    }
    PG8_WAIT_V(0);
    PG8_BAR;
#undef PG8_SA
#undef PG8_SB
#undef PG8_STAGE
#undef PG8_LDA
#undef PG8_LDB
#undef PG8_MMA
#undef PG8_WAIT_V
#undef PG8_WAIT_L
#undef PG8_BAR
#undef PG8_SCHED
}
}

struct Args {
    const float* x_prompt; const float* x_sample; const float* norm_mix_pre; const float* norm_mix_post; const float* norm_ffn_pre; const float* norm_ffn_post;
    const float* w_in; const float* conv_w; const float* pool_w; const float* pool_scale; const float* sg_norm; const float* sg_w; const float* sg_b; const float* attn_sink;
    const float* w_branch; const float* w_gate; const float* b_gate; const float* w_out; const float* w_ffn_in; const float* w_ffn_out;
    float* out; unsigned char* ws; int ph_lo, ph_hi, coop, pad;
};

template <int MODE>
__device__ __forceinline__ void transpose_item(const float* W, int ldw, int N, bf16_t* WT, int ldt, LAS float* scr, int item, int lane) {
    const int nblk = N / 32, kb = item / nblk, nb = item % nblk, k0 = 64 * kb, n0 = 32 * nb;
#pragma unroll 8
    for (int i = 0; i < 32; ++i) { const int kk = 2 * i + (lane >> 5); scr[kk * 33 + (lane & 31)] = W[(size_t)(k0 + kk) * ldw + n0 + (lane & 31)]; }
    asm volatile("s_waitcnt lgkmcnt(0)" ::: "memory");
    const int c = lane & 7;
#pragma unroll
    for (int j = 0; j < 4; ++j) { const int n = (lane >> 3) + 8 * j; const LAS float* s = scr + (8 * c) * 33 + n;
        u32x4 o; o.x = cvt_pk_bf16(s[0 * 33], s[1 * 33]); o.y = cvt_pk_bf16(s[2 * 33], s[3 * 33]); o.z = cvt_pk_bf16(s[4 * 33], s[5 * 33]); o.w = cvt_pk_bf16(s[6 * 33], s[7 * 33]);
        int drow = n0 + n;
        if (MODE == 1) { const int sc = n0 + n, isg = sc >= DFF ? 1 : 0, f = sc - isg * DFF; drow = 256 * (f >> 7) + 128 * ((f >> 6) & 1) + 32 * ((f >> 4) & 3) + 16 * isg + (f & 15); }
        *(u32x4*)(WT + (size_t)drow * ldt + k0 + 8 * c) = o; }
    asm volatile("s_waitcnt lgkmcnt(0)" ::: "memory");
}

__device__ __forceinline__ void phase_prologue(const Args& a, LAS unsigned char* lds, int wid, int lane) {
    LAS float* scr = (LAS float*)(lds + wid * 16384);
    const int gw = blockIdx.x * NWAVES + wid, NGW = gridDim.x * NWAVES;
    constexpr int I_IN = 16 * 64, I_G = 16 * 32, I_B = 16 * 32, I_O = 16 * 32, I_FI = 16 * 176, I_FO = 44 * 32, I_PW = 2;
    constexpr int I_LAYER = I_IN + 4 * I_G + I_B + I_O + I_FI + I_FO + 4 * I_PW;
    for (int it = gw; it < DEPTH * I_LAYER; it += NGW) {
        const int l = it / I_LAYER; int r = it % I_LAYER;
        unsigned char* wl = a.ws + WS_W + (size_t)l * W_LAYER;
        if (r < I_IN) { transpose_item<0>(a.w_in + (size_t)l * DM * DIN, DIN, DIN, (bf16_t*)(wl + W_IN), DM, scr, r, lane); continue; } r -= I_IN;
        if (r < 4 * I_G) { const int b = r / I_G; transpose_item<0>(a.w_gate + ((size_t)l * 4 + b) * DM * DM, DM, DM, (bf16_t*)(wl + W_G) + (size_t)b * DM * DM, DM, scr, r % I_G, lane); continue; } r -= 4 * I_G;
        if (r < I_B) { transpose_item<0>(a.w_branch + (size_t)l * DM * DM, DM, DM, (bf16_t*)(wl + W_B), DM, scr, r, lane); continue; } r -= I_B;
        if (r < I_O) { transpose_item<0>(a.w_out + (size_t)l * DM * DM, DM, DM, (bf16_t*)(wl + W_OUT), DM, scr, r, lane); continue; } r -= I_O;
        if (r < I_FI) { transpose_item<1>(a.w_ffn_in + (size_t)l * DM * NFI, NFI, NFI, (bf16_t*)(wl + W_FI), DM, scr, r, lane); continue; } r -= I_FI;
        if (r < I_FO) { transpose_item<0>(a.w_ffn_out + (size_t)l * DFF * DM, DM, DM, (bf16_t*)(wl + W_FO), DFF, scr, r, lane); continue; } r -= I_FO;
        { const int g = r / I_PW; transpose_item<0>(a.pool_w + ((size_t)l * 4 + g) * 4096, 64, 64, (bf16_t*)(wl + W_PW) + g * 4096, 64, scr, r % I_PW, lane); }
    }
    const int gt = blockIdx.x * NTHR + threadIdx.x, NGT = gridDim.x * NTHR;
    for (int i = gt; i < DEPTH * 65536 / 4; i += NGT) { const int l = (i * 4) / 65536, o = (i * 4) % 65536;
        const f32x4 v = *(const f32x4*)(a.sg_w + (size_t)l * 65536 + o); u32x2 w; w.x = cvt_pk_bf16(v[0], v[1]); w.y = cvt_pk_bf16(v[2], v[3]);
        *(u32x2*)((bf16_t*)(a.ws + WS_W + (size_t)l * W_LAYER + W_SG) + o) = w; }
    bf16_t* H = (bf16_t*)(a.ws + WS_H);
    for (int row = gw; row < M_TOK; row += NGW) {
        const float* xr = row < M_PROMPT ? a.x_prompt + (size_t)row * DM : a.x_sample + (size_t)(row - M_PROMPT) * DM;
        f32x4 v[4]; float ss = 0.f;
#pragma unroll
        for (int j = 0; j < 4; ++j) { v[j] = ((const f32x4*)xr)[lane + 64 * j]; ss += (v[j][0] * v[j][0] + v[j][1] * v[j][1]) + (v[j][2] * v[j][2] + v[j][3] * v[j][3]); }
        const float rstd = __builtin_amdgcn_rsqf(wave_sum(ss) * (1.f / DM) + EPS);
#pragma unroll
        for (int j = 0; j < 4; ++j) { const f32x4 g = ((const f32x4*)a.norm_mix_pre)[lane + 64 * j]; u32x2 w; w.x = cvt_pk_bf16(v[j][0] * rstd * g[0], v[j][1] * rstd * g[1]); w.y = cvt_pk_bf16(v[j][2] * rstd * g[2], v[j][3] * rstd * g[3]);
            ((u32x2*)(H + (size_t)row * DM))[lane + 64 * j] = w; }
    }
}

__device__ __forceinline__ void phase_resnorm(const Args& a, const bf16_t* Y, const float* gpost, const float* gnext, bool first_x, bool last_x, bf16_t* X, bf16_t* H, int wid, int lane) {
    const int gw = blockIdx.x * NWAVES + wid, NGW = gridDim.x * NWAVES;
    constexpr int RB = 3;
    for (int row0 = gw; row0 < M_TOK; row0 += RB * NGW) {
        f32x4 xv[RB][4], yv[RB][4]; float ss[RB];
#pragma unroll
        for (int r = 0; r < RB; ++r) { const int row = min(row0 + r * NGW, M_TOK - 1); ss[r] = 0.f;
#pragma unroll
            for (int j = 0; j < 4; ++j) { const u32x2 w = ((const u32x2*)(Y + (size_t)row * DM))[lane + 64 * j]; yv[r][j] = (f32x4){bflo(w.x), bfhi(w.x), bflo(w.y), bfhi(w.y)}; }
            if (first_x) { const float* xr = row < M_PROMPT ? a.x_prompt + (size_t)row * DM : a.x_sample + (size_t)(row - M_PROMPT) * DM;
#pragma unroll
                for (int j = 0; j < 4; ++j) xv[r][j] = ((const f32x4*)xr)[lane + 64 * j];
            } else {
#pragma unroll
                for (int j = 0; j < 4; ++j) { const u32x2 w = ((const u32x2*)(X + (size_t)row * DM))[lane + 64 * j]; xv[r][j] = (f32x4){bflo(w.x), bfhi(w.x), bflo(w.y), bfhi(w.y)}; }
            } }
#pragma unroll
        for (int r = 0; r < RB; ++r) { const int row = row0 + r * NGW; if (row >= M_TOK) break;
#pragma unroll
            for (int j = 0; j < 4; ++j) ss[r] += (yv[r][j][0] * yv[r][j][0] + yv[r][j][1] * yv[r][j][1]) + (yv[r][j][2] * yv[r][j][2] + yv[r][j][3] * yv[r][j][3]);
            const float rstd = __builtin_amdgcn_rsqf(wave_sum(ss[r]) * (1.f / DM) + EPS);
            float sx = 0.f;
#pragma unroll
            for (int j = 0; j < 4; ++j) { const f32x4 g = ((const f32x4*)gpost)[lane + 64 * j]; xv[r][j] = xv[r][j] + yv[r][j] * rstd * g;
                sx += (xv[r][j][0] * xv[r][j][0] + xv[r][j][1] * xv[r][j][1]) + (xv[r][j][2] * xv[r][j][2] + xv[r][j][3] * xv[r][j][3]); }
            if (last_x) {
#pragma unroll
                for (int j = 0; j < 4; ++j) ((f32x4*)(a.out + (size_t)row * DM))[lane + 64 * j] = xv[r][j];
            } else {
#pragma unroll
                for (int j = 0; j < 4; ++j) { u32x2 w; w.x = cvt_pk_bf16(xv[r][j][0], xv[r][j][1]); w.y = cvt_pk_bf16(xv[r][j][2], xv[r][j][3]); ((u32x2*)(X + (size_t)row * DM))[lane + 64 * j] = w; }
            }
            if (gnext) {
                const float rx = __builtin_amdgcn_rsqf(wave_sum(sx) * (1.f / DM) + EPS);
#pragma unroll
                for (int j = 0; j < 4; ++j) { const f32x4 g = ((const f32x4*)gnext)[lane + 64 * j]; u32x2 w; w.x = cvt_pk_bf16(xv[r][j][0] * rx * g[0], xv[r][j][1] * rx * g[1]); w.y = cvt_pk_bf16(xv[r][j][2] * rx * g[2], xv[r][j][3] * rx * g[3]);
                    ((u32x2*)(H + (size_t)row * DM))[lane + 64 * j] = w; }
            }
        }
    }
}

template <int GI>
__device__ __forceinline__ void pool_group(const bf16_t* Z, bf16_t* BR, const bf16_t* pwT, const float* pool_scale, int row, int s0, int s1, int fr, int fq) {
    constexpr int half = 1 << GI, W = 2 * half;
    const int lo = max(row - half, s0), hi = min(row + half, s1); const float inv = 1.0f / (float)(hi - lo);
    f32x4 acc[4];
#pragma unroll
    for (int d = 0; d < 4; ++d) acc[d] = (f32x4){0.f, 0.f, 0.f, 0.f};
#pragma unroll
    for (int kk = 0; kk < 2; ++kk) {
        const int c = 768 + 64 * GI + 32 * kk + 8 * fq;
        u32x4 v[W];
#pragma unroll
        for (int i = 0; i < W; ++i) { const int r2 = row - half + i; const int rc = min(max(r2, s0), s1 - 1); v[i] = *(const u32x4*)(Z + (size_t)rc * DIN + c); }
        float s[8];
#pragma unroll
        for (int j = 0; j < 8; ++j) s[j] = 0.f;
#pragma unroll
        for (int i = 0; i < W; ++i) { const int r2 = row - half + i; const float mk = (r2 >= s0 && r2 < s1) ? 1.f : 0.f;
#pragma unroll
            for (int q = 0; q < 4; ++q) { s[2 * q] += mk * bflo(v[i][q]); s[2 * q + 1] += mk * bfhi(v[i][q]); } }
        const u32x4 sv = v[half];
        u32x4 pw;
#pragma unroll
        for (int q = 0; q < 4; ++q) pw[q] = cvt_pk_bf16(s[2 * q] * inv - bflo(sv[q]), s[2 * q + 1] * inv - bfhi(sv[q]));
        const bf16x8 bfrag = __builtin_bit_cast(bf16x8, pw);
#pragma unroll
        for (int d = 0; d < 4; ++d) { const bf16x8 afrag = *(const bf16x8*)(pwT + GI * 4096 + (16 * d + fr) * 64 + 32 * kk + 8 * fq);
            acc[d] = __builtin_amdgcn_mfma_f32_16x16x32_bf16(afrag, bfrag, acc[d], 0, 0, 0); }
        __builtin_amdgcn_sched_barrier(0);
    }
#pragma unroll
    for (int d = 0; d < 4; ++d) { const int dc = 64 * GI + 16 * d + 4 * fq; const f32x4 sc = *(const f32x4*)(pool_scale + dc);
        u32x2 w; w.x = cvt_pk_bf16(acc[d][0] * sc[0], acc[d][1] * sc[1]); w.y = cvt_pk_bf16(acc[d][2] * sc[2], acc[d][3] * sc[3]);
        *(u32x2*)(BR + (size_t)row * DM + 256 + dc) = w; }
    __builtin_amdgcn_sched_barrier(0);
}
__device__ __forceinline__ void mixer_conv_pool(const bf16_t* Z, bf16_t* BR, const float* conv_w, const bf16_t* pwT, const float* pool_scale, int row0, int wid, int lane) {
    int s0, s1; seq_bounds(row0, s0, s1);
    const int tid = threadIdx.x;
#pragma unroll 1
    for (int k = 0; k < 8; ++k) { const int it = tid + k * NTHR;
        const int t = it >> 5, c8 = (it & 31) * 8, row = row0 + t;
        const int rm = max(row - 1, s0), rp = min(row + 1, s1 - 1); const float m0 = (row - 1 >= s0) ? 1.f : 0.f, m2 = (row + 1 < s1) ? 1.f : 0.f;
        const u32x4 bg = *(const u32x4*)(Z + (size_t)row * DIN + c8);
        u32x4 cg[3], xv[3];
        cg[0] = *(const u32x4*)(Z + (size_t)rm * DIN + 256 + c8); xv[0] = *(const u32x4*)(Z + (size_t)rm * DIN + 512 + c8);
        cg[1] = *(const u32x4*)(Z + (size_t)row * DIN + 256 + c8); xv[1] = *(const u32x4*)(Z + (size_t)row * DIN + 512 + c8);
        cg[2] = *(const u32x4*)(Z + (size_t)rp * DIN + 256 + c8); xv[2] = *(const u32x4*)(Z + (size_t)rp * DIN + 512 + c8);
        float cv[8];
#pragma unroll
        for (int j = 0; j < 8; ++j) cv[j] = 0.f;
#pragma unroll
        for (int d = 0; d < 3; ++d) { const float mk = d == 0 ? m0 : (d == 2 ? m2 : 1.f);
            const f32x4 w0 = *(const f32x4*)(conv_w + d * 256 + c8) * mk, w1 = *(const f32x4*)(conv_w + d * 256 + c8 + 4) * mk;
#pragma unroll
            for (int q = 0; q < 4; ++q) { cv[2 * q] += (q < 2 ? w0[2 * q] : w1[2 * q - 4]) * bflo(cg[d][q]) * bflo(xv[d][q]); cv[2 * q + 1] += (q < 2 ? w0[2 * q + 1] : w1[2 * q - 3]) * bfhi(cg[d][q]) * bfhi(xv[d][q]); } }
        u32x4 o;
#pragma unroll
        for (int q = 0; q < 4; ++q) o[q] = cvt_pk_bf16(bflo(bg[q]) * cv[2 * q], bfhi(bg[q]) * cv[2 * q + 1]);
        *(u32x4*)(BR + (size_t)row * DM + c8) = o;
    }
    const int fr = lane & 15, fq = lane >> 4; const int row = row0 + 16 * wid + fr;
    pool_group<0>(Z, BR, pwT, pool_scale, row, s0, s1, fr, fq);
    pool_group<1>(Z, BR, pwT, pool_scale, row, s0, s1, fr, fq);
    pool_group<2>(Z, BR, pwT, pool_scale, row, s0, s1, fr, fq);
    pool_group<3>(Z, BR, pwT, pool_scale, row, s0, s1, fr, fq);
}

constexpr int VLN_PITCH = 264;
__device__ __forceinline__ void mixer_spatial(const bf16_t* Z, bf16_t* BR, const float* sg_norm, const bf16_t* sgw, const float* sg_b, LAS unsigned char* lds, int row0, int wid, int lane) {
    const f32x4 gn = *(const f32x4*)(sg_norm + 4 * lane);
    u32x2 wv[16];
#pragma unroll
    for (int i = 0; i < 16; ++i) wv[i] = *(const u32x2*)(Z + (size_t)(row0 + 16 * wid + i) * DIN + 1280 + 4 * lane);
#pragma unroll
    for (int i = 0; i < 16; ++i) { const int t = 16 * wid + i; const u32x2 w = wv[i];
        f32x4 v = (f32x4){bflo(w.x), bfhi(w.x), bflo(w.y), bfhi(w.y)};
        const float mean = wave_sum((v[0] + v[1]) + (v[2] + v[3])) * (1.f / 256.f); v = v - mean;
        const float var = wave_sum((v[0] * v[0] + v[1] * v[1]) + (v[2] * v[2] + v[3] * v[3])) * (1.f / 256.f);
        const float rstd = __builtin_amdgcn_rsqf(var + EPS);
        u32x2 o; o.x = cvt_pk_bf16(v[0] * rstd * gn[0], v[1] * rstd * gn[1]); o.y = cvt_pk_bf16(v[2] * rstd * gn[2], v[3] * rstd * gn[3]);
        *(LAS u32x2*)(lds + (t * VLN_PITCH + 4 * lane) * 2) = o; }
    __syncthreads();
    const int fr = lane & 15, fq = lane >> 4, l16 = lane & 15, tq = l16 >> 2, tp = l16 & 3;
    const int t = 16 * wid + fr, row = row0 + t;
#pragma unroll 1
    for (int g = 0; g < 4; ++g) {
        bf16x8 wf[4];
#pragma unroll
        for (int kk = 0; kk < 4; ++kk) wf[kk] = *(const bf16x8*)(sgw + g * 16384 + t * 128 + 32 * kk + 8 * fq);
        const float bias = sg_b[g * 128 + t];
#pragma unroll
        for (int ct = 0; ct < 4; ++ct) { const int c0 = 64 * g + 16 * ct; f32x4 acc = (f32x4){0.f, 0.f, 0.f, 0.f};
#pragma unroll
            for (int kk = 0; kk < 4; ++kk) { const LAS unsigned char* p = lds + ((32 * kk + 8 * fq + tq) * VLN_PITCH + c0 + 4 * tp) * 2;
                const s16x4 lo = tr_read(p), hi = tr_read(p + 4 * VLN_PITCH * 2);
                const bf16x8 af = (bf16x8){lo[0], lo[1], lo[2], lo[3], hi[0], hi[1], hi[2], hi[3]};
                acc = __builtin_amdgcn_mfma_f32_16x16x32_bf16(af, wf[kk], acc, 0, 0, 0); }
            const u32x2 uw = *(const u32x2*)(Z + (size_t)row * DIN + 1024 + c0 + 4 * fq);
            u32x2 o; o.x = cvt_pk_bf16(bflo(uw.x) * (acc[0] + bias), bfhi(uw.x) * (acc[1] + bias)); o.y = cvt_pk_bf16(bflo(uw.y) * (acc[2] + bias), bfhi(uw.y) * (acc[3] + bias));
            *(u32x2*)(BR + (size_t)row * DM + 512 + c0 + 4 * fq) = o; }
    }
    __syncthreads();
}

constexpr int KV_PITCH = 72, KV_ROWS = 448, KV_BYTES = KV_ROWS * KV_PITCH * 2;
__device__ __forceinline__ void mixer_attn(const bf16_t* Z, bf16_t* BR, const float* sink, LAS unsigned char* lds, int row0, int kvh, int wid, int lane) {
    int s0, s1; seq_bounds(row0, s0, s1);
    const int tid = threadIdx.x;
    LAS unsigned char* Kl = lds; LAS unsigned char* Vl = lds + KV_BYTES;
    {   u32x4 kv[7], vv[7];
#pragma unroll
        for (int k = 0; k < 7; ++k) { const int it = tid + k * NTHR, r = it >> 3, c8 = (it & 7) * 8; const int grow = row0 - 144 + r, gc = min(max(grow, s0), s1 - 1);
            kv[k] = *(const u32x4*)(Z + (size_t)gc * DIN + 1792 + kvh * 64 + c8); vv[k] = *(const u32x4*)(Z + (size_t)gc * DIN + 1920 + kvh * 64 + c8); }
#pragma unroll
        for (int k = 0; k < 7; ++k) { const int it = tid + k * NTHR, r = it >> 3, c8 = (it & 7) * 8; const int grow = row0 - 144 + r; const bool ok = grow >= s0 && grow < s1;
            const u32x4 z4 = (u32x4){0u, 0u, 0u, 0u};
            *(LAS u32x4*)(Kl + (r * KV_PITCH + c8) * 2) = ok ? kv[k] : z4; *(LAS u32x4*)(Vl + (r * KV_PITCH + c8) * 2) = ok ? vv[k] : z4; } }
    __syncthreads();
    const int fr = lane & 15, fq = lane >> 4, tq = fr >> 2, tp = fr & 3;
    const int qrow = row0 + 16 * wid + fr;
    float frel0 = (float)(fr + 144 - 4 * fq), frlo = (float)max(-128, qrow - s1 + 1), frhi = (float)min(128, qrow - s0);
#pragma unroll 1
    for (int g = 0; g < 2; ++g) {
        asm volatile("" : "+v"(frel0), "+v"(frlo), "+v"(frhi));
        const int hq = kvh * 2 + g;
        const float slope = __builtin_amdgcn_exp2f(-2.0f * (float)(hq + 1)) * LOG2E;
        const float sk = sink[hq] * LOG2E;
        bf16x8 qf[2];
#pragma unroll
        for (int kk = 0; kk < 2; ++kk) qf[kk] = *(const bf16x8*)(Z + (size_t)qrow * DIN + 1536 + hq * 64 + 32 * kk + 8 * fq);
        f32x4 sc[18];
#pragma unroll
        for (int kt = 0; kt < 18; ++kt) { f32x4 acc = (f32x4){0.f, 0.f, 0.f, 0.f};
#pragma unroll
            for (int kk = 0; kk < 2; ++kk) { const bf16x8 kf = *(const LAS bf16x8*)(Kl + ((16 * wid + 16 * kt + fr) * KV_PITCH + 32 * kk + 8 * fq) * 2);
                acc = __builtin_amdgcn_mfma_f32_16x16x32_bf16(kf, qf[kk], acc, 0, 0, 0); }
            sc[kt] = acc; if (kt & 1) __builtin_amdgcn_sched_barrier(0); }
        float mx = sk;
#pragma unroll
        for (int kt = 0; kt < 18; ++kt)
#pragma unroll
            for (int e = 0; e < 4; ++e) { const float t = frel0 - (float)(16 * kt + e);
                float v = __builtin_fmaf(__builtin_fabsf(t), -slope, sc[kt][e] * (0.125f * LOG2E));
                const float df = t - __builtin_amdgcn_fmed3f(t, frlo, frhi);
                v = __builtin_fmaf(__builtin_fabsf(df), -1e30f, v);
                sc[kt][e] = v; mx = fmaxf(mx, v); }
        mx = fmaxf(mx, __shfl_xor(mx, 16)); mx = fmaxf(mx, __shfl_xor(mx, 32));
        float sum = 0.f;
#pragma unroll
        for (int kt = 0; kt < 18; ++kt)
#pragma unroll
            for (int e = 0; e < 4; ++e) { const float p = __builtin_amdgcn_exp2f(sc[kt][e] - mx); sc[kt][e] = p; sum += p; }
        sum += __shfl_xor(sum, 16); sum += __shfl_xor(sum, 32);
        const float rden = __builtin_amdgcn_rcpf(sum + __builtin_amdgcn_exp2f(sk - mx));
        f32x4 o[4];
#pragma unroll
        for (int d = 0; d < 4; ++d) o[d] = (f32x4){0.f, 0.f, 0.f, 0.f};
#pragma unroll
        for (int j = 0; j < 9; ++j) {
            u32x4 pw; pw.x = cvt_pk_bf16(sc[2 * j][0], sc[2 * j][1]); pw.y = cvt_pk_bf16(sc[2 * j][2], sc[2 * j][3]); pw.z = cvt_pk_bf16(sc[2 * j + 1][0], sc[2 * j + 1][1]); pw.w = cvt_pk_bf16(sc[2 * j + 1][2], sc[2 * j + 1][3]);
            const bf16x8 pf = __builtin_bit_cast(bf16x8, pw);
#pragma unroll
            for (int d = 0; d < 4; ++d) { const LAS unsigned char* p = Vl + ((16 * wid + 32 * j + 4 * fq + tq) * KV_PITCH + 16 * d + 4 * tp) * 2;
                const s16x4 lo = tr_read(p), hi = tr_read(p + 16 * KV_PITCH * 2);
                const bf16x8 vf = (bf16x8){lo[0], lo[1], lo[2], lo[3], hi[0], hi[1], hi[2], hi[3]};
                o[d] = __builtin_amdgcn_mfma_f32_16x16x32_bf16(vf, pf, o[d], 0, 0, 0); }
            __builtin_amdgcn_sched_barrier(0);
        }
#pragma unroll
        for (int d = 0; d < 4; ++d) { u32x2 w; w.x = cvt_pk_bf16(o[d][0] * rden, o[d][1] * rden); w.y = cvt_pk_bf16(o[d][2] * rden, o[d][3] * rden);
            *(u32x2*)(BR + (size_t)qrow * DM + 768 + hq * 64 + 16 * d + 4 * fq) = w; }
    }
    __syncthreads();
}

constexpr int LDS_BYTES = 131072 + 1024;
constexpr int N_PHASES = 1 + 8 * DEPTH;

__global__ void __launch_bounds__(NTHR) fwd_megakernel(Args a) {
    extern __shared__ __attribute__((aligned(16))) unsigned char lds_raw[];
    LAS unsigned char* lds = (LAS unsigned char*)lds_raw;
    cg::grid_group grid = cg::this_grid();
    const int tid = threadIdx.x, lane = tid & 63, wid = __builtin_amdgcn_readfirstlane(tid >> 6);
    const int G = gridDim.x, bx = blockIdx.x;
    unsigned char* ws = a.ws;
    bf16_t* H = (bf16_t*)(ws + WS_H); bf16_t* Z = (bf16_t*)(ws + WS_Z); bf16_t* BR = (bf16_t*)(ws + WS_BR);
    bf16_t* XB = (bf16_t*)(ws + WS_X); bf16_t* MERGED = (bf16_t*)(ws + WS_MERGED); bf16_t* Y = (bf16_t*)(ws + WS_Y); bf16_t* ACT = (bf16_t*)(ws + WS_ACT);
    const int lo = a.ph_lo, hi = a.ph_hi;
#define IN(k) (lo <= (k) && (k) < hi)
#define SEAM(k) do { if (a.coop && IN((k) + 1)) grid.sync(); } while (0)

    if (lo == 99) {
        const bf16_t* src = (const bf16_t*)(ws + (size_t)a.pad * MiB);
        for (size_t i = (size_t)bx * NTHR + tid; i < (size_t)M_TOK * DM; i += (size_t)G * NTHR) a.out[i] = __uint_as_float((unsigned)src[i] << 16);
        return;
    }
    if (IN(0)) { phase_prologue(a, lds, wid, lane); SEAM(0); }

#pragma unroll 1
    for (int l = 0; l < DEPTH; ++l) {
        const int p0 = 1 + 8 * l;
        int tl = threadIdx.x; asm volatile("" : "+v"(tl)); const int lane = tl & 63, wid = __builtin_amdgcn_readfirstlane(tl >> 6);
        const unsigned char* wl = ws + WS_W + (size_t)l * W_LAYER;
        const bf16_t* Win = (const bf16_t*)(wl + W_IN); const bf16_t* Wg = (const bf16_t*)(wl + W_G); const bf16_t* Wb = (const bf16_t*)(wl + W_B);
        const bf16_t* Wout = (const bf16_t*)(wl + W_OUT); const bf16_t* Wfi = (const bf16_t*)(wl + W_FI); const bf16_t* Wfo = (const bf16_t*)(wl + W_FO);
        const bf16_t* sgw = (const bf16_t*)(wl + W_SG); const bf16_t* pwT = (const bf16_t*)(wl + W_PW);

        if (IN(p0 + 0)) {
            gm::SchedPlain S{H, Win, DM, M_TOK / 256, DIN / 256, DM / 64, G, bx}; gm::EpiStoreBf16 E{Z, DIN};
            gm::gemm_phase<true>(lds, DM, S, E);
            SEAM(p0 + 0);
        }
        if (IN(p0 + 1)) {
            for (int rep = 0; rep < PROBE_MIX_REPS; ++rep)
            for (int u = bx; u < 4 * 384; u += G) { const int part = u / 384, chunk = u % 384, row0 = chunk * 128;
                if (part == 0) mixer_conv_pool(Z, BR, a.conv_w + l * 768, pwT, a.pool_scale + l * 256, row0, wid, lane);
                else if (part == 1) mixer_spatial(Z, BR, a.sg_norm + l * 256, sgw, a.sg_b + l * 512, lds, row0, wid, lane);
                else mixer_attn(Z, BR, a.attn_sink + l * 4, lds, row0, part - 2, wid, lane);
            }
            SEAM(p0 + 1);
        }
        if (IN(p0 + 2)) {
            gm::SchedGate S{H, BR, Wg, Wb, M_TOK / 256, DM / 256, G, bx};
            unsigned char* scr = ws + WS_SCR + (size_t)bx * SCR_PER_CU;
            gm::EpiGate E{a.b_gate + l * 4 * DM, MERGED, (GAS unsigned char*)scr, (GAS unsigned char*)(scr + 128 * 1024)};
            for (int rep = 0; rep < PROBE_G2_REPS; ++rep) gm::gemm_phase<true>(lds, DM, S, E);
            SEAM(p0 + 2);
        }
        if (IN(p0 + 3)) {
            gm::SchedPlain S{MERGED, Wout, DM, M_TOK / 256, DM / 256, DM / 64, G, bx}; gm::EpiStoreBf16 E{Y, DM};
            gm::gemm_phase<true>(lds, DM, S, E);
            SEAM(p0 + 3);
        }
        if (IN(p0 + 4)) { phase_resnorm(a, Y, a.norm_mix_post + l * DM, a.norm_ffn_pre + l * DM, l == 0, false, XB, H, wid, lane); SEAM(p0 + 4); }
        if (IN(p0 + 5)) {
            gm::SchedPlain S{H, Wfi, DM, M_TOK / 256, NFI / 256, DM / 64, G, bx}; gm::EpiSwiGLU E{ACT};
            for (int rep = 0; rep < PROBE_G4_REPS; ++rep) gm::gemm_phase<false>(lds, DM, S, E);
            SEAM(p0 + 5);
        }
        if (IN(p0 + 6)) {
            gm::SchedPlain S{ACT, Wfo, DFF, M_TOK / 256, DM / 256, DFF / 64, G, bx}; gm::EpiStoreBf16 E{H, DM};
            gm::gemm_phase<true>(lds, DFF, S, E);
            SEAM(p0 + 6);
        }
        if (IN(p0 + 7)) { phase_resnorm(a, H, a.norm_ffn_post + l * DM, (l + 1 < DEPTH) ? a.norm_mix_pre + (l + 1) * DM : nullptr, false, l + 1 == DEPTH, XB, H, wid, lane); SEAM(p0 + 7); }
    }
#undef IN
#undef SEAM
}

extern "C" void kernel_launch(void* const* d_in, const int* in_sizes, int n_in, void* d_out, int out_size, void* d_ws, size_t ws_size, hipStream_t stream) {
    static int grid = 0;
    if (grid == 0) {
        if (n_in != 20 || out_size != M_TOK * DM || ws_size < WS_END) { fprintf(stderr, "kernel_launch: unexpected shapes (n_in %d out %d ws %zu)\n", n_in, out_size, ws_size); grid = -1; return; }
        int dev = 0, cus = 0, per_cu = 0;
        hipGetDevice(&dev); hipDeviceGetAttribute(&cus, hipDeviceAttributeMultiprocessorCount, dev);
        if (hipFuncSetAttribute((const void*)fwd_megakernel, hipFuncAttributeMaxDynamicSharedMemorySize, LDS_BYTES) != hipSuccess) { fprintf(stderr, "kernel_launch: hipFuncSetAttribute failed\n"); grid = -1; return; }
        if (hipOccupancyMaxActiveBlocksPerMultiprocessor(&per_cu, (const void*)fwd_megakernel, NTHR, LDS_BYTES) != hipSuccess || per_cu < 1) { fprintf(stderr, "kernel_launch: occupancy query says %d\n", per_cu); per_cu = 1; }
        (void)hipGetLastError();
        grid = cus * 1;
    }
    if (grid < 0) return;
    Args a{};
    const float** fp = (const float**)&a;
    for (int i = 0; i < 20; ++i) fp[i] = (const float*)d_in[i];
    a.out = (float*)d_out; a.ws = (unsigned char*)d_ws; a.pad = 0;
#if MK_LAUNCH_PER_PHASE
#ifdef DUMP_AFTER
    for (int p = 0; p <= DUMP_AFTER; ++p) { a.ph_lo = p; a.ph_hi = p + 1; a.coop = 0;
        hipLaunchKernelGGL(fwd_megakernel, dim3(grid), dim3(NTHR), LDS_BYTES, stream, a); }
    a.ph_lo = 99; a.ph_hi = 100; a.pad = DUMP_MIB;
    hipLaunchKernelGGL(fwd_megakernel, dim3(grid), dim3(NTHR), LDS_BYTES, stream, a);
#else
    for (int p = 0; p < N_PHASES; ++p) { a.ph_lo = p; a.ph_hi = p + 1; a.coop = 0;
        hipLaunchKernelGGL(fwd_megakernel, dim3(grid), dim3(NTHR), LDS_BYTES, stream, a); }
#endif
#else
    a.ph_lo = 0; a.ph_hi = N_PHASES; a.coop = 1;
    void* args[] = {&a};
    hipError_t e = hipLaunchCooperativeKernel((const void*)fwd_megakernel, dim3(grid), dim3(NTHR), args, LDS_BYTES, stream);
    if (e != hipSuccess) fprintf(stderr, "cooperative launch failed: %s (grid %d)\n", hipGetErrorString(e), grid);
#endif
}
```

```cpp
#include <hip/hip_runtime.h>
#include <hip/hip_cooperative_groups.h>
#include <cstdio>
#include <cstdint>
namespace cg = cooperative_groups;

#ifndef PROBE_MIX_REPS
#define PROBE_MIX_REPS 1
#endif
#ifndef PROBE_G4_REPS
#define PROBE_G4_REPS 1
#endif
#ifndef PROBE_G2_REPS
#define PROBE_G2_REPS 1
#endif
#ifndef MK_LAUNCH_PER_PHASE
#define MK_LAUNCH_PER_PHASE 0
#endif

#define LAS __attribute__((address_space(3)))
typedef unsigned short bf16_t;
typedef short bf16x8 __attribute__((ext_vector_type(8)));
typedef short s16x4 __attribute__((ext_vector_type(4)));
typedef float f32x4 __attribute__((ext_vector_type(4)));
typedef unsigned u32x4 __attribute__((ext_vector_type(4)));
typedef unsigned u32x2 __attribute__((ext_vector_type(2)));

constexpr int M_TOK = 49152, M_PROMPT = 32768, DM = 1024, DIN = 2048, DFF = 2816, NFI = 5632, DEPTH = 2;
constexpr int NWAVES = 8, NTHR = 512;
constexpr float EPS = 1e-6f;
constexpr float LOG2E = 1.4426950408889634f;

constexpr size_t MiB = 1u << 20;
constexpr size_t W_IN = 0, W_G = 4 * MiB, W_B = 12 * MiB, W_OUT = 14 * MiB, W_FI = 16 * MiB, W_FO = 27 * MiB, W_SG = 32 * MiB + 512 * 1024, W_PW = W_SG + 128 * 1024, W_LAYER = 33 * MiB;
constexpr size_t WS_W = 0, WS_H = 66 * MiB, WS_Z = 162 * MiB, WS_BR = 354 * MiB, WS_X = 450 * MiB, WS_CTL = 546 * MiB, WS_END = 547 * MiB;
constexpr size_t WS_MERGED = WS_Z, WS_SCR = WS_Z + 96 * MiB, WS_Y = WS_Z + 96 * MiB, WS_ACT = WS_Z;
constexpr size_t SCR_PER_CU = 256 * 1024;

typedef float f32x2_t __attribute__((ext_vector_type(2))); typedef __bf16 bf16x2_t __attribute__((ext_vector_type(2)));
__device__ __forceinline__ unsigned cvt_pk_bf16(float lo, float hi) { f32x2_t v = {lo, hi}; bf16x2_t b = __builtin_convertvector(v, bf16x2_t); return __builtin_bit_cast(unsigned, b); }
__device__ __forceinline__ float bflo(unsigned w) { return __uint_as_float(w << 16); }
__device__ __forceinline__ float bfhi(unsigned w) { return __uint_as_float(w & 0xffff0000u); }
__device__ __forceinline__ float wave_sum(float v) {
#pragma unroll
    for (int o = 1; o < 64; o <<= 1) v += __shfl_xor(v, o);
    return v;
}
__device__ __forceinline__ float sigmoidf_(float x) { return __builtin_amdgcn_rcpf(1.0f + __builtin_amdgcn_exp2f(-x * LOG2E)); }
__device__ __forceinline__ void seq_bounds(int row, int& s0, int& s1) { if (row < M_PROMPT) { s0 = row & ~4095; s1 = s0 + 4096; } else { s0 = M_PROMPT; s1 = M_TOK; } }
__device__ __forceinline__ s16x4 tr_read(const LAS unsigned char* p) { return __builtin_bit_cast(s16x4, __builtin_amdgcn_ds_read_tr16_b64_v4i16((LAS s16x4*)p)); }

namespace gm {
constexpr int BM = 256, BK = 64, HALF = 128, HTB = HALF * BK * 2, STAGE_BYTES = 8 * HTB, NXCD = 8, WGM = 8;
__host__ __device__ __forceinline__ int lds_byte(int r, int c) { const int st = (r >> 4) * 2 + (c >> 5), rr = r & 15, cc = c & 31, ob = rr * 64 + cc * 2; return st * 1024 + (ob ^ (((ob >> 9) & 1) << 5)); }
__host__ __device__ __forceinline__ void stage_rc(int b, int& R, int& C) { const int st = b / 1024, sb = b % 1024, swz = sb ^ (((sb >> 9) & 1) << 5); R = (st >> 1) * 16 + swz / 64; C = (st & 1) * 32 + (swz % 64) / 2; }
__host__ __device__ __forceinline__ int perm32(int rho) { const int n = rho >> 4, i = rho & 15; return 8 * (i >> 2) + 4 * n + (i & 3); }

struct Unit { const char* A; const char* B; int nt, pm, pn, tag; };

__device__ __forceinline__ void tile_of(int L, int nM, int nN, int& pm, int& pn) {
    const int nwg = nM * nN; int wgid = L;
    { const int q = nwg / NXCD, r = nwg % NXCD, xcd = wgid % NXCD, off = wgid / NXCD; wgid = (xcd < r ? xcd * (q + 1) : r * (q + 1) + (xcd - r) * q) + off; }
    const int nig = WGM * nN, gid = wgid / nig, fm = gid * WGM, gsz = (nM - fm) < WGM ? (nM - fm) : WGM;
    pm = fm + ((wgid % nig) % gsz); pn = (wgid % nig) / gsz;
}
struct SchedPlain {
    const bf16_t* A; const bf16_t* B; int pitch, nM, nN, nt, G, c;
    __device__ __forceinline__ bool next(int i, Unit& u) const {
        const int L = i * G + c; if (L >= nM * nN) return false;
        tile_of(L, nM, nN, u.pm, u.pn);
        u.A = (const char*)(A + (size_t)u.pm * BM * pitch); u.B = (const char*)(B + (size_t)u.pn * BM * pitch); u.nt = nt; u.tag = 0; return true;
    }
};
struct SchedGate {
    const bf16_t* H; const bf16_t* BR; const bf16_t* WG; const bf16_t* WB; int nM, nN, G, c;
    __device__ __forceinline__ bool next(int i, Unit& u) const {
        const int ti = i >> 3, sub = i & 7; const int L = ti * G + c; if (L >= nM * nN) return false;
        tile_of(L, nM, nN, u.pm, u.pn);
        const int b = sub >> 1; u.tag = sub;
        if ((sub & 1) == 0) { u.A = (const char*)(H + (size_t)u.pm * BM * DM); u.B = (const char*)(WG + (size_t)b * DM * DM + (size_t)u.pn * BM * DM); u.nt = 16; }
        else { u.A = (const char*)(BR + (size_t)u.pm * BM * DM + 256 * b); u.B = (const char*)(WB + (size_t)u.pn * BM * DM + 256 * b); u.nt = 4; }
        return true;
    }
};

struct EpiStoreBf16 {
    bf16_t* O; int ldc;
    __device__ __forceinline__ void operator()(const f32x4 (&acc)[2][2][4][2], const Unit& u, int wr, int wc, int fr, int fq) const {
        const int row0 = u.pm * BM + wr * 64 + fr, col0 = u.pn * BM + wc * 32 + 8 * fq;
#pragma unroll
        for (int ai = 0; ai < 2; ++ai)
#pragma unroll
            for (int m = 0; m < 4; ++m) { bf16_t* rowp = O + (size_t)(row0 + ai * HALF + m * 16) * ldc + col0;
#pragma unroll
                for (int bj = 0; bj < 2; ++bj) { const f32x4 v0 = acc[ai][bj][m][0], v1 = acc[ai][bj][m][1];
                    u32x4 w; w.x = cvt_pk_bf16(v0[0], v0[1]); w.y = cvt_pk_bf16(v0[2], v0[3]); w.z = cvt_pk_bf16(v1[0], v1[1]); w.w = cvt_pk_bf16(v1[2], v1[3]);
                    *(u32x4*)(rowp + bj * HALF) = w; } }
    }
};
struct EpiSwiGLU {
    bf16_t* O;
    __device__ __forceinline__ void operator()(const f32x4 (&acc)[2][2][4][2], const Unit& u, int wr, int wc, int fr, int fq) const {
        const int row0 = u.pm * BM + wr * 64 + fr, col0 = u.pn * 128 + wc * 16 + 4 * fq;
#pragma unroll
        for (int ai = 0; ai < 2; ++ai)
#pragma unroll
            for (int m = 0; m < 4; ++m) { bf16_t* rowp = O + (size_t)(row0 + ai * HALF + m * 16) * DFF + col0;
#pragma unroll
                for (int bj = 0; bj < 2; ++bj) { const f32x4 a = acc[ai][bj][m][0], g = acc[ai][bj][m][1]; f32x4 o;
#pragma unroll
                    for (int e = 0; e < 4; ++e) o[e] = a[e] * sigmoidf_(a[e]) * g[e];
                    u32x2 w; w.x = cvt_pk_bf16(o[0], o[1]); w.y = cvt_pk_bf16(o[2], o[3]);
                    *(u32x2*)(rowp + bj * 64) = w; } }
    }
};
#define GAS __attribute__((address_space(1)))
struct EpiGate {
    const float* bgate; bf16_t* O; GAS unsigned char* gsc; GAS unsigned char* msc;
    __device__ __forceinline__ void operator()(const f32x4 (&acc)[2][2][4][2], const Unit& u, int wr, int wc, int fr, int fq) const {
        const int tid = threadIdx.x; const int b = u.tag >> 1, kind = u.tag & 1;
        const int row0 = u.pm * BM + wr * 64 + fr, col0 = u.pn * BM + wc * 32 + 8 * fq;
        unsigned off = (unsigned)tid * 32u;
        if (kind == 0) {
            f32x4 bv[2][2];
#pragma unroll
            for (int bj = 0; bj < 2; ++bj)
#pragma unroll
                for (int n = 0; n < 2; ++n) bv[bj][n] = *(const f32x4*)(bgate + b * DM + col0 + bj * HALF + 4 * n);
#pragma unroll
            for (int ai = 0; ai < 2; ++ai)
#pragma unroll
                for (int m = 0; m < 4; ++m) {
                    asm volatile("" : "+v"(off));
#pragma unroll
                    for (int bj = 0; bj < 2; ++bj) { const f32x4 v0 = acc[ai][bj][m][0] + bv[bj][0], v1 = acc[ai][bj][m][1] + bv[bj][1];
                        u32x4 w; w.x = cvt_pk_bf16(sigmoidf_(v0[0]), sigmoidf_(v0[1])); w.y = cvt_pk_bf16(sigmoidf_(v0[2]), sigmoidf_(v0[3]));
                        w.z = cvt_pk_bf16(sigmoidf_(v1[0]), sigmoidf_(v1[1])); w.w = cvt_pk_bf16(sigmoidf_(v1[2]), sigmoidf_(v1[3]));
                        *(GAS u32x4*)(gsc + off + bj * 16) = w; }
                    off += 16384u; }
        } else {
#pragma unroll
            for (int ai = 0; ai < 2; ++ai) {
                asm volatile("" : "+v"(off));
                u32x4 gw[4][2], mw[4][2];
#pragma unroll
                for (int m = 0; m < 4; ++m)
#pragma unroll
                    for (int bj = 0; bj < 2; ++bj) gw[m][bj] = *(const GAS u32x4*)(gsc + off + m * 16384 + bj * 16);
                if (b != 0) {
#pragma unroll
                    for (int m = 0; m < 4; ++m)
#pragma unroll
                        for (int bj = 0; bj < 2; ++bj) mw[m][bj] = *(const GAS u32x4*)(msc + off + m * 16384 + bj * 16);
                } else {
#pragma unroll
                    for (int m = 0; m < 4; ++m)
#pragma unroll
                        for (int bj = 0; bj < 2; ++bj) mw[m][bj] = (u32x4){0u, 0u, 0u, 0u};
                }
#pragma unroll
                for (int m = 0; m < 4; ++m) { bf16_t* rowp = O + (size_t)(row0 + ai * HALF + m * 16) * DM + col0;
#pragma unroll
                    for (int bj = 0; bj < 2; ++bj) { const u32x4 g = gw[m][bj], q = mw[m][bj];
                        const f32x4 a0 = acc[ai][bj][m][0], a1 = acc[ai][bj][m][1];
                        u32x4 w;
                        w.x = cvt_pk_bf16(bflo(g.x) * a0[0] + bflo(q.x), bfhi(g.x) * a0[1] + bfhi(q.x)); w.y = cvt_pk_bf16(bflo(g.y) * a0[2] + bflo(q.y), bfhi(g.y) * a0[3] + bfhi(q.y));
                        w.z = cvt_pk_bf16(bflo(g.z) * a1[0] + bflo(q.z), bfhi(g.z) * a1[1] + bfhi(q.z)); w.w = cvt_pk_bf16(bflo(g.w) * a1[2] + bflo(q.w), bfhi(g.w) * a1[3] + bfhi(q.w));
                        if (b != 3) *(GAS u32x4*)(msc + off + m * 16384 + bj * 16) = w;
                        else *(u32x4*)(rowp + bj * HALF) = w; } }
                off += 65536u; }
        }
    }
};

template <bool PERM, class Sched, class Epi>
__device__ __forceinline__ void gemm_phase(LAS unsigned char* lds, const int K, const Sched& S, const Epi& E) {
    int tid_ = threadIdx.x; asm volatile("" : "+v"(tid_));
    const int tid = tid_, wid = __builtin_amdgcn_readfirstlane(tid >> 6), lane = tid & 63, wr = wid >> 2, wc = wid & 3, fr = lane & 15, fq = lane >> 4;
    unsigned voffA[2], voffB[2];
#pragma unroll
    for (int i = 0; i < 2; ++i) { int R, C; stage_rc(tid * 16 + i * 8192, R, C); const int Rb = PERM ? ((R & ~31) + perm32(R & 31)) : R;
        voffA[i] = (unsigned)(R * K + C) * 2u; voffB[i] = (unsigned)(Rb * K + C) * 2u; }
    const size_t kstep = (size_t)(BK * 2);
    const size_t hstep = (size_t)HALF * K * 2;
    const unsigned ldsw = (unsigned)wid * 1024u;
    const int aoff = lds_byte(wr * 64 + fr, fq * 8), boff = lds_byte(wc * 32 + fr, fq * 8);
#define PG8_SA(b, h) (((b) * 2 + (h)) * HTB)
#define PG8_SB(b, h) ((4 + (b) * 2 + (h)) * HTB)
#define PG8_STAGE(bufoff, gbase, voff) do { _Pragma("unroll") for (int _i = 0; _i < 2; ++_i) \
        __builtin_amdgcn_global_load_lds((const unsigned*)((const char*)(gbase) + (voff)[_i]), (LAS unsigned*)(lds + (bufoff) + ldsw + _i * 8192), 16, 0, 0); } while (0)
#define PG8_LDA(dst, b, h) do { _Pragma("unroll") for (int m = 0; m < 4; ++m) _Pragma("unroll") for (int k = 0; k < 2; ++k) dst[m][k] = *(const LAS bf16x8*)(lds + PG8_SA(b, h) + aoff + m * 2048 + k * 1024); } while (0)
#define PG8_LDB(dst, b, h) do { _Pragma("unroll") for (int n = 0; n < 2; ++n) _Pragma("unroll") for (int k = 0; k < 2; ++k) dst[n][k] = *(const LAS bf16x8*)(lds + PG8_SB(b, h) + boff + n * 2048 + k * 1024); } while (0)
#define PG8_MMA(ai, bj, At, Bt) do { __builtin_amdgcn_s_setprio(1); _Pragma("unroll") for (int m = 0; m < 4; ++m) _Pragma("unroll") for (int n = 0; n < 2; ++n) _Pragma("unroll") for (int k = 0; k < 2; ++k) \
        acc[ai][bj][m][n] = __builtin_amdgcn_mfma_f32_16x16x32_bf16(Bt[n][k], At[m][k], acc[ai][bj][m][n], 0, 0, 0); __builtin_amdgcn_s_setprio(0); } while (0)
#define PG8_WAIT_V(n) asm volatile("s_waitcnt vmcnt(" #n ")" ::: "memory")
#define PG8_WAIT_L(n) asm volatile("s_waitcnt lgkmcnt(" #n ")" ::: "memory")
#define PG8_BAR __builtin_amdgcn_s_barrier()
#define PG8_SCHED __builtin_amdgcn_sched_barrier(0)
    Unit cur, nxt; int ui = 0;
    if (!S.next(0, cur)) return;
    f32x4 acc[2][2][4][2];
#pragma unroll
    for (int a = 0; a < 2; ++a)
#pragma unroll
        for (int b = 0; b < 2; ++b)
#pragma unroll
            for (int m = 0; m < 4; ++m)
#pragma unroll
                for (int n = 0; n < 2; ++n) acc[a][b][m][n] = (f32x4){0.f, 0.f, 0.f, 0.f};
    bf16x8 At[4][2], B0[2][2], B1[2][2];
    const char* cA = cur.A; const char* cB = cur.B;
    PG8_STAGE(PG8_SB(0, 0), cB, voffB); PG8_STAGE(PG8_SB(0, 1), cB + hstep, voffB); PG8_STAGE(PG8_SA(0, 0), cA, voffA); PG8_STAGE(PG8_SA(0, 1), cA + hstep, voffA);
    if (wr == 1) PG8_BAR;
    PG8_WAIT_V(2); PG8_BAR;
    PG8_STAGE(PG8_SB(1, 0), cB + kstep, voffB); PG8_STAGE(PG8_SA(1, 0), cA + kstep, voffA); PG8_STAGE(PG8_SB(1, 1), cB + hstep + kstep, voffB);
    PG8_WAIT_V(6); PG8_BAR;
    for (;;) {
        const bool has_next = S.next(ui + 1, nxt);
        const char* nA = has_next ? nxt.A : cA; const char* nB = has_next ? nxt.B : cB;
        const int nt = cur.nt;
        for (int t = 0; t < nt; t += 2) {
            const bool last = (t == nt - 2);
            const char* a1 = cA + (size_t)(t + 1) * kstep;
            const char* a2 = last ? nA : cA + (size_t)(t + 2) * kstep; const char* b2 = last ? nB : cB + (size_t)(t + 2) * kstep;
            const char* a3 = a2 + kstep; const char* b3 = b2 + kstep;
            PG8_LDB(B0, 0, 0); PG8_LDB(B1, 0, 1); PG8_SCHED; PG8_LDA(At, 0, 0); PG8_STAGE(PG8_SA(1, 1), a1 + hstep, voffA);
            PG8_WAIT_V(8); PG8_WAIT_L(0); PG8_BAR; PG8_MMA(0, 0, At, B0); PG8_MMA(0, 1, At, B1); PG8_BAR; PG8_SCHED;
            PG8_LDA(At, 0, 1); PG8_STAGE(PG8_SB(0, 0), b2, voffB); PG8_STAGE(PG8_SB(0, 1), b2 + hstep, voffB); PG8_STAGE(PG8_SA(0, 0), a2, voffA);
            PG8_WAIT_V(8); PG8_WAIT_L(0); PG8_BAR; PG8_MMA(1, 0, At, B0); PG8_MMA(1, 1, At, B1); PG8_BAR; PG8_SCHED;
            PG8_LDB(B0, 1, 0); PG8_LDB(B1, 1, 1); PG8_SCHED; PG8_LDA(At, 1, 0); PG8_STAGE(PG8_SA(0, 1), a2 + hstep, voffA);
            PG8_WAIT_V(8); PG8_WAIT_L(0); PG8_BAR; PG8_MMA(0, 0, At, B0); PG8_MMA(0, 1, At, B1); PG8_BAR; PG8_SCHED;
            PG8_LDA(At, 1, 1); PG8_STAGE(PG8_SB(1, 0), b3, voffB); PG8_STAGE(PG8_SB(1, 1), b3 + hstep, voffB); PG8_STAGE(PG8_SA(1, 0), a3, voffA);
            PG8_WAIT_V(8); PG8_WAIT_L(0); PG8_BAR; PG8_MMA(1, 0, At, B0); PG8_MMA(1, 1, At, B1); PG8_BAR; PG8_SCHED;
        }
        if (wr == 0) PG8_BAR;
        E(acc, cur, wr, wc, fr, fq);
        if (!has_next) break;
#pragma unroll
        for (int a = 0; a < 2; ++a)
#pragma unroll
            for (int b = 0; b < 2; ++b)
#pragma unroll
                for (int m = 0; m < 4; ++m)
#pragma unroll
                    for (int n = 0; n < 2; ++n) acc[a][b][m][n] = (f32x4){0.f, 0.f, 0.f, 0.f};
        cur = nxt; cA = nA; cB = nB; ++ui;
        if (wr == 1) PG8_BAR;
    }
    PG8_WAIT_V(0);
    PG8_BAR;
#undef PG8_SA
#undef PG8_SB
#undef PG8_STAGE
#undef PG8_LDA
#undef PG8_LDB
#undef PG8_MMA
#undef PG8_WAIT_V
#undef PG8_WAIT_L
#undef PG8_BAR
#undef PG8_SCHED
}
}

struct Args {
    const float* x_prompt; const float* x_sample; const float* norm_mix_pre; const float* norm_mix_post; const float* norm_ffn_pre; const float* norm_ffn_post;
    const float* w_in; const float* conv_w; const float* pool_w; const float* pool_scale; const float* sg_norm; const float* sg_w; const float* sg_b; const float* attn_sink;
    const float* w_branch; const float* w_gate; const float* b_gate; const float* w_out; const float* w_ffn_in; const float* w_ffn_out;
    float* out; unsigned char* ws; int ph_lo, ph_hi, coop, pad;
};

template <int MODE>
__device__ __forceinline__ void transpose_item(const float* W, int ldw, int N, bf16_t* WT, int ldt, LAS float* scr, int item, int lane) {
    const int nblk = N / 32, kb = item / nblk, nb = item % nblk, k0 = 64 * kb, n0 = 32 * nb;
#pragma unroll 8
    for (int i = 0; i < 32; ++i) { const int kk = 2 * i + (lane >> 5); scr[kk * 33 + (lane & 31)] = W[(size_t)(k0 + kk) * ldw + n0 + (lane & 31)]; }
    asm volatile("s_waitcnt lgkmcnt(0)" ::: "memory");
    const int c = lane & 7;
#pragma unroll
    for (int j = 0; j < 4; ++j) { const int n = (lane >> 3) + 8 * j; const LAS float* s = scr + (8 * c) * 33 + n;
        u32x4 o; o.x = cvt_pk_bf16(s[0 * 33], s[1 * 33]); o.y = cvt_pk_bf16(s[2 * 33], s[3 * 33]); o.z = cvt_pk_bf16(s[4 * 33], s[5 * 33]); o.w = cvt_pk_bf16(s[6 * 33], s[7 * 33]);
        int drow = n0 + n;
        if (MODE == 1) { const int sc = n0 + n, isg = sc >= DFF ? 1 : 0, f = sc - isg * DFF; drow = 256 * (f >> 7) + 128 * ((f >> 6) & 1) + 32 * ((f >> 4) & 3) + 16 * isg + (f & 15); }
        *(u32x4*)(WT + (size_t)drow * ldt + k0 + 8 * c) = o; }
    asm volatile("s_waitcnt lgkmcnt(0)" ::: "memory");
}

__device__ __forceinline__ void phase_prologue(const Args& a, LAS unsigned char* lds, int wid, int lane) {
    LAS float* scr = (LAS float*)(lds + wid * 16384);
    const int gw = blockIdx.x * NWAVES + wid, NGW = gridDim.x * NWAVES;
    constexpr int I_IN = 16 * 64, I_G = 16 * 32, I_B = 16 * 32, I_O = 16 * 32, I_FI = 16 * 176, I_FO = 44 * 32, I_PW = 2;
    constexpr int I_LAYER = I_IN + 4 * I_G + I_B + I_O + I_FI + I_FO + 4 * I_PW;
    for (int it = gw; it < DEPTH * I_LAYER; it += NGW) {
        const int l = it / I_LAYER; int r = it % I_LAYER;
        unsigned char* wl = a.ws + WS_W + (size_t)l * W_LAYER;
        if (r < I_IN) { transpose_item<0>(a.w_in + (size_t)l * DM * DIN, DIN, DIN, (bf16_t*)(wl + W_IN), DM, scr, r, lane); continue; } r -= I_IN;
        if (r < 4 * I_G) { const int b = r / I_G; transpose_item<0>(a.w_gate + ((size_t)l * 4 + b) * DM * DM, DM, DM, (bf16_t*)(wl + W_G) + (size_t)b * DM * DM, DM, scr, r % I_G, lane); continue; } r -= 4 * I_G;
        if (r < I_B) { transpose_item<0>(a.w_branch + (size_t)l * DM * DM, DM, DM, (bf16_t*)(wl + W_B), DM, scr, r, lane); continue; } r -= I_B;
        if (r < I_O) { transpose_item<0>(a.w_out + (size_t)l * DM * DM, DM, DM, (bf16_t*)(wl + W_OUT), DM, scr, r, lane); continue; } r -= I_O;
        if (r < I_FI) { transpose_item<1>(a.w_ffn_in + (size_t)l * DM * NFI, NFI, NFI, (bf16_t*)(wl + W_FI), DM, scr, r, lane); continue; } r -= I_FI;
        if (r < I_FO) { transpose_item<0>(a.w_ffn_out + (size_t)l * DFF * DM, DM, DM, (bf16_t*)(wl + W_FO), DFF, scr, r, lane); continue; } r -= I_FO;
        { const int g = r / I_PW; transpose_item<0>(a.pool_w + ((size_t)l * 4 + g) * 4096, 64, 64, (bf16_t*)(wl + W_PW) + g * 4096, 64, scr, r % I_PW, lane); }
    }
    const int gt = blockIdx.x * NTHR + threadIdx.x, NGT = gridDim.x * NTHR;
    for (int i = gt; i < DEPTH * 65536 / 4; i += NGT) { const int l = (i * 4) / 65536, o = (i * 4) % 65536;
        const f32x4 v = *(const f32x4*)(a.sg_w + (size_t)l * 65536 + o); u32x2 w; w.x = cvt_pk_bf16(v[0], v[1]); w.y = cvt_pk_bf16(v[2], v[3]);
        *(u32x2*)((bf16_t*)(a.ws + WS_W + (size_t)l * W_LAYER + W_SG) + o) = w; }
    bf16_t* H = (bf16_t*)(a.ws + WS_H);
    for (int row = gw; row < M_TOK; row += NGW) {
        const float* xr = row < M_PROMPT ? a.x_prompt + (size_t)row * DM : a.x_sample + (size_t)(row - M_PROMPT) * DM;
        f32x4 v[4]; float ss = 0.f;
#pragma unroll
        for (int j = 0; j < 4; ++j) { v[j] = ((const f32x4*)xr)[lane + 64 * j]; ss += (v[j][0] * v[j][0] + v[j][1] * v[j][1]) + (v[j][2] * v[j][2] + v[j][3] * v[j][3]); }
        const float rstd = __builtin_amdgcn_rsqf(wave_sum(ss) * (1.f / DM) + EPS);
#pragma unroll
        for (int j = 0; j < 4; ++j) { const f32x4 g = ((const f32x4*)a.norm_mix_pre)[lane + 64 * j]; u32x2 w; w.x = cvt_pk_bf16(v[j][0] * rstd * g[0], v[j][1] * rstd * g[1]); w.y = cvt_pk_bf16(v[j][2] * rstd * g[2], v[j][3] * rstd * g[3]);
            ((u32x2*)(H + (size_t)row * DM))[lane + 64 * j] = w; }
    }
}

__device__ __forceinline__ void phase_resnorm(const Args& a, const bf16_t* Y, const float* gpost, const float* gnext, bool first_x, bool last_x, bf16_t* X, bf16_t* H, int wid, int lane) {
    const int gw = blockIdx.x * NWAVES + wid, NGW = gridDim.x * NWAVES;
    constexpr int RB = 3;
    for (int row0 = gw; row0 < M_TOK; row0 += RB * NGW) {
        f32x4 xv[RB][4], yv[RB][4]; float ss[RB];
#pragma unroll
        for (int r = 0; r < RB; ++r) { const int row = min(row0 + r * NGW, M_TOK - 1); ss[r] = 0.f;
#pragma unroll
            for (int j = 0; j < 4; ++j) { const u32x2 w = ((const u32x2*)(Y + (size_t)row * DM))[lane + 64 * j]; yv[r][j] = (f32x4){bflo(w.x), bfhi(w.x), bflo(w.y), bfhi(w.y)}; }
            if (first_x) { const float* xr = row < M_PROMPT ? a.x_prompt + (size_t)row * DM : a.x_sample + (size_t)(row - M_PROMPT) * DM;
#pragma unroll
                for (int j = 0; j < 4; ++j) xv[r][j] = ((const f32x4*)xr)[lane + 64 * j];
            } else {
#pragma unroll
                for (int j = 0; j < 4; ++j) { const u32x2 w = ((const u32x2*)(X + (size_t)row * DM))[lane + 64 * j]; xv[r][j] = (f32x4){bflo(w.x), bfhi(w.x), bflo(w.y), bfhi(w.y)}; }
            } }
#pragma unroll
        for (int r = 0; r < RB; ++r) { const int row = row0 + r * NGW; if (row >= M_TOK) break;
#pragma unroll
            for (int j = 0; j < 4; ++j) ss[r] += (yv[r][j][0] * yv[r][j][0] + yv[r][j][1] * yv[r][j][1]) + (yv[r][j][2] * yv[r][j][2] + yv[r][j][3] * yv[r][j][3]);
            const float rstd = __builtin_amdgcn_rsqf(wave_sum(ss[r]) * (1.f / DM) + EPS);
            float sx = 0.f;
#pragma unroll
            for (int j = 0; j < 4; ++j) { const f32x4 g = ((const f32x4*)gpost)[lane + 64 * j]; xv[r][j] = xv[r][j] + yv[r][j] * rstd * g;
                sx += (xv[r][j][0] * xv[r][j][0] + xv[r][j][1] * xv[r][j][1]) + (xv[r][j][2] * xv[r][j][2] + xv[r][j][3] * xv[r][j][3]); }
            if (last_x) {
#pragma unroll
                for (int j = 0; j < 4; ++j) ((f32x4*)(a.out + (size_t)row * DM))[lane + 64 * j] = xv[r][j];
            } else {
#pragma unroll
                for (int j = 0; j < 4; ++j) { u32x2 w; w.x = cvt_pk_bf16(xv[r][j][0], xv[r][j][1]); w.y = cvt_pk_bf16(xv[r][j][2], xv[r][j][3]); ((u32x2*)(X + (size_t)row * DM))[lane + 64 * j] = w; }
            }
            if (gnext) {
                const float rx = __builtin_amdgcn_rsqf(wave_sum(sx) * (1.f / DM) + EPS);
#pragma unroll
                for (int j = 0; j < 4; ++j) { const f32x4 g = ((const f32x4*)gnext)[lane + 64 * j]; u32x2 w; w.x = cvt_pk_bf16(xv[r][j][0] * rx * g[0], xv[r][j][1] * rx * g[1]); w.y = cvt_pk_bf16(xv[r][j][2] * rx * g[2], xv[r][j][3] * rx * g[3]);
                    ((u32x2*)(H + (size_t)row * DM))[lane + 64 * j] = w; }
            }
        }
    }
}

template <int GI>
__device__ __forceinline__ void pool_group(const bf16_t* Z, bf16_t* BR, const bf16_t* pwT, const float* pool_scale, int row, int s0, int s1, int fr, int fq) {
    constexpr int half = 1 << GI, W = 2 * half;
    const int lo = max(row - half, s0), hi = min(row + half, s1); const float inv = 1.0f / (float)(hi - lo);
    f32x4 acc[4];
#pragma unroll
    for (int d = 0; d < 4; ++d) acc[d] = (f32x4){0.f, 0.f, 0.f, 0.f};
#pragma unroll
    for (int kk = 0; kk < 2; ++kk) {
        const int c = 768 + 64 * GI + 32 * kk + 8 * fq;
        u32x4 v[W];
#pragma unroll
        for (int i = 0; i < W; ++i) { const int r2 = row - half + i; const int rc = min(max(r2, s0), s1 - 1); v[i] = *(const u32x4*)(Z + (size_t)rc * DIN + c); }
        float s[8];
#pragma unroll
        for (int j = 0; j < 8; ++j) s[j] = 0.f;
#pragma unroll
        for (int i = 0; i < W; ++i) { const int r2 = row - half + i; const float mk = (r2 >= s0 && r2 < s1) ? 1.f : 0.f;
#pragma unroll
            for (int q = 0; q < 4; ++q) { s[2 * q] += mk * bflo(v[i][q]); s[2 * q + 1] += mk * bfhi(v[i][q]); } }
        const u32x4 sv = v[half];
        u32x4 pw;
#pragma unroll
        for (int q = 0; q < 4; ++q) pw[q] = cvt_pk_bf16(s[2 * q] * inv - bflo(sv[q]), s[2 * q + 1] * inv - bfhi(sv[q]));
        const bf16x8 bfrag = __builtin_bit_cast(bf16x8, pw);
#pragma unroll
        for (int d = 0; d < 4; ++d) { const bf16x8 afrag = *(const bf16x8*)(pwT + GI * 4096 + (16 * d + fr) * 64 + 32 * kk + 8 * fq);
            acc[d] = __builtin_amdgcn_mfma_f32_16x16x32_bf16(afrag, bfrag, acc[d], 0, 0, 0); }
        __builtin_amdgcn_sched_barrier(0);
    }
#pragma unroll
    for (int d = 0; d < 4; ++d) { const int dc = 64 * GI + 16 * d + 4 * fq; const f32x4 sc = *(const f32x4*)(pool_scale + dc);
        u32x2 w; w.x = cvt_pk_bf16(acc[d][0] * sc[0], acc[d][1] * sc[1]); w.y = cvt_pk_bf16(acc[d][2] * sc[2], acc[d][3] * sc[3]);
        *(u32x2*)(BR + (size_t)row * DM + 256 + dc) = w; }
    __builtin_amdgcn_sched_barrier(0);
}
__device__ __forceinline__ void mixer_conv_pool(const bf16_t* Z, bf16_t* BR, const float* conv_w, const bf16_t* pwT, const float* pool_scale, int row0, int wid, int lane) {
    int s0, s1; seq_bounds(row0, s0, s1);
    const int tid = threadIdx.x;
#pragma unroll 1
    for (int k = 0; k < 8; ++k) { const int it = tid + k * NTHR;
        const int t = it >> 5, c8 = (it & 31) * 8, row = row0 + t;
        const int rm = max(row - 1, s0), rp = min(row + 1, s1 - 1); const float m0 = (row - 1 >= s0) ? 1.f : 0.f, m2 = (row + 1 < s1) ? 1.f : 0.f;
        const u32x4 bg = *(const u32x4*)(Z + (size_t)row * DIN + c8);
        u32x4 cg[3], xv[3];
        cg[0] = *(const u32x4*)(Z + (size_t)rm * DIN + 256 + c8); xv[0] = *(const u32x4*)(Z + (size_t)rm * DIN + 512 + c8);
        cg[1] = *(const u32x4*)(Z + (size_t)row * DIN + 256 + c8); xv[1] = *(const u32x4*)(Z + (size_t)row * DIN + 512 + c8);
        cg[2] = *(const u32x4*)(Z + (size_t)rp * DIN + 256 + c8); xv[2] = *(const u32x4*)(Z + (size_t)rp * DIN + 512 + c8);
        float cv[8];
#pragma unroll
        for (int j = 0; j < 8; ++j) cv[j] = 0.f;
#pragma unroll
        for (int d = 0; d < 3; ++d) { const float mk = d == 0 ? m0 : (d == 2 ? m2 : 1.f);
            const f32x4 w0 = *(const f32x4*)(conv_w + d * 256 + c8) * mk, w1 = *(const f32x4*)(conv_w + d * 256 + c8 + 4) * mk;
#pragma unroll
            for (int q = 0; q < 4; ++q) { cv[2 * q] += (q < 2 ? w0[2 * q] : w1[2 * q - 4]) * bflo(cg[d][q]) * bflo(xv[d][q]); cv[2 * q + 1] += (q < 2 ? w0[2 * q + 1] : w1[2 * q - 3]) * bfhi(cg[d][q]) * bfhi(xv[d][q]); } }
        u32x4 o;
#pragma unroll
        for (int q = 0; q < 4; ++q) o[q] = cvt_pk_bf16(bflo(bg[q]) * cv[2 * q], bfhi(bg[q]) * cv[2 * q + 1]);
        *(u32x4*)(BR + (size_t)row * DM + c8) = o;
    }
    const int fr = lane & 15, fq = lane >> 4; const int row = row0 + 16 * wid + fr;
    pool_group<0>(Z, BR, pwT, pool_scale, row, s0, s1, fr, fq);
    pool_group<1>(Z, BR, pwT, pool_scale, row, s0, s1, fr, fq);
    pool_group<2>(Z, BR, pwT, pool_scale, row, s0, s1, fr, fq);
    pool_group<3>(Z, BR, pwT, pool_scale, row, s0, s1, fr, fq);
}

constexpr int VLN_PITCH = 264;
__device__ __forceinline__ void mixer_spatial(const bf16_t* Z, bf16_t* BR, const float* sg_norm, const bf16_t* sgw, const float* sg_b, LAS unsigned char* lds, int row0, int wid, int lane) {
    const f32x4 gn = *(const f32x4*)(sg_norm + 4 * lane);
    u32x2 wv[16];
#pragma unroll
    for (int i = 0; i < 16; ++i) wv[i] = *(const u32x2*)(Z + (size_t)(row0 + 16 * wid + i) * DIN + 1280 + 4 * lane);
#pragma unroll
    for (int i = 0; i < 16; ++i) { const int t = 16 * wid + i; const u32x2 w = wv[i];
        f32x4 v = (f32x4){bflo(w.x), bfhi(w.x), bflo(w.y), bfhi(w.y)};
        const float mean = wave_sum((v[0] + v[1]) + (v[2] + v[3])) * (1.f / 256.f); v = v - mean;
        const float var = wave_sum((v[0] * v[0] + v[1] * v[1]) + (v[2] * v[2] + v[3] * v[3])) * (1.f / 256.f);
        const float rstd = __builtin_amdgcn_rsqf(var + EPS);
        u32x2 o; o.x = cvt_pk_bf16(v[0] * rstd * gn[0], v[1] * rstd * gn[1]); o.y = cvt_pk_bf16(v[2] * rstd * gn[2], v[3] * rstd * gn[3]);
        *(LAS u32x2*)(lds + (t * VLN_PITCH + 4 * lane) * 2) = o; }
    __syncthreads();
    const int fr = lane & 15, fq = lane >> 4, l16 = lane & 15, tq = l16 >> 2, tp = l16 & 3;
    const int t = 16 * wid + fr, row = row0 + t;
#pragma unroll 1
    for (int g = 0; g < 4; ++g) {
        bf16x8 wf[4];
#pragma unroll
        for (int kk = 0; kk < 4; ++kk) wf[kk] = *(const bf16x8*)(sgw + g * 16384 + t * 128 + 32 * kk + 8 * fq);
        const float bias = sg_b[g * 128 + t];
#pragma unroll
        for (int ct = 0; ct < 4; ++ct) { const int c0 = 64 * g + 16 * ct; f32x4 acc = (f32x4){0.f, 0.f, 0.f, 0.f};
#pragma unroll
            for (int kk = 0; kk < 4; ++kk) { const LAS unsigned char* p = lds + ((32 * kk + 8 * fq + tq) * VLN_PITCH + c0 + 4 * tp) * 2;
                const s16x4 lo = tr_read(p), hi = tr_read(p + 4 * VLN_PITCH * 2);
                const bf16x8 af = (bf16x8){lo[0], lo[1], lo[2], lo[3], hi[0], hi[1], hi[2], hi[3]};
                acc = __builtin_amdgcn_mfma_f32_16x16x32_bf16(af, wf[kk], acc, 0, 0, 0); }
            const u32x2 uw = *(const u32x2*)(Z + (size_t)row * DIN + 1024 + c0 + 4 * fq);
            u32x2 o; o.x = cvt_pk_bf16(bflo(uw.x) * (acc[0] + bias), bfhi(uw.x) * (acc[1] + bias)); o.y = cvt_pk_bf16(bflo(uw.y) * (acc[2] + bias), bfhi(uw.y) * (acc[3] + bias));
            *(u32x2*)(BR + (size_t)row * DM + 512 + c0 + 4 * fq) = o; }
    }
    __syncthreads();
}

constexpr int KV_PITCH = 72, KV_ROWS = 448, KV_BYTES = KV_ROWS * KV_PITCH * 2;
__device__ __forceinline__ void mixer_attn(const bf16_t* Z, bf16_t* BR, const float* sink, LAS unsigned char* lds, int row0, int kvh, int wid, int lane) {
    int s0, s1; seq_bounds(row0, s0, s1);
    const int tid = threadIdx.x;
    LAS unsigned char* Kl = lds; LAS unsigned char* Vl = lds + KV_BYTES;
    {   u32x4 kv[7], vv[7];
#pragma unroll
        for (int k = 0; k < 7; ++k) { const int it = tid + k * NTHR, r = it >> 3, c8 = (it & 7) * 8; const int grow = row0 - 144 + r, gc = min(max(grow, s0), s1 - 1);
            kv[k] = *(const u32x4*)(Z + (size_t)gc * DIN + 1792 + kvh * 64 + c8); vv[k] = *(const u32x4*)(Z + (size_t)gc * DIN + 1920 + kvh * 64 + c8); }
#pragma unroll
        for (int k = 0; k < 7; ++k) { const int it = tid + k * NTHR, r = it >> 3, c8 = (it & 7) * 8; const int grow = row0 - 144 + r; const bool ok = grow >= s0 && grow < s1;
            const u32x4 z4 = (u32x4){0u, 0u, 0u, 0u};
            *(LAS u32x4*)(Kl + (r * KV_PITCH + c8) * 2) = ok ? kv[k] : z4; *(LAS u32x4*)(Vl + (r * KV_PITCH + c8) * 2) = ok ? vv[k] : z4; } }
    __syncthreads();
    const int fr = lane & 15, fq = lane >> 4, tq = fr >> 2, tp = fr & 3;
    const int qrow = row0 + 16 * wid + fr;
    float frel0 = (float)(fr + 144 - 4 * fq), frlo = (float)max(-128, qrow - s1 + 1), frhi = (float)min(128, qrow - s0);
#pragma unroll 1
    for (int g = 0; g < 2; ++g) {
        asm volatile("" : "+v"(frel0), "+v"(frlo), "+v"(frhi));
        const int hq = kvh * 2 + g;
        const float slope = __builtin_amdgcn_exp2f(-2.0f * (float)(hq + 1)) * LOG2E;
        const float sk = sink[hq] * LOG2E;
        bf16x8 qf[2];
#pragma unroll
        for (int kk = 0; kk < 2; ++kk) qf[kk] = *(const bf16x8*)(Z + (size_t)qrow * DIN + 1536 + hq * 64 + 32 * kk + 8 * fq);
        f32x4 sc[18];
#pragma unroll
        for (int kt = 0; kt < 18; ++kt) { f32x4 acc = (f32x4){0.f, 0.f, 0.f, 0.f};
#pragma unroll
            for (int kk = 0; kk < 2; ++kk) { const bf16x8 kf = *(const LAS bf16x8*)(Kl + ((16 * wid + 16 * kt + fr) * KV_PITCH + 32 * kk + 8 * fq) * 2);
                acc = __builtin_amdgcn_mfma_f32_16x16x32_bf16(kf, qf[kk], acc, 0, 0, 0); }
            sc[kt] = acc; if (kt & 1) __builtin_amdgcn_sched_barrier(0); }
        float mx = sk;
#pragma unroll
        for (int kt = 0; kt < 18; ++kt)
#pragma unroll
            for (int e = 0; e < 4; ++e) { const float t = frel0 - (float)(16 * kt + e);
                float v = __builtin_fmaf(__builtin_fabsf(t), -slope, sc[kt][e] * (0.125f * LOG2E));
                const float df = t - __builtin_amdgcn_fmed3f(t, frlo, frhi);
                v = __builtin_fmaf(__builtin_fabsf(df), -1e30f, v);
                sc[kt][e] = v; mx = fmaxf(mx, v); }
        mx = fmaxf(mx, __shfl_xor(mx, 16)); mx = fmaxf(mx, __shfl_xor(mx, 32));
        float sum = 0.f;
#pragma unroll
        for (int kt = 0; kt < 18; ++kt)
#pragma unroll
            for (int e = 0; e < 4; ++e) { const float p = __builtin_amdgcn_exp2f(sc[kt][e] - mx); sc[kt][e] = p; sum += p; }
        sum += __shfl_xor(sum, 16); sum += __shfl_xor(sum, 32);
        const float rden = __builtin_amdgcn_rcpf(sum + __builtin_amdgcn_exp2f(sk - mx));
        f32x4 o[4];
#pragma unroll
        for (int d = 0; d < 4; ++d) o[d] = (f32x4){0.f, 0.f, 0.f, 0.f};
#pragma unroll
        for (int j = 0; j < 9; ++j) {
            u32x4 pw; pw.x = cvt_pk_bf16(sc[2 * j][0], sc[2 * j][1]); pw.y = cvt_pk_bf16(sc[2 * j][2], sc[2 * j][3]); pw.z = cvt_pk_bf16(sc[2 * j + 1][0], sc[2 * j + 1][1]); pw.w = cvt_pk_bf16(sc[2 * j + 1][2], sc[2 * j + 1][3]);
            const bf16x8 pf = __builtin_bit_cast(bf16x8, pw);
#pragma unroll
            for (int d = 0; d < 4; ++d) { const LAS unsigned char* p = Vl + ((16 * wid + 32 * j + 4 * fq + tq) * KV_PITCH + 16 * d + 4 * tp) * 2;
                const s16x4 lo = tr_read(p), hi = tr_read(p + 16 * KV_PITCH * 2);
                const bf16x8 vf = (bf16x8){lo[0], lo[1], lo[2], lo[3], hi[0], hi[1], hi[2], hi[3]};
                o[d] = __builtin_amdgcn_mfma_f32_16x16x32_bf16(vf, pf, o[d], 0, 0, 0); }
            __builtin_amdgcn_sched_barrier(0);
        }
#pragma unroll
        for (int d = 0; d < 4; ++d) { u32x2 w; w.x = cvt_pk_bf16(o[d][0] * rden, o[d][1] * rden); w.y = cvt_pk_bf16(o[d][2] * rden, o[d][3] * rden);
            *(u32x2*)(BR + (size_t)qrow * DM + 768 + hq * 64 + 16 * d + 4 * fq) = w; }
    }
    __syncthreads();
}

#define XB_TMO      128
#define XB_XCNT(j)  (256  + 64 * (j))
#define XB_XSUB(j)  (1280 + 64 * (j))
#define XB_XGEN(j)  (2304 + 64 * (j))
#define XB_TOP      3328
#define XB_TOPGEN   3392
#define XCD_BAR_WORDS 3456
#define XB_SPIN_CAP (1u << 18)

__device__ __forceinline__ unsigned xb_ld(unsigned* p)              { return __hip_atomic_load(p, __ATOMIC_RELAXED, __HIP_MEMORY_SCOPE_AGENT); }
__device__ __forceinline__ unsigned xb_add(unsigned* p, unsigned v) { return __hip_atomic_fetch_add(p, v, __ATOMIC_RELAXED, __HIP_MEMORY_SCOPE_AGENT); }
__device__ __forceinline__ unsigned xb_xcc_id() { return (unsigned)__builtin_amdgcn_s_getreg((3 << 11) | 20) & 0xFu; }
#define XB_SPIN(cond, bar) do { unsigned _sp = 0; while (cond) { __builtin_amdgcn_s_sleep(1); \
    if ((++_sp & 255u) == 0u) { if (xb_ld(&(bar)[XB_TMO])) break; if (_sp > XB_SPIN_CAP) { atomicAdd(&(bar)[XB_TMO], 1u); break; } } } } while (0)

struct XcdBarrier {
    unsigned* bar; unsigned x;
    volatile LAS unsigned* st;
};

__device__ __forceinline__ XcdBarrier xcd_barrier_post(unsigned* bar, volatile LAS unsigned* st) {
    XcdBarrier b; b.bar = bar; b.x = xb_xcc_id(); b.st = st;
    if (threadIdx.x == 0) (void)xb_add(&bar[XB_XCNT(b.x)], 1u);
    return b;
}
__device__ __forceinline__ void xcd_barrier_complete(unsigned* bar, unsigned x, unsigned& nloc, unsigned& nx) {
    const unsigned G = gridDim.x * gridDim.y * gridDim.z;
    unsigned sum, cnt, mine, sp = 0u;
    for (;;) {
        sum = 0u; cnt = 0u; mine = 0u;
#pragma unroll
        for (unsigned j = 0; j < 16; ++j) { const unsigned c = xb_ld(&bar[XB_XCNT(j)]); sum += c; cnt += (c > 0u) ? 1u : 0u; mine = (j == x) ? c : mine; }
        if (sum == G) break;
        __builtin_amdgcn_s_sleep(1);
        if ((++sp & 255u) == 0u) { if (xb_ld(&bar[XB_TMO])) break; if (sp > XB_SPIN_CAP) { atomicAdd(&bar[XB_TMO], 1u); break; } }
    }
    nloc = mine > 0u ? mine : 1u; nx = cnt > 0u ? cnt : 1u;
}

__device__ __forceinline__ void xcd_barrier(const XcdBarrier& b) {
    asm volatile("s_waitcnt vmcnt(0)" ::: "memory");
    __syncthreads();
    if (threadIdx.x == 0) {
        unsigned* bar = b.bar;
        __builtin_amdgcn_s_waitcnt(0);
        unsigned nloc = b.st[0], nx = b.st[1];
        if (nloc == 0u) { xcd_barrier_complete(bar, b.x, nloc, nx); b.st[0] = nloc; b.st[1] = nx; }
        const unsigned old = xb_add(&bar[XB_XSUB(b.x)], 1u);
        const unsigned gen = old / nloc;
        if (old + 1u == (gen + 1u) * nloc) {
            __builtin_amdgcn_fence(__ATOMIC_RELEASE, "agent");
            asm volatile("s_waitcnt vmcnt(0)" ::: "memory");
            const unsigned og = xb_add(&bar[XB_TOP], 1u);
            const unsigned tg = og / nx;
            if (og + 1u == (tg + 1u) * nx) xb_add(&bar[XB_TOPGEN], 1u);
            else XB_SPIN(xb_ld(&bar[XB_TOPGEN]) == tg, bar);
            __builtin_amdgcn_fence(__ATOMIC_ACQUIRE, "agent");
            xb_add(&bar[XB_XGEN(b.x)], 1u);
            asm volatile("s_waitcnt vmcnt(0)" ::: "memory");
        } else {
            XB_SPIN(xb_ld(&bar[XB_XGEN(b.x)]) == gen, bar);
            __builtin_amdgcn_fence(__ATOMIC_ACQUIRE, "agent");
            asm volatile("s_waitcnt vmcnt(0)" ::: "memory");
        }
    }
    __syncthreads();
}


constexpr int LDS_BYTES = 131072 + 1024;
constexpr int N_PHASES = 1 + 8 * DEPTH;

__global__ void __launch_bounds__(NTHR) fwd_megakernel(Args a) {
    extern __shared__ __attribute__((aligned(16))) unsigned char lds_raw[];
    LAS unsigned char* lds = (LAS unsigned char*)lds_raw;
    cg::grid_group grid = cg::this_grid();
    const int tid = threadIdx.x, lane = tid & 63, wid = __builtin_amdgcn_readfirstlane(tid >> 6);
    const int G = gridDim.x, bx = blockIdx.x;
    unsigned char* ws = a.ws;
    bf16_t* H = (bf16_t*)(ws + WS_H); bf16_t* Z = (bf16_t*)(ws + WS_Z); bf16_t* BR = (bf16_t*)(ws + WS_BR);
    bf16_t* XB = (bf16_t*)(ws + WS_X); bf16_t* MERGED = (bf16_t*)(ws + WS_MERGED); bf16_t* Y = (bf16_t*)(ws + WS_Y); bf16_t* ACT = (bf16_t*)(ws + WS_ACT);
    const int lo = a.ph_lo, hi = a.ph_hi;
    volatile LAS unsigned* bst = (volatile LAS unsigned*)(lds + 131072);
    if (tid < 2) bst[tid] = 0u;
    __syncthreads();
    XcdBarrier xbar = xcd_barrier_post((unsigned*)(ws + WS_CTL), bst);
#define IN(k) (lo <= (k) && (k) < hi)
#define SEAM(k) do { if (a.coop && IN((k) + 1)) { if ((k) == 0) grid.sync(); else xcd_barrier(xbar); } } while (0)

    if (lo == 99) {
        const bf16_t* src = (const bf16_t*)(ws + (size_t)a.pad * MiB);
        for (size_t i = (size_t)bx * NTHR + tid; i < (size_t)M_TOK * DM; i += (size_t)G * NTHR) a.out[i] = __uint_as_float((unsigned)src[i] << 16);
        return;
    }
    if (IN(0)) { phase_prologue(a, lds, wid, lane); SEAM(0); }

#pragma unroll 1
    for (int l = 0; l < DEPTH; ++l) {
        const int p0 = 1 + 8 * l;
        int tl = threadIdx.x; asm volatile("" : "+v"(tl)); const int lane = tl & 63, wid = __builtin_amdgcn_readfirstlane(tl >> 6);
        const unsigned char* wl = ws + WS_W + (size_t)l * W_LAYER;
        const bf16_t* Win = (const bf16_t*)(wl + W_IN); const bf16_t* Wg = (const bf16_t*)(wl + W_G); const bf16_t* Wb = (const bf16_t*)(wl + W_B);
        const bf16_t* Wout = (const bf16_t*)(wl + W_OUT); const bf16_t* Wfi = (const bf16_t*)(wl + W_FI); const bf16_t* Wfo = (const bf16_t*)(wl + W_FO);
        const bf16_t* sgw = (const bf16_t*)(wl + W_SG); const bf16_t* pwT = (const bf16_t*)(wl + W_PW);

        if (IN(p0 + 0)) {
            gm::SchedPlain S{H, Win, DM, M_TOK / 256, DIN / 256, DM / 64, G, bx}; gm::EpiStoreBf16 E{Z, DIN};
            gm::gemm_phase<true>(lds, DM, S, E);
            SEAM(p0 + 0);
        }
        if (IN(p0 + 1)) {
            for (int rep = 0; rep < PROBE_MIX_REPS; ++rep)
            for (int u = bx; u < 4 * 384; u += G) { const int part = u / 384, chunk = u % 384, row0 = chunk * 128;
                if (part == 0) mixer_conv_pool(Z, BR, a.conv_w + l * 768, pwT, a.pool_scale + l * 256, row0, wid, lane);
                else if (part == 1) mixer_spatial(Z, BR, a.sg_norm + l * 256, sgw, a.sg_b + l * 512, lds, row0, wid, lane);
                else mixer_attn(Z, BR, a.attn_sink + l * 4, lds, row0, part - 2, wid, lane);
            }
            SEAM(p0 + 1);
        }
        if (IN(p0 + 2)) {
            gm::SchedGate S{H, BR, Wg, Wb, M_TOK / 256, DM / 256, G, bx};
            unsigned char* scr = ws + WS_SCR + (size_t)bx * SCR_PER_CU;
            gm::EpiGate E{a.b_gate + l * 4 * DM, MERGED, (GAS unsigned char*)scr, (GAS unsigned char*)(scr + 128 * 1024)};
            for (int rep = 0; rep < PROBE_G2_REPS; ++rep) gm::gemm_phase<true>(lds, DM, S, E);
            SEAM(p0 + 2);
        }
        if (IN(p0 + 3)) {
            gm::SchedPlain S{MERGED, Wout, DM, M_TOK / 256, DM / 256, DM / 64, G, bx}; gm::EpiStoreBf16 E{Y, DM};
            gm::gemm_phase<true>(lds, DM, S, E);
            SEAM(p0 + 3);
        }
        if (IN(p0 + 4)) { phase_resnorm(a, Y, a.norm_mix_post + l * DM, a.norm_ffn_pre + l * DM, l == 0, false, XB, H, wid, lane); SEAM(p0 + 4); }
        if (IN(p0 + 5)) {
            gm::SchedPlain S{H, Wfi, DM, M_TOK / 256, NFI / 256, DM / 64, G, bx}; gm::EpiSwiGLU E{ACT};
            for (int rep = 0; rep < PROBE_G4_REPS; ++rep) gm::gemm_phase<false>(lds, DM, S, E);
            SEAM(p0 + 5);
        }
        if (IN(p0 + 6)) {
            gm::SchedPlain S{ACT, Wfo, DFF, M_TOK / 256, DM / 256, DFF / 64, G, bx}; gm::EpiStoreBf16 E{H, DM};
            gm::gemm_phase<true>(lds, DFF, S, E);
            SEAM(p0 + 6);
        }
        if (IN(p0 + 7)) { phase_resnorm(a, H, a.norm_ffn_post + l * DM, (l + 1 < DEPTH) ? a.norm_mix_pre + (l + 1) * DM : nullptr, false, l + 1 == DEPTH, XB, H, wid, lane); SEAM(p0 + 7); }
    }
#undef IN
#undef SEAM
}

extern "C" void kernel_launch(void* const* d_in, const int* in_sizes, int n_in, void* d_out, int out_size, void* d_ws, size_t ws_size, hipStream_t stream) {
    static int grid = 0;
    if (grid == 0) {
        if (n_in != 20 || out_size != M_TOK * DM || ws_size < WS_END) { fprintf(stderr, "kernel_launch: unexpected shapes (n_in %d out %d ws %zu)\n", n_in, out_size, ws_size); grid = -1; return; }
        int dev = 0, cus = 0, per_cu = 0;
        hipGetDevice(&dev); hipDeviceGetAttribute(&cus, hipDeviceAttributeMultiprocessorCount, dev);
        if (hipFuncSetAttribute((const void*)fwd_megakernel, hipFuncAttributeMaxDynamicSharedMemorySize, LDS_BYTES) != hipSuccess) { fprintf(stderr, "kernel_launch: hipFuncSetAttribute failed\n"); grid = -1; return; }
        if (hipOccupancyMaxActiveBlocksPerMultiprocessor(&per_cu, (const void*)fwd_megakernel, NTHR, LDS_BYTES) != hipSuccess || per_cu < 1) { fprintf(stderr, "kernel_launch: occupancy query says %d\n", per_cu); per_cu = 1; }
        (void)hipGetLastError();
        grid = cus * 1;
    }
    if (grid < 0) return;
    if (hipMemsetAsync((char*)d_ws + WS_CTL, 0, 16384, stream) != hipSuccess) { fprintf(stderr, "kernel_launch: memset of barrier words failed\n"); return; }
    Args a{};
    const float** fp = (const float**)&a;
    for (int i = 0; i < 20; ++i) fp[i] = (const float*)d_in[i];
    a.out = (float*)d_out; a.ws = (unsigned char*)d_ws; a.pad = 0;
#if MK_LAUNCH_PER_PHASE
#ifdef DUMP_AFTER
    for (int p = 0; p <= DUMP_AFTER; ++p) { a.ph_lo = p; a.ph_hi = p + 1; a.coop = 0;
        hipLaunchKernelGGL(fwd_megakernel, dim3(grid), dim3(NTHR), LDS_BYTES, stream, a); }
    a.ph_lo = 99; a.ph_hi = 100; a.pad = DUMP_MIB;
    hipLaunchKernelGGL(fwd_megakernel, dim3(grid), dim3(NTHR), LDS_BYTES, stream, a);
#else
    for (int p = 0; p < N_PHASES; ++p) { a.ph_lo = p; a.ph_hi = p + 1; a.coop = 0;
        hipLaunchKernelGGL(fwd_megakernel, dim3(grid), dim3(NTHR), LDS_BYTES, stream, a); }
#endif
#else
    a.ph_lo = 0; a.ph_hi = N_PHASES; a.coop = 1;
    void* args[] = {&a};
    hipError_t e = hipLaunchCooperativeKernel((const void*)fwd_megakernel, dim3(grid), dim3(NTHR), args, LDS_BYTES, stream);
    if (e != hipSuccess) fprintf(stderr, "cooperative launch failed: %s (grid %d)\n", hipGetErrorString(e), grid);
#endif
}
```

```cpp
#include <hip/hip_runtime.h>
#include <hip/hip_cooperative_groups.h>
#include <cstdio>
#include <cstdint>
namespace cg = cooperative_groups;

#ifndef PROBE_MIX_REPS
#define PROBE_MIX_REPS 1
#endif
#ifndef PROBE_G4_REPS
#define PROBE_G4_REPS 1
#endif
#ifndef PROBE_G2_REPS
#define PROBE_G2_REPS 1
#endif
#ifndef MK_LAUNCH_PER_PHASE
#define MK_LAUNCH_PER_PHASE 0
#endif

#define LAS __attribute__((address_space(3)))
typedef unsigned short bf16_t;
typedef short bf16x8 __attribute__((ext_vector_type(8)));
typedef short s16x4 __attribute__((ext_vector_type(4)));
typedef float f32x4 __attribute__((ext_vector_type(4)));
typedef unsigned u32x4 __attribute__((ext_vector_type(4)));
typedef unsigned u32x2 __attribute__((ext_vector_type(2)));

constexpr int M_TOK = 49152, M_PROMPT = 32768, DM = 1024, DIN = 2048, DFF = 2816, NFI = 5632, DEPTH = 2;
constexpr int NWAVES = 8, NTHR = 512;
constexpr float EPS = 1e-6f;
constexpr float LOG2E = 1.4426950408889634f;

constexpr size_t MiB = 1u << 20;
constexpr size_t W_IN = 0, W_G = 4 * MiB, W_B = 12 * MiB, W_OUT = 14 * MiB, W_FI = 16 * MiB, W_FO = 27 * MiB, W_SG = 32 * MiB + 512 * 1024, W_PW = W_SG + 128 * 1024, W_LAYER = 33 * MiB;
constexpr size_t WS_W = 0, WS_H = 66 * MiB, WS_Z = 162 * MiB, WS_BR = 354 * MiB, WS_X = 450 * MiB, WS_CTL = 546 * MiB, WS_END = 547 * MiB;
constexpr size_t WS_MERGED = WS_Z, WS_SCR = WS_Z + 96 * MiB, WS_Y = WS_Z + 96 * MiB, WS_ACT = WS_Z;
constexpr size_t SCR_PER_CU = 256 * 1024;

typedef float f32x2_t __attribute__((ext_vector_type(2))); typedef __bf16 bf16x2_t __attribute__((ext_vector_type(2)));
__device__ __forceinline__ unsigned cvt_pk_bf16(float lo, float hi) { f32x2_t v = {lo, hi}; bf16x2_t b = __builtin_convertvector(v, bf16x2_t); return __builtin_bit_cast(unsigned, b); }
__device__ __forceinline__ float bflo(unsigned w) { return __uint_as_float(w << 16); }
__device__ __forceinline__ float bfhi(unsigned w) { return __uint_as_float(w & 0xffff0000u); }
__device__ __forceinline__ float wave_sum(float v) {
#pragma unroll
    for (int o = 1; o < 64; o <<= 1) v += __shfl_xor(v, o);
    return v;
}
__device__ __forceinline__ float sigmoidf_(float x) { return __builtin_amdgcn_rcpf(1.0f + __builtin_amdgcn_exp2f(-x * LOG2E)); }
__device__ __forceinline__ void seq_bounds(int row, int& s0, int& s1) { if (row < M_PROMPT) { s0 = row & ~4095; s1 = s0 + 4096; } else { s0 = M_PROMPT; s1 = M_TOK; } }
__device__ __forceinline__ s16x4 tr_read(const LAS unsigned char* p) { return __builtin_bit_cast(s16x4, __builtin_amdgcn_ds_read_tr16_b64_v4i16((LAS s16x4*)p)); }

namespace gm {
constexpr int BM = 256, BK = 64, HALF = 128, HTB = HALF * BK * 2, STAGE_BYTES = 8 * HTB, NXCD = 8, WGM = 8;
__host__ __device__ __forceinline__ int lds_byte(int r, int c) { const int st = (r >> 4) * 2 + (c >> 5), rr = r & 15, cc = c & 31, ob = rr * 64 + cc * 2; return st * 1024 + (ob ^ (((ob >> 9) & 1) << 5)); }
__host__ __device__ __forceinline__ void stage_rc(int b, int& R, int& C) { const int st = b / 1024, sb = b % 1024, swz = sb ^ (((sb >> 9) & 1) << 5); R = (st >> 1) * 16 + swz / 64; C = (st & 1) * 32 + (swz % 64) / 2; }
__host__ __device__ __forceinline__ int perm32(int rho) { const int n = rho >> 4, i = rho & 15; return 8 * (i >> 2) + 4 * n + (i & 3); }

struct Unit { const char* A; const char* B; int nt, pm, pn, tag; };

__device__ __forceinline__ void tile_of(int L, int nM, int nN, int& pm, int& pn) {
    const int nwg = nM * nN; int wgid = L;
    { const int q = nwg / NXCD, r = nwg % NXCD, xcd = wgid % NXCD, off = wgid / NXCD; wgid = (xcd < r ? xcd * (q + 1) : r * (q + 1) + (xcd - r) * q) + off; }
    const int nig = WGM * nN, gid = wgid / nig, fm = gid * WGM, gsz = (nM - fm) < WGM ? (nM - fm) : WGM;
    pm = fm + ((wgid % nig) % gsz); pn = (wgid % nig) / gsz;
}
struct SchedPlain {
    const bf16_t* A; const bf16_t* B; int pitch, nM, nN, nt, G, c;
    __device__ __forceinline__ bool next(int i, Unit& u) const {
        const int L = i * G + c; if (L >= nM * nN) return false;
        tile_of(L, nM, nN, u.pm, u.pn);
        u.A = (const char*)(A + (size_t)u.pm * BM * pitch); u.B = (const char*)(B + (size_t)u.pn * BM * pitch); u.nt = nt; u.tag = 0; return true;
    }
};
struct SchedGate {
    const bf16_t* H; const bf16_t* BR; const bf16_t* WG; const bf16_t* WB; int nM, nN, G, c;
    __device__ __forceinline__ bool next(int i, Unit& u) const {
        const int ti = i >> 3, sub = i & 7; const int L = ti * G + c; if (L >= nM * nN) return false;
        tile_of(L, nM, nN, u.pm, u.pn);
        const int b = sub >> 1; u.tag = sub;
        if ((sub & 1) == 0) { u.A = (const char*)(H + (size_t)u.pm * BM * DM); u.B = (const char*)(WG + (size_t)b * DM * DM + (size_t)u.pn * BM * DM); u.nt = 16; }
        else { u.A = (const char*)(BR + (size_t)u.pm * BM * DM + 256 * b); u.B = (const char*)(WB + (size_t)u.pn * BM * DM + 256 * b); u.nt = 4; }
        return true;
    }
};

struct EpiStoreBf16 {
    bf16_t* O; int ldc;
    __device__ __forceinline__ void operator()(const f32x4 (&acc)[2][2][4][2], const Unit& u, int wr, int wc, int fr, int fq) const {
        const int row0 = u.pm * BM + wr * 64 + fr, col0 = u.pn * BM + wc * 32 + 8 * fq;
#pragma unroll
        for (int ai = 0; ai < 2; ++ai)
#pragma unroll
            for (int m = 0; m < 4; ++m) { bf16_t* rowp = O + (size_t)(row0 + ai * HALF + m * 16) * ldc + col0;
#pragma unroll
                for (int bj = 0; bj < 2; ++bj) { const f32x4 v0 = acc[ai][bj][m][0], v1 = acc[ai][bj][m][1];
                    u32x4 w; w.x = cvt_pk_bf16(v0[0], v0[1]); w.y = cvt_pk_bf16(v0[2], v0[3]); w.z = cvt_pk_bf16(v1[0], v1[1]); w.w = cvt_pk_bf16(v1[2], v1[3]);
                    *(u32x4*)(rowp + bj * HALF) = w; } }
    }
};
struct EpiSwiGLU {
    bf16_t* O;
    __device__ __forceinline__ void operator()(const f32x4 (&acc)[2][2][4][2], const Unit& u, int wr, int wc, int fr, int fq) const {
        const int row0 = u.pm * BM + wr * 64 + fr, col0 = u.pn * 128 + wc * 32 + 8 * fq;
#pragma unroll
        for (int ai = 0; ai < 2; ++ai)
#pragma unroll
            for (int m = 0; m < 4; ++m) { bf16_t* rowp = O + (size_t)(row0 + ai * HALF + m * 16) * DFF + col0;
                f32x4 o[2];
#pragma unroll
                for (int n = 0; n < 2; ++n) { const f32x4 av = acc[ai][0][m][n], g = acc[ai][1][m][n];
#pragma unroll
                    for (int e = 0; e < 4; ++e) o[n][e] = av[e] * sigmoidf_(av[e]) * g[e]; }
                u32x4 w; w.x = cvt_pk_bf16(o[0][0], o[0][1]); w.y = cvt_pk_bf16(o[0][2], o[0][3]); w.z = cvt_pk_bf16(o[1][0], o[1][1]); w.w = cvt_pk_bf16(o[1][2], o[1][3]);
                *(u32x4*)rowp = w; }
    }
};
#define GAS __attribute__((address_space(1)))
struct EpiGate {
    const float* bgate; bf16_t* O; GAS unsigned char* gsc; GAS unsigned char* msc;
    __device__ __forceinline__ void operator()(const f32x4 (&acc)[2][2][4][2], const Unit& u, int wr, int wc, int fr, int fq) const {
        const int tid = threadIdx.x; const int b = u.tag >> 1, kind = u.tag & 1;
        const int row0 = u.pm * BM + wr * 64 + fr, col0 = u.pn * BM + wc * 32 + 8 * fq;
        unsigned off = (unsigned)tid * 32u;
        if (kind == 0) {
            f32x4 bv[2][2];
#pragma unroll
            for (int bj = 0; bj < 2; ++bj)
#pragma unroll
                for (int n = 0; n < 2; ++n) bv[bj][n] = *(const f32x4*)(bgate + b * DM + col0 + bj * HALF + 4 * n);
#pragma unroll
            for (int ai = 0; ai < 2; ++ai)
#pragma unroll
                for (int m = 0; m < 4; ++m) {
                    asm volatile("" : "+v"(off));
#pragma unroll
                    for (int bj = 0; bj < 2; ++bj) { const f32x4 v0 = acc[ai][bj][m][0] + bv[bj][0], v1 = acc[ai][bj][m][1] + bv[bj][1];
                        u32x4 w; w.x = cvt_pk_bf16(sigmoidf_(v0[0]), sigmoidf_(v0[1])); w.y = cvt_pk_bf16(sigmoidf_(v0[2]), sigmoidf_(v0[3]));
                        w.z = cvt_pk_bf16(sigmoidf_(v1[0]), sigmoidf_(v1[1])); w.w = cvt_pk_bf16(sigmoidf_(v1[2]), sigmoidf_(v1[3]));
                        *(GAS u32x4*)(gsc + off + bj * 16) = w; }
                    off += 16384u; }
        } else {
#pragma unroll
            for (int ai = 0; ai < 2; ++ai) {
                asm volatile("" : "+v"(off));
                u32x4 gw[4][2], mw[4][2];
#pragma unroll
                for (int m = 0; m < 4; ++m)
#pragma unroll
                    for (int bj = 0; bj < 2; ++bj) gw[m][bj] = *(const GAS u32x4*)(gsc + off + m * 16384 + bj * 16);
                if (b != 0) {
#pragma unroll
                    for (int m = 0; m < 4; ++m)
#pragma unroll
                        for (int bj = 0; bj < 2; ++bj) mw[m][bj] = *(const GAS u32x4*)(msc + off + m * 16384 + bj * 16);
                } else {
#pragma unroll
                    for (int m = 0; m < 4; ++m)
#pragma unroll
                        for (int bj = 0; bj < 2; ++bj) mw[m][bj] = (u32x4){0u, 0u, 0u, 0u};
                }
#pragma unroll
                for (int m = 0; m < 4; ++m) { bf16_t* rowp = O + (size_t)(row0 + ai * HALF + m * 16) * DM + col0;
#pragma unroll
                    for (int bj = 0; bj < 2; ++bj) { const u32x4 g = gw[m][bj], q = mw[m][bj];
                        const f32x4 a0 = acc[ai][bj][m][0], a1 = acc[ai][bj][m][1];
                        u32x4 w;
                        w.x = cvt_pk_bf16(bflo(g.x) * a0[0] + bflo(q.x), bfhi(g.x) * a0[1] + bfhi(q.x)); w.y = cvt_pk_bf16(bflo(g.y) * a0[2] + bflo(q.y), bfhi(g.y) * a0[3] + bfhi(q.y));
                        w.z = cvt_pk_bf16(bflo(g.z) * a1[0] + bflo(q.z), bfhi(g.z) * a1[1] + bfhi(q.z)); w.w = cvt_pk_bf16(bflo(g.w) * a1[2] + bflo(q.w), bfhi(g.w) * a1[3] + bfhi(q.w));
                        if (b != 3) *(GAS u32x4*)(msc + off + m * 16384 + bj * 16) = w;
                        else *(u32x4*)(rowp + bj * HALF) = w; } }
                off += 65536u; }
        }
    }
};

template <bool PERM, class Sched, class Epi>
__device__ __forceinline__ void gemm_phase(LAS unsigned char* lds, const int K, const Sched& S, const Epi& E) {
    int tid_ = threadIdx.x; asm volatile("" : "+v"(tid_));
    const int tid = tid_, wid = __builtin_amdgcn_readfirstlane(tid >> 6), lane = tid & 63, wr = wid >> 2, wc = wid & 3, fr = lane & 15, fq = lane >> 4;
    unsigned voffA[2], voffB[2];
#pragma unroll
    for (int i = 0; i < 2; ++i) { int R, C; stage_rc(tid * 16 + i * 8192, R, C); const int Rb = PERM ? ((R & ~31) + perm32(R & 31)) : R;
        voffA[i] = (unsigned)(R * K + C) * 2u; voffB[i] = (unsigned)(Rb * K + C) * 2u; }
    const size_t kstep = (size_t)(BK * 2);
    const size_t hstep = (size_t)HALF * K * 2;
    const unsigned ldsw = (unsigned)wid * 1024u;
    const int aoff = lds_byte(wr * 64 + fr, fq * 8), boff = lds_byte(wc * 32 + fr, fq * 8);
#define PG8_SA(b, h) (((b) * 2 + (h)) * HTB)
#define PG8_SB(b, h) ((4 + (b) * 2 + (h)) * HTB)
#define PG8_STAGE(bufoff, gbase, voff) do { _Pragma("unroll") for (int _i = 0; _i < 2; ++_i) \
        __builtin_amdgcn_global_load_lds((const unsigned*)((const char*)(gbase) + (voff)[_i]), (LAS unsigned*)(lds + (bufoff) + ldsw + _i * 8192), 16, 0, 0); } while (0)
#define PG8_LDA(dst, b, h) do { _Pragma("unroll") for (int m = 0; m < 4; ++m) _Pragma("unroll") for (int k = 0; k < 2; ++k) dst[m][k] = *(const LAS bf16x8*)(lds + PG8_SA(b, h) + aoff + m * 2048 + k * 1024); } while (0)
#define PG8_LDB(dst, b, h) do { _Pragma("unroll") for (int n = 0; n < 2; ++n) _Pragma("unroll") for (int k = 0; k < 2; ++k) dst[n][k] = *(const LAS bf16x8*)(lds + PG8_SB(b, h) + boff + n * 2048 + k * 1024); } while (0)
#define PG8_MMA(ai, bj, At, Bt) do { __builtin_amdgcn_s_setprio(1); _Pragma("unroll") for (int m = 0; m < 4; ++m) _Pragma("unroll") for (int n = 0; n < 2; ++n) _Pragma("unroll") for (int k = 0; k < 2; ++k) \
        acc[ai][bj][m][n] = __builtin_amdgcn_mfma_f32_16x16x32_bf16(Bt[n][k], At[m][k], acc[ai][bj][m][n], 0, 0, 0); __builtin_amdgcn_s_setprio(0); } while (0)
#define PG8_WAIT_V(n) asm volatile("s_waitcnt vmcnt(" #n ")" ::: "memory")
#define PG8_WAIT_L(n) asm volatile("s_waitcnt lgkmcnt(" #n ")" ::: "memory")
#define PG8_BAR __builtin_amdgcn_s_barrier()
#define PG8_SCHED __builtin_amdgcn_sched_barrier(0)
    Unit cur, nxt; int ui = 0;
    if (!S.next(0, cur)) return;
    f32x4 acc[2][2][4][2];
#pragma unroll
    for (int a = 0; a < 2; ++a)
#pragma unroll
        for (int b = 0; b < 2; ++b)
#pragma unroll
            for (int m = 0; m < 4; ++m)
#pragma unroll
                for (int n = 0; n < 2; ++n) acc[a][b][m][n] = (f32x4){0.f, 0.f, 0.f, 0.f};
    bf16x8 At[4][2], B0[2][2], B1[2][2];
    const char* cA = cur.A; const char* cB = cur.B;
    PG8_STAGE(PG8_SB(0, 0), cB, voffB); PG8_STAGE(PG8_SB(0, 1), cB + hstep, voffB); PG8_STAGE(PG8_SA(0, 0), cA, voffA); PG8_STAGE(PG8_SA(0, 1), cA + hstep, voffA);
    if (wr == 1) PG8_BAR;
    PG8_WAIT_V(2); PG8_BAR;
    PG8_STAGE(PG8_SB(1, 0), cB + kstep, voffB); PG8_STAGE(PG8_SA(1, 0), cA + kstep, voffA); PG8_STAGE(PG8_SB(1, 1), cB + hstep + kstep, voffB);
    PG8_WAIT_V(6); PG8_BAR;
    for (;;) {
        const bool has_next = S.next(ui + 1, nxt);
        const char* nA = has_next ? nxt.A : cA; const char* nB = has_next ? nxt.B : cB;
        const int nt = cur.nt;
        for (int t = 0; t < nt; t += 2) {
            const bool last = (t == nt - 2);
            const char* a1 = cA + (size_t)(t + 1) * kstep;
            const char* a2 = last ? nA : cA + (size_t)(t + 2) * kstep; const char* b2 = last ? nB : cB + (size_t)(t + 2) * kstep;
            const char* a3 = a2 + kstep; const char* b3 = b2 + kstep;
            PG8_LDB(B0, 0, 0); PG8_LDB(B1, 0, 1); PG8_SCHED; PG8_LDA(At, 0, 0); PG8_STAGE(PG8_SA(1, 1), a1 + hstep, voffA);
            PG8_WAIT_V(8); PG8_WAIT_L(0); PG8_BAR; PG8_MMA(0, 0, At, B0); PG8_MMA(0, 1, At, B1); PG8_BAR; PG8_SCHED;
            PG8_LDA(At, 0, 1); PG8_STAGE(PG8_SB(0, 0), b2, voffB); PG8_STAGE(PG8_SB(0, 1), b2 + hstep, voffB); PG8_STAGE(PG8_SA(0, 0), a2, voffA);
            PG8_WAIT_V(8); PG8_WAIT_L(0); PG8_BAR; PG8_MMA(1, 0, At, B0); PG8_MMA(1, 1, At, B1); PG8_BAR; PG8_SCHED;
            PG8_LDB(B0, 1, 0); PG8_LDB(B1, 1, 1); PG8_SCHED; PG8_LDA(At, 1, 0); PG8_STAGE(PG8_SA(0, 1), a2 + hstep, voffA);
            PG8_WAIT_V(8); PG8_WAIT_L(0); PG8_BAR; PG8_MMA(0, 0, At, B0); PG8_MMA(0, 1, At, B1); PG8_BAR; PG8_SCHED;
            PG8_LDA(At, 1, 1); PG8_STAGE(PG8_SB(1, 0), b3, voffB); PG8_STAGE(PG8_SB(1, 1), b3 + hstep, voffB); PG8_STAGE(PG8_SA(1, 0), a3, voffA);
            PG8_WAIT_V(8); PG8_WAIT_L(0); PG8_BAR; PG8_MMA(1, 0, At, B0); PG8_MMA(1, 1, At, B1); PG8_BAR; PG8_SCHED;
        }
        if (wr == 0) PG8_BAR;
        E(acc, cur, wr, wc, fr, fq);
        if (!has_next) break;
#pragma unroll
        for (int a = 0; a < 2; ++a)
#pragma unroll
            for (int b = 0; b < 2; ++b)
#pragma unroll
                for (int m = 0; m < 4; ++m)
#pragma unroll
                    for (int n = 0; n < 2; ++n) acc[a][b][m][n] = (f32x4){0.f, 0.f, 0.f, 0.f};
        cur = nxt; cA = nA; cB = nB; ++ui;
        if (wr == 1) PG8_BAR;
    }
    PG8_WAIT_V(0);
    PG8_BAR;
#undef PG8_SA
#undef PG8_SB
#undef PG8_STAGE
#undef PG8_LDA
#undef PG8_LDB
#undef PG8_MMA
#undef PG8_WAIT_V
#undef PG8_WAIT_L
#undef PG8_BAR
#undef PG8_SCHED
}
}

struct Args {
    const float* x_prompt; const float* x_sample; const float* norm_mix_pre; const float* norm_mix_post; const float* norm_ffn_pre; const float* norm_ffn_post;
    const float* w_in; const float* conv_w; const float* pool_w; const float* pool_scale; const float* sg_norm; const float* sg_w; const float* sg_b; const float* attn_sink;
    const float* w_branch; const float* w_gate; const float* b_gate; const float* w_out; const float* w_ffn_in; const float* w_ffn_out;
    float* out; unsigned char* ws; int ph_lo, ph_hi, coop, pad;
};

template <int MODE>
__device__ __forceinline__ void transpose_item(const float* W, int ldw, int N, bf16_t* WT, int ldt, LAS float* scr, int item, int lane) {
    const int nblk = N / 32, kb = item / nblk, nb = item % nblk, k0 = 64 * kb, n0 = 32 * nb;
#pragma unroll 8
    for (int i = 0; i < 32; ++i) { const int kk = 2 * i + (lane >> 5); scr[kk * 33 + (lane & 31)] = W[(size_t)(k0 + kk) * ldw + n0 + (lane & 31)]; }
    asm volatile("s_waitcnt lgkmcnt(0)" ::: "memory");
    const int c = lane & 7;
#pragma unroll
    for (int j = 0; j < 4; ++j) { const int n = (lane >> 3) + 8 * j; const LAS float* s = scr + (8 * c) * 33 + n;
        u32x4 o; o.x = cvt_pk_bf16(s[0 * 33], s[1 * 33]); o.y = cvt_pk_bf16(s[2 * 33], s[3 * 33]); o.z = cvt_pk_bf16(s[4 * 33], s[5 * 33]); o.w = cvt_pk_bf16(s[6 * 33], s[7 * 33]);
        int drow = n0 + n;
        if (MODE == 1) { const int sc = n0 + n, isg = sc >= DFF ? 1 : 0, f = sc - isg * DFF; drow = 256 * (f >> 7) + 128 * isg + (f & 127); }
        *(u32x4*)(WT + (size_t)drow * ldt + k0 + 8 * c) = o; }
    asm volatile("s_waitcnt lgkmcnt(0)" ::: "memory");
}

__device__ __forceinline__ void phase_prologue(const Args& a, LAS unsigned char* lds, int wid, int lane) {
    LAS float* scr = (LAS float*)(lds + wid * 16384);
    const int gw = blockIdx.x * NWAVES + wid, NGW = gridDim.x * NWAVES;
    constexpr int I_IN = 16 * 64, I_G = 16 * 32, I_B = 16 * 32, I_O = 16 * 32, I_FI = 16 * 176, I_FO = 44 * 32, I_PW = 2;
    constexpr int I_LAYER = I_IN + 4 * I_G + I_B + I_O + I_FI + I_FO + 4 * I_PW;
    for (int it = gw; it < DEPTH * I_LAYER; it += NGW) {
        const int l = it / I_LAYER; int r = it % I_LAYER;
        unsigned char* wl = a.ws + WS_W + (size_t)l * W_LAYER;
        if (r < I_IN) { transpose_item<0>(a.w_in + (size_t)l * DM * DIN, DIN, DIN, (bf16_t*)(wl + W_IN), DM, scr, r, lane); continue; } r -= I_IN;
        if (r < 4 * I_G) { const int b = r / I_G; transpose_item<0>(a.w_gate + ((size_t)l * 4 + b) * DM * DM, DM, DM, (bf16_t*)(wl + W_G) + (size_t)b * DM * DM, DM, scr, r % I_G, lane); continue; } r -= 4 * I_G;
        if (r < I_B) { transpose_item<0>(a.w_branch + (size_t)l * DM * DM, DM, DM, (bf16_t*)(wl + W_B), DM, scr, r, lane); continue; } r -= I_B;
        if (r < I_O) { transpose_item<0>(a.w_out + (size_t)l * DM * DM, DM, DM, (bf16_t*)(wl + W_OUT), DM, scr, r, lane); continue; } r -= I_O;
        if (r < I_FI) { transpose_item<1>(a.w_ffn_in + (size_t)l * DM * NFI, NFI, NFI, (bf16_t*)(wl + W_FI), DM, scr, r, lane); continue; } r -= I_FI;
        if (r < I_FO) { transpose_item<0>(a.w_ffn_out + (size_t)l * DFF * DM, DM, DM, (bf16_t*)(wl + W_FO), DFF, scr, r, lane); continue; } r -= I_FO;
        { const int g = r / I_PW; transpose_item<0>(a.pool_w + ((size_t)l * 4 + g) * 4096, 64, 64, (bf16_t*)(wl + W_PW) + g * 4096, 64, scr, r % I_PW, lane); }
    }
    const int gt = blockIdx.x * NTHR + threadIdx.x, NGT = gridDim.x * NTHR;
    for (int i = gt; i < DEPTH * 65536 / 4; i += NGT) { const int l = (i * 4) / 65536, o = (i * 4) % 65536;
        const f32x4 v = *(const f32x4*)(a.sg_w + (size_t)l * 65536 + o); u32x2 w; w.x = cvt_pk_bf16(v[0], v[1]); w.y = cvt_pk_bf16(v[2], v[3]);
        *(u32x2*)((bf16_t*)(a.ws + WS_W + (size_t)l * W_LAYER + W_SG) + o) = w; }
    bf16_t* H = (bf16_t*)(a.ws + WS_H);
    for (int row0 = gw; row0 < M_TOK; row0 += 3 * NGW) {
        f32x4 v[3][4];
#pragma unroll
        for (int r = 0; r < 3; ++r) { const int row = row0 + r * NGW; const float* xr = row < M_PROMPT ? a.x_prompt + (size_t)row * DM : a.x_sample + (size_t)(row - M_PROMPT) * DM;
#pragma unroll
            for (int j = 0; j < 4; ++j) v[r][j] = ((const f32x4*)xr)[lane + 64 * j]; }
#pragma unroll
        for (int r = 0; r < 3; ++r) { const int row = row0 + r * NGW; float ss = 0.f;
#pragma unroll
            for (int j = 0; j < 4; ++j) ss += (v[r][j][0] * v[r][j][0] + v[r][j][1] * v[r][j][1]) + (v[r][j][2] * v[r][j][2] + v[r][j][3] * v[r][j][3]);
            const float rstd = __builtin_amdgcn_rsqf(wave_sum(ss) * (1.f / DM) + EPS);
#pragma unroll
            for (int j = 0; j < 4; ++j) { const f32x4 g = ((const f32x4*)a.norm_mix_pre)[lane + 64 * j]; u32x2 w; w.x = cvt_pk_bf16(v[r][j][0] * rstd * g[0], v[r][j][1] * rstd * g[1]); w.y = cvt_pk_bf16(v[r][j][2] * rstd * g[2], v[r][j][3] * rstd * g[3]);
                ((u32x2*)(H + (size_t)row * DM))[lane + 64 * j] = w; } }
    }
}

__device__ __forceinline__ void phase_resnorm(const Args& a, const bf16_t* Y, const float* gpost, const float* gnext, bool first_x, bool last_x, bf16_t* X, bf16_t* H, int wid, int lane) {
    const int gw = blockIdx.x * NWAVES + wid, NGW = gridDim.x * NWAVES;
    constexpr int RB = 4;
    for (int row0 = gw; row0 < M_TOK; row0 += RB * NGW) {
        f32x4 xv[RB][4], yv[RB][4]; float ss[RB];
#pragma unroll
        for (int r = 0; r < RB; ++r) { const int row = min(row0 + r * NGW, M_TOK - 1); ss[r] = 0.f;
#pragma unroll
            for (int j = 0; j < 4; ++j) { const u32x2 w = ((const u32x2*)(Y + (size_t)row * DM))[lane + 64 * j]; yv[r][j] = (f32x4){bflo(w.x), bfhi(w.x), bflo(w.y), bfhi(w.y)}; }
            if (first_x) { const float* xr = row < M_PROMPT ? a.x_prompt + (size_t)row * DM : a.x_sample + (size_t)(row - M_PROMPT) * DM;
#pragma unroll
                for (int j = 0; j < 4; ++j) xv[r][j] = ((const f32x4*)xr)[lane + 64 * j];
            } else {
#pragma unroll
                for (int j = 0; j < 4; ++j) { const u32x2 w = ((const u32x2*)(X + (size_t)row * DM))[lane + 64 * j]; xv[r][j] = (f32x4){bflo(w.x), bfhi(w.x), bflo(w.y), bfhi(w.y)}; }
            } }
#pragma unroll
        for (int r = 0; r < RB; ++r) { const int row = row0 + r * NGW; if (row >= M_TOK) break;
#pragma unroll
            for (int j = 0; j < 4; ++j) ss[r] += (yv[r][j][0] * yv[r][j][0] + yv[r][j][1] * yv[r][j][1]) + (yv[r][j][2] * yv[r][j][2] + yv[r][j][3] * yv[r][j][3]);
            const float rstd = __builtin_amdgcn_rsqf(wave_sum(ss[r]) * (1.f / DM) + EPS);
            float sx = 0.f;
#pragma unroll
            for (int j = 0; j < 4; ++j) { const f32x4 g = ((const f32x4*)gpost)[lane + 64 * j]; xv[r][j] = xv[r][j] + yv[r][j] * rstd * g;
                sx += (xv[r][j][0] * xv[r][j][0] + xv[r][j][1] * xv[r][j][1]) + (xv[r][j][2] * xv[r][j][2] + xv[r][j][3] * xv[r][j][3]); }
            if (last_x) {
#pragma unroll
                for (int j = 0; j < 4; ++j) ((f32x4*)(a.out + (size_t)row * DM))[lane + 64 * j] = xv[r][j];
            } else {
#pragma unroll
                for (int j = 0; j < 4; ++j) { u32x2 w; w.x = cvt_pk_bf16(xv[r][j][0], xv[r][j][1]); w.y = cvt_pk_bf16(xv[r][j][2], xv[r][j][3]); ((u32x2*)(X + (size_t)row * DM))[lane + 64 * j] = w; }
            }
            if (gnext) {
                const float rx = __builtin_amdgcn_rsqf(wave_sum(sx) * (1.f / DM) + EPS);
#pragma unroll
                for (int j = 0; j < 4; ++j) { const f32x4 g = ((const f32x4*)gnext)[lane + 64 * j]; u32x2 w; w.x = cvt_pk_bf16(xv[r][j][0] * rx * g[0], xv[r][j][1] * rx * g[1]); w.y = cvt_pk_bf16(xv[r][j][2] * rx * g[2], xv[r][j][3] * rx * g[3]);
                    ((u32x2*)(H + (size_t)row * DM))[lane + 64 * j] = w; }
            }
        }
    }
}

template <int GI>
__device__ __forceinline__ void pool_group(const bf16_t* Z, bf16_t* BR, const bf16_t* pwT, const float* pool_scale, int row, int s0, int s1, int fr, int fq) {
    constexpr int half = 1 << GI, W = 2 * half;
    const int lo = max(row - half, s0), hi = min(row + half, s1); const float inv = 1.0f / (float)(hi - lo);
    f32x4 acc[4];
#pragma unroll
    for (int d = 0; d < 4; ++d) acc[d] = (f32x4){0.f, 0.f, 0.f, 0.f};
#pragma unroll
    for (int kk = 0; kk < 2; ++kk) {
        const int c = 768 + 64 * GI + 32 * kk + 8 * fq;
        u32x4 v[W];
#pragma unroll
        for (int i = 0; i < W; ++i) { const int r2 = row - half + i; const int rc = min(max(r2, s0), s1 - 1); v[i] = *(const u32x4*)(Z + (size_t)rc * DIN + c); }
        float s[8];
#pragma unroll
        for (int j = 0; j < 8; ++j) s[j] = 0.f;
#pragma unroll
        for (int i = 0; i < W; ++i) { const int r2 = row - half + i; const float mk = (r2 >= s0 && r2 < s1) ? 1.f : 0.f;
#pragma unroll
            for (int q = 0; q < 4; ++q) { s[2 * q] += mk * bflo(v[i][q]); s[2 * q + 1] += mk * bfhi(v[i][q]); } }
        const u32x4 sv = v[half];
        u32x4 pw;
#pragma unroll
        for (int q = 0; q < 4; ++q) pw[q] = cvt_pk_bf16(s[2 * q] * inv - bflo(sv[q]), s[2 * q + 1] * inv - bfhi(sv[q]));
        const bf16x8 bfrag = __builtin_bit_cast(bf16x8, pw);
#pragma unroll
        for (int d = 0; d < 4; ++d) { const bf16x8 afrag = *(const bf16x8*)(pwT + GI * 4096 + (16 * d + fr) * 64 + 32 * kk + 8 * fq);
            acc[d] = __builtin_amdgcn_mfma_f32_16x16x32_bf16(afrag, bfrag, acc[d], 0, 0, 0); }
        __builtin_amdgcn_sched_barrier(0);
    }
#pragma unroll
    for (int d = 0; d < 4; ++d) { const int dc = 64 * GI + 16 * d + 4 * fq; const f32x4 sc = *(const f32x4*)(pool_scale + dc);
        u32x2 w; w.x = cvt_pk_bf16(acc[d][0] * sc[0], acc[d][1] * sc[1]); w.y = cvt_pk_bf16(acc[d][2] * sc[2], acc[d][3] * sc[3]);
        *(u32x2*)(BR + (size_t)row * DM + 256 + dc) = w; }
    __builtin_amdgcn_sched_barrier(0);
}
__device__ __forceinline__ void mixer_conv_pool(const bf16_t* Z, bf16_t* BR, const float* conv_w, const bf16_t* pwT, const float* pool_scale, int row0, int wid, int lane) {
    int s0, s1; seq_bounds(row0, s0, s1);
    const int tid = threadIdx.x;
#pragma unroll 1
    for (int k = 0; k < 8; ++k) { const int it = tid + k * NTHR;
        const int t = it >> 5, c8 = (it & 31) * 8, row = row0 + t;
        const int rm = max(row - 1, s0), rp = min(row + 1, s1 - 1); const float m0 = (row - 1 >= s0) ? 1.f : 0.f, m2 = (row + 1 < s1) ? 1.f : 0.f;
        const u32x4 bg = *(const u32x4*)(Z + (size_t)row * DIN + c8);
        u32x4 cg[3], xv[3];
        cg[0] = *(const u32x4*)(Z + (size_t)rm * DIN + 256 + c8); xv[0] = *(const u32x4*)(Z + (size_t)rm * DIN + 512 + c8);
        cg[1] = *(const u32x4*)(Z + (size_t)row * DIN + 256 + c8); xv[1] = *(const u32x4*)(Z + (size_t)row * DIN + 512 + c8);
        cg[2] = *(const u32x4*)(Z + (size_t)rp * DIN + 256 + c8); xv[2] = *(const u32x4*)(Z + (size_t)rp * DIN + 512 + c8);
        float cv[8];
#pragma unroll
        for (int j = 0; j < 8; ++j) cv[j] = 0.f;
#pragma unroll
        for (int d = 0; d < 3; ++d) { const float mk = d == 0 ? m0 : (d == 2 ? m2 : 1.f);
            const f32x4 w0 = *(const f32x4*)(conv_w + d * 256 + c8) * mk, w1 = *(const f32x4*)(conv_w + d * 256 + c8 + 4) * mk;
#pragma unroll
            for (int q = 0; q < 4; ++q) { cv[2 * q] += (q < 2 ? w0[2 * q] : w1[2 * q - 4]) * bflo(cg[d][q]) * bflo(xv[d][q]); cv[2 * q + 1] += (q < 2 ? w0[2 * q + 1] : w1[2 * q - 3]) * bfhi(cg[d][q]) * bfhi(xv[d][q]); } }
        u32x4 o;
#pragma unroll
        for (int q = 0; q < 4; ++q) o[q] = cvt_pk_bf16(bflo(bg[q]) * cv[2 * q], bfhi(bg[q]) * cv[2 * q + 1]);
        *(u32x4*)(BR + (size_t)row * DM + c8) = o;
    }
    const int fr = lane & 15, fq = lane >> 4; const int row = row0 + 16 * wid + fr;
    pool_group<0>(Z, BR, pwT, pool_scale, row, s0, s1, fr, fq);
    pool_group<1>(Z, BR, pwT, pool_scale, row, s0, s1, fr, fq);
    pool_group<2>(Z, BR, pwT, pool_scale, row, s0, s1, fr, fq);
    pool_group<3>(Z, BR, pwT, pool_scale, row, s0, s1, fr, fq);
}

constexpr int VLN_PITCH = 264;
__device__ __forceinline__ void mixer_spatial(const bf16_t* Z, bf16_t* BR, const float* sg_norm, const bf16_t* sgw, const float* sg_b, LAS unsigned char* lds, int row0, int wid, int lane) {
    const f32x4 gn = *(const f32x4*)(sg_norm + 4 * lane);
    u32x2 wv[16];
#pragma unroll
    for (int i = 0; i < 16; ++i) wv[i] = *(const u32x2*)(Z + (size_t)(row0 + 16 * wid + i) * DIN + 1280 + 4 * lane);
#pragma unroll
    for (int i = 0; i < 16; ++i) { const int t = 16 * wid + i; const u32x2 w = wv[i];
        f32x4 v = (f32x4){bflo(w.x), bfhi(w.x), bflo(w.y), bfhi(w.y)};
        const float mean = wave_sum((v[0] + v[1]) + (v[2] + v[3])) * (1.f / 256.f); v = v - mean;
        const float var = wave_sum((v[0] * v[0] + v[1] * v[1]) + (v[2] * v[2] + v[3] * v[3])) * (1.f / 256.f);
        const float rstd = __builtin_amdgcn_rsqf(var + EPS);
        u32x2 o; o.x = cvt_pk_bf16(v[0] * rstd * gn[0], v[1] * rstd * gn[1]); o.y = cvt_pk_bf16(v[2] * rstd * gn[2], v[3] * rstd * gn[3]);
        *(LAS u32x2*)(lds + (t * VLN_PITCH + 4 * lane) * 2) = o; }
    __syncthreads();
    const int fr = lane & 15, fq = lane >> 4, l16 = lane & 15, tq = l16 >> 2, tp = l16 & 3;
    const int t = 16 * wid + fr, row = row0 + t;
#pragma unroll 1
    for (int g = 0; g < 4; ++g) {
        bf16x8 wf[4];
#pragma unroll
        for (int kk = 0; kk < 4; ++kk) wf[kk] = *(const bf16x8*)(sgw + g * 16384 + t * 128 + 32 * kk + 8 * fq);
        const float bias = sg_b[g * 128 + t];
#pragma unroll
        for (int ct = 0; ct < 4; ++ct) { const int c0 = 64 * g + 16 * ct; f32x4 acc = (f32x4){0.f, 0.f, 0.f, 0.f};
#pragma unroll
            for (int kk = 0; kk < 4; ++kk) { const LAS unsigned char* p = lds + ((32 * kk + 8 * fq + tq) * VLN_PITCH + c0 + 4 * tp) * 2;
                const s16x4 lo = tr_read(p), hi = tr_read(p + 4 * VLN_PITCH * 2);
                const bf16x8 af = (bf16x8){lo[0], lo[1], lo[2], lo[3], hi[0], hi[1], hi[2], hi[3]};
                acc = __builtin_amdgcn_mfma_f32_16x16x32_bf16(af, wf[kk], acc, 0, 0, 0); }
            const u32x2 uw = *(const u32x2*)(Z + (size_t)row * DIN + 1024 + c0 + 4 * fq);
            u32x2 o; o.x = cvt_pk_bf16(bflo(uw.x) * (acc[0] + bias), bfhi(uw.x) * (acc[1] + bias)); o.y = cvt_pk_bf16(bflo(uw.y) * (acc[2] + bias), bfhi(uw.y) * (acc[3] + bias));
            *(u32x2*)(BR + (size_t)row * DM + 512 + c0 + 4 * fq) = o; }
    }
    __syncthreads();
}

constexpr int KV_PITCH = 72, KV_ROWS = 448, KV_BYTES = KV_ROWS * KV_PITCH * 2;
__device__ __forceinline__ void mixer_attn(const bf16_t* Z, bf16_t* BR, const float* sink, LAS unsigned char* lds, int row0, int kvh, int wid, int lane) {
    int s0, s1; seq_bounds(row0, s0, s1);
    const int tid = threadIdx.x;
    LAS unsigned char* Kl = lds; LAS unsigned char* Vl = lds + KV_BYTES;
    {   u32x4 kv[7], vv[7];
#pragma unroll
        for (int k = 0; k < 7; ++k) { const int it = tid + k * NTHR, r = it >> 3, c8 = (it & 7) * 8; const int grow = row0 - 144 + r, gc = min(max(grow, s0), s1 - 1);
            kv[k] = *(const u32x4*)(Z + (size_t)gc * DIN + 1792 + kvh * 64 + c8); vv[k] = *(const u32x4*)(Z + (size_t)gc * DIN + 1920 + kvh * 64 + c8); }
#pragma unroll
        for (int k = 0; k < 7; ++k) { const int it = tid + k * NTHR, r = it >> 3, c8 = (it & 7) * 8; const int grow = row0 - 144 + r; const bool ok = grow >= s0 && grow < s1;
            const u32x4 z4 = (u32x4){0u, 0u, 0u, 0u};
            *(LAS u32x4*)(Kl + (r * KV_PITCH + c8) * 2) = ok ? kv[k] : z4; *(LAS u32x4*)(Vl + (r * KV_PITCH + c8) * 2) = ok ? vv[k] : z4; } }
    __syncthreads();
    const int fr = lane & 15, fq = lane >> 4, tq = fr >> 2, tp = fr & 3;
    const int qrow = row0 + 16 * wid + fr;
    float frel0 = (float)(fr + 144 - 4 * fq), frlo = (float)max(-128, qrow - s1 + 1), frhi = (float)min(128, qrow - s0);
#pragma unroll 1
    for (int g = 0; g < 2; ++g) {
        asm volatile("" : "+v"(frel0), "+v"(frlo), "+v"(frhi));
        const int hq = kvh * 2 + g;
        const float slope = __builtin_amdgcn_exp2f(-2.0f * (float)(hq + 1)) * LOG2E;
        const float sk = sink[hq] * LOG2E;
        bf16x8 qf[2];
#pragma unroll
        for (int kk = 0; kk < 2; ++kk) qf[kk] = *(const bf16x8*)(Z + (size_t)qrow * DIN + 1536 + hq * 64 + 32 * kk + 8 * fq);
        f32x4 sc[18];
#pragma unroll
        for (int kt = 0; kt < 18; ++kt) { f32x4 acc = (f32x4){0.f, 0.f, 0.f, 0.f};
#pragma unroll
            for (int kk = 0; kk < 2; ++kk) { const bf16x8 kf = *(const LAS bf16x8*)(Kl + ((16 * wid + 16 * kt + fr) * KV_PITCH + 32 * kk + 8 * fq) * 2);
                acc = __builtin_amdgcn_mfma_f32_16x16x32_bf16(kf, qf[kk], acc, 0, 0, 0); }
            sc[kt] = acc; if (kt & 1) __builtin_amdgcn_sched_barrier(0); }
        float mx = sk;
#pragma unroll
        for (int kt = 0; kt < 18; ++kt)
#pragma unroll
            for (int e = 0; e < 4; ++e) { const float t = frel0 - (float)(16 * kt + e);
                float v = __builtin_fmaf(__builtin_fabsf(t), -slope, sc[kt][e] * (0.125f * LOG2E));
                const float df = t - __builtin_amdgcn_fmed3f(t, frlo, frhi);
                v = __builtin_fmaf(__builtin_fabsf(df), -1e30f, v);
                sc[kt][e] = v; mx = fmaxf(mx, v); }
        mx = fmaxf(mx, __shfl_xor(mx, 16)); mx = fmaxf(mx, __shfl_xor(mx, 32));
        float sum = 0.f;
#pragma unroll
        for (int kt = 0; kt < 18; ++kt)
#pragma unroll
            for (int e = 0; e < 4; ++e) { const float p = __builtin_amdgcn_exp2f(sc[kt][e] - mx); sc[kt][e] = p; sum += p; }
        sum += __shfl_xor(sum, 16); sum += __shfl_xor(sum, 32);
        const float rden = __builtin_amdgcn_rcpf(sum + __builtin_amdgcn_exp2f(sk - mx));
        f32x4 o[4];
#pragma unroll
        for (int d = 0; d < 4; ++d) o[d] = (f32x4){0.f, 0.f, 0.f, 0.f};
#pragma unroll
        for (int j = 0; j < 9; ++j) {
            u32x4 pw; pw.x = cvt_pk_bf16(sc[2 * j][0], sc[2 * j][1]); pw.y = cvt_pk_bf16(sc[2 * j][2], sc[2 * j][3]); pw.z = cvt_pk_bf16(sc[2 * j + 1][0], sc[2 * j + 1][1]); pw.w = cvt_pk_bf16(sc[2 * j + 1][2], sc[2 * j + 1][3]);
            const bf16x8 pf = __builtin_bit_cast(bf16x8, pw);
#pragma unroll
            for (int d = 0; d < 4; ++d) { const LAS unsigned char* p = Vl + ((16 * wid + 32 * j + 4 * fq + tq) * KV_PITCH + 16 * d + 4 * tp) * 2;
                const s16x4 lo = tr_read(p), hi = tr_read(p + 16 * KV_PITCH * 2);
                const bf16x8 vf = (bf16x8){lo[0], lo[1], lo[2], lo[3], hi[0], hi[1], hi[2], hi[3]};
                o[d] = __builtin_amdgcn_mfma_f32_16x16x32_bf16(vf, pf, o[d], 0, 0, 0); }
            __builtin_amdgcn_sched_barrier(0);
        }
#pragma unroll
        for (int d = 0; d < 4; ++d) { u32x2 w; w.x = cvt_pk_bf16(o[d][0] * rden, o[d][1] * rden); w.y = cvt_pk_bf16(o[d][2] * rden, o[d][3] * rden);
            *(u32x2*)(BR + (size_t)qrow * DM + 768 + hq * 64 + 16 * d + 4 * fq) = w; }
    }
    __syncthreads();
}

#define XB_TMO      128
#define XB_XCNT(j)  (256  + 64 * (j))
#define XB_XSUB(j)  (1280 + 64 * (j))
#define XB_XGEN(j)  (2304 + 64 * (j))
#define XB_TOP      3328
#define XB_TOPGEN   3392
#define XCD_BAR_WORDS 3456
#define XB_SPIN_CAP (1u << 18)

__device__ __forceinline__ unsigned xb_ld(unsigned* p)              { return __hip_atomic_load(p, __ATOMIC_RELAXED, __HIP_MEMORY_SCOPE_AGENT); }
__device__ __forceinline__ unsigned xb_add(unsigned* p, unsigned v) { return __hip_atomic_fetch_add(p, v, __ATOMIC_RELAXED, __HIP_MEMORY_SCOPE_AGENT); }
__device__ __forceinline__ unsigned xb_xcc_id() { return (unsigned)__builtin_amdgcn_s_getreg((3 << 11) | 20) & 0xFu; }
#define XB_SPIN(cond, bar) do { unsigned _sp = 0; while (cond) { __builtin_amdgcn_s_sleep(1); \
    if ((++_sp & 255u) == 0u) { if (xb_ld(&(bar)[XB_TMO])) break; if (_sp > XB_SPIN_CAP) { atomicAdd(&(bar)[XB_TMO], 1u); break; } } } } while (0)

struct XcdBarrier {
    unsigned* bar; unsigned x;
    volatile LAS unsigned* st;
};

__device__ __forceinline__ XcdBarrier xcd_barrier_post(unsigned* bar, volatile LAS unsigned* st) {
    XcdBarrier b; b.bar = bar; b.x = xb_xcc_id(); b.st = st;
    if (threadIdx.x == 0) (void)xb_add(&bar[XB_XCNT(b.x)], 1u);
    return b;
}
__device__ __forceinline__ void xcd_barrier_complete(unsigned* bar, unsigned x, unsigned& nloc, unsigned& nx) {
    const unsigned G = gridDim.x * gridDim.y * gridDim.z;
    unsigned sum, cnt, mine, sp = 0u;
    for (;;) {
        sum = 0u; cnt = 0u; mine = 0u;
#pragma unroll
        for (unsigned j = 0; j < 16; ++j) { const unsigned c = xb_ld(&bar[XB_XCNT(j)]); sum += c; cnt += (c > 0u) ? 1u : 0u; mine = (j == x) ? c : mine; }
        if (sum == G) break;
        __builtin_amdgcn_s_sleep(1);
        if ((++sp & 255u) == 0u) { if (xb_ld(&bar[XB_TMO])) break; if (sp > XB_SPIN_CAP) { atomicAdd(&bar[XB_TMO], 1u); break; } }
    }
    nloc = mine > 0u ? mine : 1u; nx = cnt > 0u ? cnt : 1u;
}

__device__ __forceinline__ void xcd_barrier(const XcdBarrier& b) {
    asm volatile("s_waitcnt vmcnt(0)" ::: "memory");
    __syncthreads();
    if (threadIdx.x == 0) {
        unsigned* bar = b.bar;
        __builtin_amdgcn_s_waitcnt(0);
        unsigned nloc = b.st[0], nx = b.st[1];
        if (nloc == 0u) { xcd_barrier_complete(bar, b.x, nloc, nx); b.st[0] = nloc; b.st[1] = nx; }
        const unsigned old = xb_add(&bar[XB_XSUB(b.x)], 1u);
        const unsigned gen = old / nloc;
        if (old + 1u == (gen + 1u) * nloc) {
            __builtin_amdgcn_fence(__ATOMIC_RELEASE, "agent");
            asm volatile("s_waitcnt vmcnt(0)" ::: "memory");
            const unsigned og = xb_add(&bar[XB_TOP], 1u);
            const unsigned tg = og / nx;
            if (og + 1u == (tg + 1u) * nx) xb_add(&bar[XB_TOPGEN], 1u);
            else XB_SPIN(xb_ld(&bar[XB_TOPGEN]) == tg, bar);
            __builtin_amdgcn_fence(__ATOMIC_ACQUIRE, "agent");
            xb_add(&bar[XB_XGEN(b.x)], 1u);
            asm volatile("s_waitcnt vmcnt(0)" ::: "memory");
        } else {
            XB_SPIN(xb_ld(&bar[XB_XGEN(b.x)]) == gen, bar);
            __builtin_amdgcn_fence(__ATOMIC_ACQUIRE, "agent");
            asm volatile("s_waitcnt vmcnt(0)" ::: "memory");
        }
    }
    __syncthreads();
}


constexpr int LDS_BYTES = 131072 + 1024;
constexpr int N_PHASES = 1 + 8 * DEPTH;

__global__ void __launch_bounds__(NTHR) fwd_megakernel(Args a) {
    extern __shared__ __attribute__((aligned(16))) unsigned char lds_raw[];
    LAS unsigned char* lds = (LAS unsigned char*)lds_raw;
    cg::grid_group grid = cg::this_grid();
    const int tid = threadIdx.x, lane = tid & 63, wid = __builtin_amdgcn_readfirstlane(tid >> 6);
    const int G = gridDim.x, bx = blockIdx.x;
    unsigned char* ws = a.ws;
    bf16_t* H = (bf16_t*)(ws + WS_H); bf16_t* Z = (bf16_t*)(ws + WS_Z); bf16_t* BR = (bf16_t*)(ws + WS_BR);
    bf16_t* XB = (bf16_t*)(ws + WS_X); bf16_t* MERGED = (bf16_t*)(ws + WS_MERGED); bf16_t* Y = (bf16_t*)(ws + WS_Y); bf16_t* ACT = (bf16_t*)(ws + WS_ACT);
    const int lo = a.ph_lo, hi = a.ph_hi;
    volatile LAS unsigned* bst = (volatile LAS unsigned*)(lds + 131072);
    if (tid < 2) bst[tid] = 0u;
    __syncthreads();
    XcdBarrier xbar = xcd_barrier_post((unsigned*)(ws + WS_CTL), bst);
#define IN(k) (lo <= (k) && (k) < hi)
#define SEAM(k) do { if (a.coop && IN((k) + 1)) { if (a.coop == 2) grid.sync(); else xcd_barrier(xbar); } } while (0)

    if (lo == 99) {
        const bf16_t* src = (const bf16_t*)(ws + (size_t)a.pad * MiB);
        for (size_t i = (size_t)bx * NTHR + tid; i < (size_t)M_TOK * DM; i += (size_t)G * NTHR) a.out[i] = __uint_as_float((unsigned)src[i] << 16);
        return;
    }
    if (IN(0)) { phase_prologue(a, lds, wid, lane); SEAM(0); }

#pragma unroll 1
    for (int l = 0; l < DEPTH; ++l) {
        const int p0 = 1 + 8 * l;
        int tl = threadIdx.x; asm volatile("" : "+v"(tl)); const int lane = tl & 63, wid = __builtin_amdgcn_readfirstlane(tl >> 6);
        const unsigned char* wl = ws + WS_W + (size_t)l * W_LAYER;
        const bf16_t* Win = (const bf16_t*)(wl + W_IN); const bf16_t* Wg = (const bf16_t*)(wl + W_G); const bf16_t* Wb = (const bf16_t*)(wl + W_B);
        const bf16_t* Wout = (const bf16_t*)(wl + W_OUT); const bf16_t* Wfi = (const bf16_t*)(wl + W_FI); const bf16_t* Wfo = (const bf16_t*)(wl + W_FO);
        const bf16_t* sgw = (const bf16_t*)(wl + W_SG); const bf16_t* pwT = (const bf16_t*)(wl + W_PW);

        if (IN(p0 + 0)) {
            gm::SchedPlain S{H, Win, DM, M_TOK / 256, DIN / 256, DM / 64, G, bx}; gm::EpiStoreBf16 E{Z, DIN};
            gm::gemm_phase<true>(lds, DM, S, E);
            SEAM(p0 + 0);
        }
        if (IN(p0 + 1)) {
            for (int rep = 0; rep < PROBE_MIX_REPS; ++rep)
            for (int u = bx; u < 4 * 384; u += G) { const int part = u / 384, chunk = u % 384, row0 = chunk * 128;
                if (part == 0) mixer_conv_pool(Z, BR, a.conv_w + l * 768, pwT, a.pool_scale + l * 256, row0, wid, lane);
                else if (part == 1) mixer_spatial(Z, BR, a.sg_norm + l * 256, sgw, a.sg_b + l * 512, lds, row0, wid, lane);
                else mixer_attn(Z, BR, a.attn_sink + l * 4, lds, row0, part - 2, wid, lane);
            }
            SEAM(p0 + 1);
        }
        if (IN(p0 + 2)) {
            gm::SchedGate S{H, BR, Wg, Wb, M_TOK / 256, DM / 256, G, bx};
            unsigned char* scr = ws + WS_SCR + (size_t)bx * SCR_PER_CU;
            gm::EpiGate E{a.b_gate + l * 4 * DM, MERGED, (GAS unsigned char*)scr, (GAS unsigned char*)(scr + 128 * 1024)};
            for (int rep = 0; rep < PROBE_G2_REPS; ++rep) gm::gemm_phase<true>(lds, DM, S, E);
            SEAM(p0 + 2);
        }
        if (IN(p0 + 3)) {
            gm::SchedPlain S{MERGED, Wout, DM, M_TOK / 256, DM / 256, DM / 64, G, bx}; gm::EpiStoreBf16 E{Y, DM};
            gm::gemm_phase<true>(lds, DM, S, E);
            SEAM(p0 + 3);
        }
        if (IN(p0 + 4)) { phase_resnorm(a, Y, a.norm_mix_post + l * DM, a.norm_ffn_pre + l * DM, l == 0, false, XB, H, wid, lane); SEAM(p0 + 4); }
        if (IN(p0 + 5)) {
            gm::SchedPlain S{H, Wfi, DM, M_TOK / 256, NFI / 256, DM / 64, G, bx}; gm::EpiSwiGLU E{ACT};
            for (int rep = 0; rep < PROBE_G4_REPS; ++rep) gm::gemm_phase<true>(lds, DM, S, E);
            SEAM(p0 + 5);
        }
        if (IN(p0 + 6)) {
            gm::SchedPlain S{ACT, Wfo, DFF, M_TOK / 256, DM / 256, DFF / 64, G, bx}; gm::EpiStoreBf16 E{H, DM};
            gm::gemm_phase<true>(lds, DFF, S, E);
            SEAM(p0 + 6);
        }
        if (IN(p0 + 7)) { phase_resnorm(a, H, a.norm_ffn_post + l * DM, (l + 1 < DEPTH) ? a.norm_mix_pre + (l + 1) * DM : nullptr, false, l + 1 == DEPTH, XB, H, wid, lane); SEAM(p0 + 7); }
    }
#undef IN
#undef SEAM
}

extern "C" void kernel_launch(void* const* d_in, const int* in_sizes, int n_in, void* d_out, int out_size, void* d_ws, size_t ws_size, hipStream_t stream) {
    static int grid = 0;
    if (grid == 0) {
        if (n_in != 20 || out_size != M_TOK * DM || ws_size < WS_END) { fprintf(stderr, "kernel_launch: unexpected shapes (n_in %d out %d ws %zu)\n", n_in, out_size, ws_size); grid = -1; return; }
        int dev = 0, cus = 0, per_cu = 0;
        hipGetDevice(&dev); hipDeviceGetAttribute(&cus, hipDeviceAttributeMultiprocessorCount, dev);
        if (hipFuncSetAttribute((const void*)fwd_megakernel, hipFuncAttributeMaxDynamicSharedMemorySize, LDS_BYTES) != hipSuccess) { fprintf(stderr, "kernel_launch: hipFuncSetAttribute failed\n"); grid = -1; return; }
        if (hipOccupancyMaxActiveBlocksPerMultiprocessor(&per_cu, (const void*)fwd_megakernel, NTHR, LDS_BYTES) != hipSuccess || per_cu < 1) { fprintf(stderr, "kernel_launch: occupancy query says %d\n", per_cu); per_cu = 1; }
        (void)hipGetLastError();
        grid = cus * 1;
    }
    if (grid < 0) return;
    if (hipMemsetAsync((char*)d_ws + WS_CTL, 0, 16384, stream) != hipSuccess) { fprintf(stderr, "kernel_launch: memset of barrier words failed\n"); return; }
    Args a{};
    const float** fp = (const float**)&a;
    for (int i = 0; i < 20; ++i) fp[i] = (const float*)d_in[i];
    a.out = (float*)d_out; a.ws = (unsigned char*)d_ws; a.pad = 0;
#if MK_LAUNCH_PER_PHASE
#ifdef DUMP_AFTER
    for (int p = 0; p <= DUMP_AFTER; ++p) { a.ph_lo = p; a.ph_hi = p + 1; a.coop = 0;
        hipLaunchKernelGGL(fwd_megakernel, dim3(grid), dim3(NTHR), LDS_BYTES, stream, a); }
    a.ph_lo = 99; a.ph_hi = 100; a.pad = DUMP_MIB;
    hipLaunchKernelGGL(fwd_megakernel, dim3(grid), dim3(NTHR), LDS_BYTES, stream, a);
#else
    for (int p = 0; p < N_PHASES; ++p) { a.ph_lo = p; a.ph_hi = p + 1; a.coop = 0;
        hipLaunchKernelGGL(fwd_megakernel, dim3(grid), dim3(NTHR), LDS_BYTES, stream, a); }
#endif
#else
    a.ph_lo = 0; a.ph_hi = N_PHASES; a.coop = 1;
    void* args[] = {&a};
    hipError_t e = hipLaunchCooperativeKernel((const void*)fwd_megakernel, dim3(grid), dim3(NTHR), args, LDS_BYTES, stream);
    if (e != hipSuccess) fprintf(stderr, "cooperative launch failed: %s (grid %d)\n", hipGetErrorString(e), grid);
#endif
}
```

```cpp
#include <hip/hip_runtime.h>
#include <hip/hip_cooperative_groups.h>
#include <cstdio>
#include <cstdint>
namespace cg = cooperative_groups;

#ifndef PROBE_MIX_REPS
#define PROBE_MIX_REPS 1
#endif
#ifndef PROBE_G4_REPS
#define PROBE_G4_REPS 1
#endif
#ifndef PROBE_G2_REPS
#define PROBE_G2_REPS 1
#endif
#ifndef MK_LAUNCH_PER_PHASE
#define MK_LAUNCH_PER_PHASE 0
#endif

#define LAS __attribute__((address_space(3)))
typedef unsigned short bf16_t;
typedef short bf16x8 __attribute__((ext_vector_type(8)));
typedef short s16x4 __attribute__((ext_vector_type(4)));
typedef float f32x4 __attribute__((ext_vector_type(4)));
typedef unsigned u32x4 __attribute__((ext_vector_type(4)));
typedef unsigned u32x2 __attribute__((ext_vector_type(2)));

constexpr int M_TOK = 49152, M_PROMPT = 32768, DM = 1024, DIN = 2048, DFF = 2816, NFI = 5632, DEPTH = 2;
constexpr int NWAVES = 8, NTHR = 512;
constexpr float EPS = 1e-6f;
constexpr float LOG2E = 1.4426950408889634f;

constexpr size_t MiB = 1u << 20;
constexpr size_t W_IN = 0, W_G = 4 * MiB, W_B = 12 * MiB, W_OUT = 14 * MiB, W_FI = 16 * MiB, W_FO = 27 * MiB, W_SG = 32 * MiB + 512 * 1024, W_PW = W_SG + 128 * 1024, W_LAYER = 33 * MiB;
constexpr size_t WS_W = 0, WS_H = 66 * MiB, WS_Z = 162 * MiB, WS_BR = 354 * MiB, WS_X = 450 * MiB, WS_CTL = 546 * MiB, WS_END = 547 * MiB;
constexpr size_t WS_MERGED = WS_Z, WS_SCR = WS_Z + 96 * MiB, WS_Y = WS_Z + 96 * MiB, WS_ACT = WS_Z;
constexpr size_t SCR_PER_CU = 256 * 1024;

typedef float f32x2_t __attribute__((ext_vector_type(2))); typedef __bf16 bf16x2_t __attribute__((ext_vector_type(2)));
__device__ __forceinline__ unsigned cvt_pk_bf16(float lo, float hi) { f32x2_t v = {lo, hi}; bf16x2_t b = __builtin_convertvector(v, bf16x2_t); return __builtin_bit_cast(unsigned, b); }
__device__ __forceinline__ float bflo(unsigned w) { return __uint_as_float(w << 16); }
__device__ __forceinline__ float bfhi(unsigned w) { return __uint_as_float(w & 0xffff0000u); }
__device__ __forceinline__ float wave_sum(float v) {
#pragma unroll
    for (int o = 1; o < 64; o <<= 1) v += __shfl_xor(v, o);
    return v;
}
__device__ __forceinline__ float sigmoidf_(float x) { return __builtin_amdgcn_rcpf(1.0f + __builtin_amdgcn_exp2f(-x * LOG2E)); }
__device__ __forceinline__ float sig2_(float t) { return __builtin_amdgcn_rcpf(1.0f + __builtin_amdgcn_exp2f(t)); }
__device__ __forceinline__ void seq_bounds(int row, int& s0, int& s1) { if (row < M_PROMPT) { s0 = row & ~4095; s1 = s0 + 4096; } else { s0 = M_PROMPT; s1 = M_TOK; } }
__device__ __forceinline__ s16x4 tr_read(const LAS unsigned char* p) { return __builtin_bit_cast(s16x4, __builtin_amdgcn_ds_read_tr16_b64_v4i16((LAS s16x4*)p)); }

namespace gm {
constexpr int BM = 256, BK = 64, HALF = 128, HTB = HALF * BK * 2, STAGE_BYTES = 8 * HTB, NXCD = 8, WGM = 8;
__host__ __device__ __forceinline__ int lds_byte(int r, int c) { const int st = (r >> 4) * 2 + (c >> 5), rr = r & 15, cc = c & 31, ob = rr * 64 + cc * 2; return st * 1024 + (ob ^ (((ob >> 9) & 1) << 5)); }
__host__ __device__ __forceinline__ void stage_rc(int b, int& R, int& C) { const int st = b / 1024, sb = b % 1024, swz = sb ^ (((sb >> 9) & 1) << 5); R = (st >> 1) * 16 + swz / 64; C = (st & 1) * 32 + (swz % 64) / 2; }
__host__ __device__ __forceinline__ int perm32(int rho) { const int n = rho >> 4, i = rho & 15; return 8 * (i >> 2) + 4 * n + (i & 3); }

struct Unit { const char* A; const char* B; int nt, pm, pn, tag; };

__device__ __forceinline__ void tile_of(int L, int nM, int nN, int& pm, int& pn) {
    const int nwg = nM * nN; int wgid = L;
    { const int q = nwg / NXCD, r = nwg % NXCD, xcd = wgid % NXCD, off = wgid / NXCD; wgid = (xcd < r ? xcd * (q + 1) : r * (q + 1) + (xcd - r) * q) + off; }
    const int nig = WGM * nN, gid = wgid / nig, fm = gid * WGM, gsz = (nM - fm) < WGM ? (nM - fm) : WGM;
    pm = fm + ((wgid % nig) % gsz); pn = (wgid % nig) / gsz;
}
struct SchedPlain {
    const bf16_t* A; const bf16_t* B; int pitch, nM, nN, nt, G, c;
    __device__ __forceinline__ bool next(int i, Unit& u) const {
        const int L = i * G + c; if (L >= nM * nN) return false;
        tile_of(L, nM, nN, u.pm, u.pn);
        u.A = (const char*)(A + (size_t)u.pm * BM * pitch); u.B = (const char*)(B + (size_t)u.pn * BM * pitch); u.nt = nt; u.tag = 0; return true;
    }
};
struct SchedGate {
    const bf16_t* H; const bf16_t* BR; const bf16_t* WG; const bf16_t* WB; int nM, nN, G, c;
    __device__ __forceinline__ bool next(int i, Unit& u) const {
        const int ti = i >> 3, sub = i & 7; const int L = ti * G + c; if (L >= nM * nN) return false;
        tile_of(L, nM, nN, u.pm, u.pn);
        const int b = sub >> 1; u.tag = sub;
        if ((sub & 1) == 0) { u.A = (const char*)(H + (size_t)u.pm * BM * DM); u.B = (const char*)(WG + (size_t)b * DM * DM + (size_t)u.pn * BM * DM); u.nt = 16; }
        else { u.A = (const char*)(BR + (size_t)u.pm * BM * DM + 256 * b); u.B = (const char*)(WB + (size_t)u.pn * BM * DM + 256 * b); u.nt = 4; }
        return true;
    }
};

struct EpiStoreBf16 {
    bf16_t* O; int ldc;
    __device__ __forceinline__ void operator()(const f32x4 (&acc)[2][2][4][2], const Unit& u, int wr, int wc, int fr, int fq) const {
        const int row0 = u.pm * BM + wr * 64 + fr, col0 = u.pn * BM + wc * 32 + 8 * fq;
#pragma unroll
        for (int ai = 0; ai < 2; ++ai)
#pragma unroll
            for (int m = 0; m < 4; ++m) { bf16_t* rowp = O + (size_t)(row0 + ai * HALF + m * 16) * ldc + col0;
#pragma unroll
                for (int bj = 0; bj < 2; ++bj) { const f32x4 v0 = acc[ai][bj][m][0], v1 = acc[ai][bj][m][1];
                    u32x4 w; w.x = cvt_pk_bf16(v0[0], v0[1]); w.y = cvt_pk_bf16(v0[2], v0[3]); w.z = cvt_pk_bf16(v1[0], v1[1]); w.w = cvt_pk_bf16(v1[2], v1[3]);
                    *(u32x4*)(rowp + bj * HALF) = w; } }
    }
};
struct EpiSwiGLU {
    bf16_t* O;
    __device__ __forceinline__ void operator()(const f32x4 (&acc)[2][2][4][2], const Unit& u, int wr, int wc, int fr, int fq) const {
        const int row0 = u.pm * BM + wr * 64 + fr, col0 = u.pn * 128 + wc * 32 + 8 * fq;
#pragma unroll
        for (int ai = 0; ai < 2; ++ai)
#pragma unroll
            for (int m = 0; m < 4; ++m) { bf16_t* rowp = O + (size_t)(row0 + ai * HALF + m * 16) * DFF + col0;
                f32x4 o[2];
#pragma unroll
                for (int n = 0; n < 2; ++n) { const f32x4 av = acc[ai][0][m][n], g = acc[ai][1][m][n];
#pragma unroll
                    for (int e = 0; e < 4; ++e) o[n][e] = av[e] * sigmoidf_(av[e]) * g[e]; }
                u32x4 w; w.x = cvt_pk_bf16(o[0][0], o[0][1]); w.y = cvt_pk_bf16(o[0][2], o[0][3]); w.z = cvt_pk_bf16(o[1][0], o[1][1]); w.w = cvt_pk_bf16(o[1][2], o[1][3]);
                *(u32x4*)rowp = w; }
    }
};
#define GAS __attribute__((address_space(1)))
struct EpiGate {
    const float* bgate; bf16_t* O; GAS unsigned char* gsc; GAS unsigned char* msc;
    __device__ __forceinline__ void operator()(const f32x4 (&acc)[2][2][4][2], const Unit& u, int wr, int wc, int fr, int fq) const {
        const int tid = threadIdx.x; const int b = u.tag >> 1, kind = u.tag & 1;
        const int row0 = u.pm * BM + wr * 64 + fr, col0 = u.pn * BM + wc * 32 + 8 * fq;
        unsigned off = (unsigned)tid * 32u;
        if (kind == 0) {
            f32x4 bv[2][2];
#pragma unroll
            for (int bj = 0; bj < 2; ++bj)
#pragma unroll
                for (int n = 0; n < 2; ++n) bv[bj][n] = *(const f32x4*)(bgate + b * DM + col0 + bj * HALF + 4 * n) * (-LOG2E);
#pragma unroll
            for (int ai = 0; ai < 2; ++ai)
#pragma unroll
                for (int m = 0; m < 4; ++m) {
                    asm volatile("" : "+v"(off));
#pragma unroll
                    for (int bj = 0; bj < 2; ++bj) { const f32x4 v0 = acc[ai][bj][m][0] * (-LOG2E) + bv[bj][0], v1 = acc[ai][bj][m][1] * (-LOG2E) + bv[bj][1];
                        u32x4 w; w.x = cvt_pk_bf16(sig2_(v0[0]), sig2_(v0[1])); w.y = cvt_pk_bf16(sig2_(v0[2]), sig2_(v0[3]));
                        w.z = cvt_pk_bf16(sig2_(v1[0]), sig2_(v1[1])); w.w = cvt_pk_bf16(sig2_(v1[2]), sig2_(v1[3]));
                        *(GAS u32x4*)(gsc + off + bj * 16) = w; }
                    off += 16384u; }
        } else {
#pragma unroll
            for (int ai = 0; ai < 2; ++ai) {
                asm volatile("" : "+v"(off));
                u32x4 gw[4][2], mw[4][2];
#pragma unroll
                for (int m = 0; m < 4; ++m)
#pragma unroll
                    for (int bj = 0; bj < 2; ++bj) gw[m][bj] = *(const GAS u32x4*)(gsc + off + m * 16384 + bj * 16);
                if (b != 0) {
#pragma unroll
                    for (int m = 0; m < 4; ++m)
#pragma unroll
                        for (int bj = 0; bj < 2; ++bj) mw[m][bj] = *(const GAS u32x4*)(msc + off + m * 16384 + bj * 16);
                } else {
#pragma unroll
                    for (int m = 0; m < 4; ++m)
#pragma unroll
                        for (int bj = 0; bj < 2; ++bj) mw[m][bj] = (u32x4){0u, 0u, 0u, 0u};
                }
#pragma unroll
                for (int m = 0; m < 4; ++m) { bf16_t* rowp = O + (size_t)(row0 + ai * HALF + m * 16) * DM + col0;
#pragma unroll
                    for (int bj = 0; bj < 2; ++bj) { const u32x4 g = gw[m][bj], q = mw[m][bj];
                        const f32x4 a0 = acc[ai][bj][m][0], a1 = acc[ai][bj][m][1];
                        u32x4 w;
                        w.x = cvt_pk_bf16(bflo(g.x) * a0[0] + bflo(q.x), bfhi(g.x) * a0[1] + bfhi(q.x)); w.y = cvt_pk_bf16(bflo(g.y) * a0[2] + bflo(q.y), bfhi(g.y) * a0[3] + bfhi(q.y));
                        w.z = cvt_pk_bf16(bflo(g.z) * a1[0] + bflo(q.z), bfhi(g.z) * a1[1] + bfhi(q.z)); w.w = cvt_pk_bf16(bflo(g.w) * a1[2] + bflo(q.w), bfhi(g.w) * a1[3] + bfhi(q.w));
                        if (b != 3) *(GAS u32x4*)(msc + off + m * 16384 + bj * 16) = w;
                        else *(u32x4*)(rowp + bj * HALF) = w; } }
                off += 65536u; }
        }
    }
};

template <bool PERM, class Sched, class Epi>
__device__ __forceinline__ void gemm_phase(LAS unsigned char* lds, const int K, const Sched& S, const Epi& E) {
    int tid_ = threadIdx.x; asm volatile("" : "+v"(tid_));
    const int tid = tid_, wid = __builtin_amdgcn_readfirstlane(tid >> 6), lane = tid & 63, wr = wid >> 2, wc = wid & 3, fr = lane & 15, fq = lane >> 4;
    unsigned voffA[2], voffB[2];
#pragma unroll
    for (int i = 0; i < 2; ++i) { int R, C; stage_rc(tid * 16 + i * 8192, R, C); const int Rb = PERM ? ((R & ~31) + perm32(R & 31)) : R;
        voffA[i] = (unsigned)(R * K + C) * 2u; voffB[i] = (unsigned)(Rb * K + C) * 2u; }
    const size_t kstep = (size_t)(BK * 2);
    const size_t hstep = (size_t)HALF * K * 2;
    const unsigned ldsw = (unsigned)wid * 1024u;
    const int aoff = lds_byte(wr * 64 + fr, fq * 8), boff = lds_byte(wc * 32 + fr, fq * 8);
#define PG8_SA(b, h) (((b) * 2 + (h)) * HTB)
#define PG8_SB(b, h) ((4 + (b) * 2 + (h)) * HTB)
#define PG8_STAGE(bufoff, gbase, voff) do { _Pragma("unroll") for (int _i = 0; _i < 2; ++_i) \
        __builtin_amdgcn_global_load_lds((const unsigned*)((const char*)(gbase) + (voff)[_i]), (LAS unsigned*)(lds + (bufoff) + ldsw + _i * 8192), 16, 0, 0); } while (0)
#define PG8_LDA(dst, b, h) do { _Pragma("unroll") for (int m = 0; m < 4; ++m) _Pragma("unroll") for (int k = 0; k < 2; ++k) dst[m][k] = *(const LAS bf16x8*)(lds + PG8_SA(b, h) + aoff + m * 2048 + k * 1024); } while (0)
#define PG8_LDB(dst, b, h) do { _Pragma("unroll") for (int n = 0; n < 2; ++n) _Pragma("unroll") for (int k = 0; k < 2; ++k) dst[n][k] = *(const LAS bf16x8*)(lds + PG8_SB(b, h) + boff + n * 2048 + k * 1024); } while (0)
#define PG8_MMA(ai, bj, At, Bt) do { __builtin_amdgcn_s_setprio(1); _Pragma("unroll") for (int m = 0; m < 4; ++m) _Pragma("unroll") for (int n = 0; n < 2; ++n) _Pragma("unroll") for (int k = 0; k < 2; ++k) \
        acc[ai][bj][m][n] = __builtin_amdgcn_mfma_f32_16x16x32_bf16(Bt[n][k], At[m][k], acc[ai][bj][m][n], 0, 0, 0); __builtin_amdgcn_s_setprio(0); } while (0)
#define PG8_WAIT_V(n) asm volatile("s_waitcnt vmcnt(" #n ")" ::: "memory")
#define PG8_WAIT_L(n) asm volatile("s_waitcnt lgkmcnt(" #n ")" ::: "memory")
#define PG8_BAR __builtin_amdgcn_s_barrier()
#define PG8_SCHED __builtin_amdgcn_sched_barrier(0)
    Unit cur, nxt; int ui = 0;
    if (!S.next(0, cur)) return;
    f32x4 acc[2][2][4][2];
#pragma unroll
    for (int a = 0; a < 2; ++a)
#pragma unroll
        for (int b = 0; b < 2; ++b)
#pragma unroll
            for (int m = 0; m < 4; ++m)
#pragma unroll
                for (int n = 0; n < 2; ++n) acc[a][b][m][n] = (f32x4){0.f, 0.f, 0.f, 0.f};
    bf16x8 At[4][2], B0[2][2], B1[2][2];
    const char* cA = cur.A; const char* cB = cur.B;
    PG8_STAGE(PG8_SB(0, 0), cB, voffB); PG8_STAGE(PG8_SB(0, 1), cB + hstep, voffB); PG8_STAGE(PG8_SA(0, 0), cA, voffA); PG8_STAGE(PG8_SA(0, 1), cA + hstep, voffA);
    if (wr == 1) PG8_BAR;
    PG8_WAIT_V(2); PG8_BAR;
    PG8_STAGE(PG8_SB(1, 0), cB + kstep, voffB); PG8_STAGE(PG8_SA(1, 0), cA + kstep, voffA); PG8_STAGE(PG8_SB(1, 1), cB + hstep + kstep, voffB);
    PG8_WAIT_V(6); PG8_BAR;
    for (;;) {
        const bool has_next = S.next(ui + 1, nxt);
        const char* nA = has_next ? nxt.A : cA; const char* nB = has_next ? nxt.B : cB;
        const int nt = cur.nt;
        for (int t = 0; t < nt; t += 2) {
            const bool last = (t == nt - 2);
            const char* a1 = cA + (size_t)(t + 1) * kstep;
            const char* a2 = last ? nA : cA + (size_t)(t + 2) * kstep; const char* b2 = last ? nB : cB + (size_t)(t + 2) * kstep;
            const char* a3 = a2 + kstep; const char* b3 = b2 + kstep;
            PG8_LDB(B0, 0, 0); PG8_LDB(B1, 0, 1); PG8_SCHED; PG8_LDA(At, 0, 0); PG8_STAGE(PG8_SA(1, 1), a1 + hstep, voffA);
            PG8_WAIT_V(8); PG8_WAIT_L(0); PG8_BAR; PG8_MMA(0, 0, At, B0); PG8_MMA(0, 1, At, B1); PG8_BAR; PG8_SCHED;
            PG8_LDA(At, 0, 1); PG8_STAGE(PG8_SB(0, 0), b2, voffB); PG8_STAGE(PG8_SB(0, 1), b2 + hstep, voffB); PG8_STAGE(PG8_SA(0, 0), a2, voffA);
            PG8_WAIT_V(8); PG8_WAIT_L(0); PG8_BAR; PG8_MMA(1, 0, At, B0); PG8_MMA(1, 1, At, B1); PG8_BAR; PG8_SCHED;
            PG8_LDB(B0, 1, 0); PG8_LDB(B1, 1, 1); PG8_SCHED; PG8_LDA(At, 1, 0); PG8_STAGE(PG8_SA(0, 1), a2 + hstep, voffA);
            PG8_WAIT_V(8); PG8_WAIT_L(0); PG8_BAR; PG8_MMA(0, 0, At, B0); PG8_MMA(0, 1, At, B1); PG8_BAR; PG8_SCHED;
            PG8_LDA(At, 1, 1); PG8_STAGE(PG8_SB(1, 0), b3, voffB); PG8_STAGE(PG8_SB(1, 1), b3 + hstep, voffB); PG8_STAGE(PG8_SA(1, 0), a3, voffA);
            PG8_WAIT_V(8); PG8_WAIT_L(0); PG8_BAR; PG8_MMA(1, 0, At, B0); PG8_MMA(1, 1, At, B1); PG8_BAR; PG8_SCHED;
        }
        if (wr == 0) PG8_BAR;
        E(acc, cur, wr, wc, fr, fq);
        if (!has_next) break;
#pragma unroll
        for (int a = 0; a < 2; ++a)
#pragma unroll
            for (int b = 0; b < 2; ++b)
#pragma unroll
                for (int m = 0; m < 4; ++m)
#pragma unroll
                    for (int n = 0; n < 2; ++n) acc[a][b][m][n] = (f32x4){0.f, 0.f, 0.f, 0.f};
        cur = nxt; cA = nA; cB = nB; ++ui;
        if (wr == 1) PG8_BAR;
    }
    PG8_WAIT_V(0);
    PG8_BAR;
#undef PG8_SA
#undef PG8_SB
#undef PG8_STAGE
#undef PG8_LDA
#undef PG8_LDB
#undef PG8_MMA
#undef PG8_WAIT_V
#undef PG8_WAIT_L
#undef PG8_BAR
#undef PG8_SCHED
}
}

struct Args {
    const float* x_prompt; const float* x_sample; const float* norm_mix_pre; const float* norm_mix_post; const float* norm_ffn_pre; const float* norm_ffn_post;
    const float* w_in; const float* conv_w; const float* pool_w; const float* pool_scale; const float* sg_norm; const float* sg_w; const float* sg_b; const float* attn_sink;
    const float* w_branch; const float* w_gate; const float* b_gate; const float* w_out; const float* w_ffn_in; const float* w_ffn_out;
    float* out; unsigned char* ws; int ph_lo, ph_hi, coop, pad;
};

template <int MODE>
__device__ __forceinline__ void transpose_item(const float* W, int ldw, int N, bf16_t* WT, int ldt, LAS float* scr, int item, int lane) {
    const int nblk = N / 32, kb = item / nblk, nb = item % nblk, k0 = 64 * kb, n0 = 32 * nb;
    float wv[32];
#pragma unroll
    for (int i = 0; i < 32; ++i) wv[i] = W[(size_t)(k0 + 2 * i + (lane >> 5)) * ldw + n0 + (lane & 31)];
#pragma unroll
    for (int i = 0; i < 32; ++i) scr[(2 * i + (lane >> 5)) * 33 + (lane & 31)] = wv[i];
    asm volatile("s_waitcnt lgkmcnt(0)" ::: "memory");
    const int c = lane & 7;
#pragma unroll
    for (int j = 0; j < 4; ++j) { const int n = (lane >> 3) + 8 * j; const LAS float* s = scr + (8 * c) * 33 + n;
        u32x4 o; o.x = cvt_pk_bf16(s[0 * 33], s[1 * 33]); o.y = cvt_pk_bf16(s[2 * 33], s[3 * 33]); o.z = cvt_pk_bf16(s[4 * 33], s[5 * 33]); o.w = cvt_pk_bf16(s[6 * 33], s[7 * 33]);
        int drow = n0 + n;
        if (MODE == 1) { const int sc = n0 + n, isg = sc >= DFF ? 1 : 0, f = sc - isg * DFF; drow = 256 * (f >> 7) + 128 * isg + (f & 127); }
        *(u32x4*)(WT + (size_t)drow * ldt + k0 + 8 * c) = o; }
    asm volatile("s_waitcnt lgkmcnt(0)" ::: "memory");
}

__device__ __forceinline__ void phase_prologue(const Args& a, LAS unsigned char* lds, int wid, int lane) {
    LAS float* scr = (LAS float*)(lds + wid * 16384);
    const int gw = blockIdx.x * NWAVES + wid, NGW = gridDim.x * NWAVES;
    constexpr int I_IN = 16 * 64, I_G = 16 * 32, I_B = 16 * 32, I_O = 16 * 32, I_FI = 16 * 176, I_FO = 44 * 32, I_PW = 2;
    constexpr int I_LAYER = I_IN + 4 * I_G + I_B + I_O + I_FI + I_FO + 4 * I_PW;
    for (int it = gw; it < DEPTH * I_LAYER; it += NGW) {
        const int l = it / I_LAYER; int r = it % I_LAYER;
        unsigned char* wl = a.ws + WS_W + (size_t)l * W_LAYER;
        if (r < I_IN) { transpose_item<0>(a.w_in + (size_t)l * DM * DIN, DIN, DIN, (bf16_t*)(wl + W_IN), DM, scr, r, lane); continue; } r -= I_IN;
        if (r < 4 * I_G) { const int b = r / I_G; transpose_item<0>(a.w_gate + ((size_t)l * 4 + b) * DM * DM, DM, DM, (bf16_t*)(wl + W_G) + (size_t)b * DM * DM, DM, scr, r % I_G, lane); continue; } r -= 4 * I_G;
        if (r < I_B) { transpose_item<0>(a.w_branch + (size_t)l * DM * DM, DM, DM, (bf16_t*)(wl + W_B), DM, scr, r, lane); continue; } r -= I_B;
        if (r < I_O) { transpose_item<0>(a.w_out + (size_t)l * DM * DM, DM, DM, (bf16_t*)(wl + W_OUT), DM, scr, r, lane); continue; } r -= I_O;
        if (r < I_FI) { transpose_item<1>(a.w_ffn_in + (size_t)l * DM * NFI, NFI, NFI, (bf16_t*)(wl + W_FI), DM, scr, r, lane); continue; } r -= I_FI;
        if (r < I_FO) { transpose_item<0>(a.w_ffn_out + (size_t)l * DFF * DM, DM, DM, (bf16_t*)(wl + W_FO), DFF, scr, r, lane); continue; } r -= I_FO;
        { const int g = r / I_PW; transpose_item<0>(a.pool_w + ((size_t)l * 4 + g) * 4096, 64, 64, (bf16_t*)(wl + W_PW) + g * 4096, 64, scr, r % I_PW, lane); }
    }
    const int gt = blockIdx.x * NTHR + threadIdx.x, NGT = gridDim.x * NTHR;
    for (int i = gt; i < DEPTH * 65536 / 4; i += NGT) { const int l = (i * 4) / 65536, o = (i * 4) % 65536;
        const f32x4 v = *(const f32x4*)(a.sg_w + (size_t)l * 65536 + o); u32x2 w; w.x = cvt_pk_bf16(v[0], v[1]); w.y = cvt_pk_bf16(v[2], v[3]);
        *(u32x2*)((bf16_t*)(a.ws + WS_W + (size_t)l * W_LAYER + W_SG) + o) = w; }
    bf16_t* H = (bf16_t*)(a.ws + WS_H);
    for (int row0 = gw; row0 < M_TOK; row0 += 3 * NGW) {
        f32x4 v[3][4];
#pragma unroll
        for (int r = 0; r < 3; ++r) { const int row = row0 + r * NGW; const float* xr = row < M_PROMPT ? a.x_prompt + (size_t)row * DM : a.x_sample + (size_t)(row - M_PROMPT) * DM;
#pragma unroll
            for (int j = 0; j < 4; ++j) v[r][j] = ((const f32x4*)xr)[lane + 64 * j]; }
#pragma unroll
        for (int r = 0; r < 3; ++r) { const int row = row0 + r * NGW; float ss = 0.f;
#pragma unroll
            for (int j = 0; j < 4; ++j) ss += (v[r][j][0] * v[r][j][0] + v[r][j][1] * v[r][j][1]) + (v[r][j][2] * v[r][j][2] + v[r][j][3] * v[r][j][3]);
            const float rstd = __builtin_amdgcn_rsqf(wave_sum(ss) * (1.f / DM) + EPS);
#pragma unroll
            for (int j = 0; j < 4; ++j) { const f32x4 g = ((const f32x4*)a.norm_mix_pre)[lane + 64 * j]; u32x2 w; w.x = cvt_pk_bf16(v[r][j][0] * rstd * g[0], v[r][j][1] * rstd * g[1]); w.y = cvt_pk_bf16(v[r][j][2] * rstd * g[2], v[r][j][3] * rstd * g[3]);
                ((u32x2*)(H + (size_t)row * DM))[lane + 64 * j] = w; } }
    }
}

__device__ __forceinline__ void phase_resnorm(const Args& a, const bf16_t* Y, const float* gpost, const float* gnext, bool first_x, bool last_x, bf16_t* X, bf16_t* H, int wid, int lane) {
    const int gw = blockIdx.x * NWAVES + wid, NGW = gridDim.x * NWAVES;
    constexpr int RB = 4;
    for (int row0 = gw; row0 < M_TOK; row0 += RB * NGW) {
        f32x4 xv[RB][4], yv[RB][4]; float ss[RB];
#pragma unroll
        for (int r = 0; r < RB; ++r) { const int row = min(row0 + r * NGW, M_TOK - 1); ss[r] = 0.f;
#pragma unroll
            for (int j = 0; j < 4; ++j) { const u32x2 w = ((const u32x2*)(Y + (size_t)row * DM))[lane + 64 * j]; yv[r][j] = (f32x4){bflo(w.x), bfhi(w.x), bflo(w.y), bfhi(w.y)}; }
            if (first_x) { const float* xr = row < M_PROMPT ? a.x_prompt + (size_t)row * DM : a.x_sample + (size_t)(row - M_PROMPT) * DM;
#pragma unroll
                for (int j = 0; j < 4; ++j) xv[r][j] = ((const f32x4*)xr)[lane + 64 * j];
            } else {
#pragma unroll
                for (int j = 0; j < 4; ++j) { const u32x2 w = ((const u32x2*)(X + (size_t)row * DM))[lane + 64 * j]; xv[r][j] = (f32x4){bflo(w.x), bfhi(w.x), bflo(w.y), bfhi(w.y)}; }
            } }
#pragma unroll
        for (int r = 0; r < RB; ++r) { const int row = row0 + r * NGW; if (row >= M_TOK) break;
#pragma unroll
            for (int j = 0; j < 4; ++j) ss[r] += (yv[r][j][0] * yv[r][j][0] + yv[r][j][1] * yv[r][j][1]) + (yv[r][j][2] * yv[r][j][2] + yv[r][j][3] * yv[r][j][3]);
            const float rstd = __builtin_amdgcn_rsqf(wave_sum(ss[r]) * (1.f / DM) + EPS);
            float sx = 0.f;
#pragma unroll
            for (int j = 0; j < 4; ++j) { const f32x4 g = ((const f32x4*)gpost)[lane + 64 * j]; xv[r][j] = xv[r][j] + yv[r][j] * rstd * g;
                sx += (xv[r][j][0] * xv[r][j][0] + xv[r][j][1] * xv[r][j][1]) + (xv[r][j][2] * xv[r][j][2] + xv[r][j][3] * xv[r][j][3]); }
            if (last_x) {
#pragma unroll
                for (int j = 0; j < 4; ++j) ((f32x4*)(a.out + (size_t)row * DM))[lane + 64 * j] = xv[r][j];
            } else {
#pragma unroll
                for (int j = 0; j < 4; ++j) { u32x2 w; w.x = cvt_pk_bf16(xv[r][j][0], xv[r][j][1]); w.y = cvt_pk_bf16(xv[r][j][2], xv[r][j][3]); ((u32x2*)(X + (size_t)row * DM))[lane + 64 * j] = w; }
            }
            if (gnext) {
                const float rx = __builtin_amdgcn_rsqf(wave_sum(sx) * (1.f / DM) + EPS);
#pragma unroll
                for (int j = 0; j < 4; ++j) { const f32x4 g = ((const f32x4*)gnext)[lane + 64 * j]; u32x2 w; w.x = cvt_pk_bf16(xv[r][j][0] * rx * g[0], xv[r][j][1] * rx * g[1]); w.y = cvt_pk_bf16(xv[r][j][2] * rx * g[2], xv[r][j][3] * rx * g[3]);
                    ((u32x2*)(H + (size_t)row * DM))[lane + 64 * j] = w; }
            }
        }
    }
}

template <int GI>
__device__ __forceinline__ void pool_group(const bf16_t* Z, bf16_t* BR, const bf16_t* pwT, const float* pool_scale, int row, int s0, int s1, int fr, int fq) {
    constexpr int half = 1 << GI, W = 2 * half;
    const int lo = max(row - half, s0), hi = min(row + half, s1); const float inv = 1.0f / (float)(hi - lo);
    f32x4 acc[4];
#pragma unroll
    for (int d = 0; d < 4; ++d) acc[d] = (f32x4){0.f, 0.f, 0.f, 0.f};
#pragma unroll
    for (int kk = 0; kk < 2; ++kk) {
        const int c = 768 + 64 * GI + 32 * kk + 8 * fq;
        u32x4 v[W];
#pragma unroll
        for (int i = 0; i < W; ++i) { const int r2 = row - half + i; const int rc = min(max(r2, s0), s1 - 1); v[i] = *(const u32x4*)(Z + (size_t)rc * DIN + c); }
        float s[8];
#pragma unroll
        for (int j = 0; j < 8; ++j) s[j] = 0.f;
#pragma unroll
        for (int i = 0; i < W; ++i) { const int r2 = row - half + i; const float mk = (r2 >= s0 && r2 < s1) ? 1.f : 0.f;
#pragma unroll
            for (int q = 0; q < 4; ++q) { s[2 * q] += mk * bflo(v[i][q]); s[2 * q + 1] += mk * bfhi(v[i][q]); } }
        const u32x4 sv = v[half];
        u32x4 pw;
#pragma unroll
        for (int q = 0; q < 4; ++q) pw[q] = cvt_pk_bf16(s[2 * q] * inv - bflo(sv[q]), s[2 * q + 1] * inv - bfhi(sv[q]));
        const bf16x8 bfrag = __builtin_bit_cast(bf16x8, pw);
#pragma unroll
        for (int d = 0; d < 4; ++d) { const bf16x8 afrag = *(const bf16x8*)(pwT + GI * 4096 + (16 * d + fr) * 64 + 32 * kk + 8 * fq);
            acc[d] = __builtin_amdgcn_mfma_f32_16x16x32_bf16(afrag, bfrag, acc[d], 0, 0, 0); }
        __builtin_amdgcn_sched_barrier(0);
    }
#pragma unroll
    for (int d = 0; d < 4; ++d) { const int dc = 64 * GI + 16 * d + 4 * fq; const f32x4 sc = *(const f32x4*)(pool_scale + dc);
        u32x2 w; w.x = cvt_pk_bf16(acc[d][0] * sc[0], acc[d][1] * sc[1]); w.y = cvt_pk_bf16(acc[d][2] * sc[2], acc[d][3] * sc[3]);
        *(u32x2*)(BR + (size_t)row * DM + 256 + dc) = w; }
    __builtin_amdgcn_sched_barrier(0);
}
__device__ __forceinline__ void mixer_conv_pool(const bf16_t* Z, bf16_t* BR, const float* conv_w, const bf16_t* pwT, const float* pool_scale, int row0, int wid, int lane) {
    int s0, s1; seq_bounds(row0, s0, s1);
    const int tid = threadIdx.x;
#pragma unroll 1
    for (int k = 0; k < 8; ++k) { const int it = tid + k * NTHR;
        const int t = it >> 5, c8 = (it & 31) * 8, row = row0 + t;
        const int rm = max(row - 1, s0), rp = min(row + 1, s1 - 1); const float m0 = (row - 1 >= s0) ? 1.f : 0.f, m2 = (row + 1 < s1) ? 1.f : 0.f;
        const u32x4 bg = *(const u32x4*)(Z + (size_t)row * DIN + c8);
        u32x4 cg[3], xv[3];
        cg[0] = *(const u32x4*)(Z + (size_t)rm * DIN + 256 + c8); xv[0] = *(const u32x4*)(Z + (size_t)rm * DIN + 512 + c8);
        cg[1] = *(const u32x4*)(Z + (size_t)row * DIN + 256 + c8); xv[1] = *(const u32x4*)(Z + (size_t)row * DIN + 512 + c8);
        cg[2] = *(const u32x4*)(Z + (size_t)rp * DIN + 256 + c8); xv[2] = *(const u32x4*)(Z + (size_t)rp * DIN + 512 + c8);
        float cv[8];
#pragma unroll
        for (int j = 0; j < 8; ++j) cv[j] = 0.f;
#pragma unroll
        for (int d = 0; d < 3; ++d) { const float mk = d == 0 ? m0 : (d == 2 ? m2 : 1.f);
            const f32x4 w0 = *(const f32x4*)(conv_w + d * 256 + c8) * mk, w1 = *(const f32x4*)(conv_w + d * 256 + c8 + 4) * mk;
#pragma unroll
            for (int q = 0; q < 4; ++q) { cv[2 * q] += (q < 2 ? w0[2 * q] : w1[2 * q - 4]) * bflo(cg[d][q]) * bflo(xv[d][q]); cv[2 * q + 1] += (q < 2 ? w0[2 * q + 1] : w1[2 * q - 3]) * bfhi(cg[d][q]) * bfhi(xv[d][q]); } }
        u32x4 o;
#pragma unroll
        for (int q = 0; q < 4; ++q) o[q] = cvt_pk_bf16(bflo(bg[q]) * cv[2 * q], bfhi(bg[q]) * cv[2 * q + 1]);
        *(u32x4*)(BR + (size_t)row * DM + c8) = o;
    }
    const int fr = lane & 15, fq = lane >> 4; const int row = row0 + 16 * wid + fr;
    pool_group<0>(Z, BR, pwT, pool_scale, row, s0, s1, fr, fq);
    pool_group<1>(Z, BR, pwT, pool_scale, row, s0, s1, fr, fq);
    pool_group<2>(Z, BR, pwT, pool_scale, row, s0, s1, fr, fq);
    pool_group<3>(Z, BR, pwT, pool_scale, row, s0, s1, fr, fq);
}

constexpr int VLN_PITCH = 264;
__device__ __forceinline__ void mixer_spatial(const bf16_t* Z, bf16_t* BR, const float* sg_norm, const bf16_t* sgw, const float* sg_b, LAS unsigned char* lds, int row0, int wid, int lane) {
    const f32x4 gn = *(const f32x4*)(sg_norm + 4 * lane);
    u32x2 wv[16];
#pragma unroll
    for (int i = 0; i < 16; ++i) wv[i] = *(const u32x2*)(Z + (size_t)(row0 + 16 * wid + i) * DIN + 1280 + 4 * lane);
#pragma unroll
    for (int i = 0; i < 16; ++i) { const int t = 16 * wid + i; const u32x2 w = wv[i];
        f32x4 v = (f32x4){bflo(w.x), bfhi(w.x), bflo(w.y), bfhi(w.y)};
        const float mean = wave_sum((v[0] + v[1]) + (v[2] + v[3])) * (1.f / 256.f); v = v - mean;
        const float var = wave_sum((v[0] * v[0] + v[1] * v[1]) + (v[2] * v[2] + v[3] * v[3])) * (1.f / 256.f);
        const float rstd = __builtin_amdgcn_rsqf(var + EPS);
        u32x2 o; o.x = cvt_pk_bf16(v[0] * rstd * gn[0], v[1] * rstd * gn[1]); o.y = cvt_pk_bf16(v[2] * rstd * gn[2], v[3] * rstd * gn[3]);
        *(LAS u32x2*)(lds + (t * VLN_PITCH + 4 * lane) * 2) = o; }
    __syncthreads();
    const int fr = lane & 15, fq = lane >> 4, l16 = lane & 15, tq = l16 >> 2, tp = l16 & 3;
    const int t = 16 * wid + fr, row = row0 + t;
#pragma unroll 1
    for (int g = 0; g < 4; ++g) {
        bf16x8 wf[4];
#pragma unroll
        for (int kk = 0; kk < 4; ++kk) wf[kk] = *(const bf16x8*)(sgw + g * 16384 + t * 128 + 32 * kk + 8 * fq);
        const float bias = sg_b[g * 128 + t];
#pragma unroll
        for (int ct = 0; ct < 4; ++ct) { const int c0 = 64 * g + 16 * ct; f32x4 acc = (f32x4){0.f, 0.f, 0.f, 0.f};
#pragma unroll
            for (int kk = 0; kk < 4; ++kk) { const LAS unsigned char* p = lds + ((32 * kk + 8 * fq + tq) * VLN_PITCH + c0 + 4 * tp) * 2;
                const s16x4 lo = tr_read(p), hi = tr_read(p + 4 * VLN_PITCH * 2);
                const bf16x8 af = (bf16x8){lo[0], lo[1], lo[2], lo[3], hi[0], hi[1], hi[2], hi[3]};
                acc = __builtin_amdgcn_mfma_f32_16x16x32_bf16(af, wf[kk], acc, 0, 0, 0); }
            const u32x2 uw = *(const u32x2*)(Z + (size_t)row * DIN + 1024 + c0 + 4 * fq);
            u32x2 o; o.x = cvt_pk_bf16(bflo(uw.x) * (acc[0] + bias), bfhi(uw.x) * (acc[1] + bias)); o.y = cvt_pk_bf16(bflo(uw.y) * (acc[2] + bias), bfhi(uw.y) * (acc[3] + bias));
            *(u32x2*)(BR + (size_t)row * DM + 512 + c0 + 4 * fq) = o; }
    }
    __syncthreads();
}

constexpr int KV_PITCH = 72, KV_ROWS = 448, KV_BYTES = KV_ROWS * KV_PITCH * 2;
__device__ __forceinline__ void mixer_attn(const bf16_t* Z, bf16_t* BR, const float* sink, LAS unsigned char* lds, int row0, int kvh, int wid, int lane) {
    int s0, s1; seq_bounds(row0, s0, s1);
    const int tid = threadIdx.x;
    LAS unsigned char* Kl = lds; LAS unsigned char* Vl = lds + KV_BYTES;
    {   u32x4 kv[7], vv[7];
#pragma unroll
        for (int k = 0; k < 7; ++k) { const int it = tid + k * NTHR, r = it >> 3, c8 = (it & 7) * 8; const int grow = row0 - 144 + r, gc = min(max(grow, s0), s1 - 1);
            kv[k] = *(const u32x4*)(Z + (size_t)gc * DIN + 1792 + kvh * 64 + c8); vv[k] = *(const u32x4*)(Z + (size_t)gc * DIN + 1920 + kvh * 64 + c8); }
#pragma unroll
        for (int k = 0; k < 7; ++k) { const int it = tid + k * NTHR, r = it >> 3, c8 = (it & 7) * 8; const int grow = row0 - 144 + r; const bool ok = grow >= s0 && grow < s1;
            const u32x4 z4 = (u32x4){0u, 0u, 0u, 0u};
            *(LAS u32x4*)(Kl + (r * KV_PITCH + c8) * 2) = ok ? kv[k] : z4; *(LAS u32x4*)(Vl + (r * KV_PITCH + c8) * 2) = ok ? vv[k] : z4; } }
    __syncthreads();
    const int fr = lane & 15, fq = lane >> 4, tq = fr >> 2, tp = fr & 3;
    const int qrow = row0 + 16 * wid + fr;
    float frel0 = (float)(fr + 144 - 4 * fq), frlo = (float)max(-128, qrow - s1 + 1), frhi = (float)min(128, qrow - s0);
#pragma unroll 1
    for (int g = 0; g < 2; ++g) {
        asm volatile("" : "+v"(frel0), "+v"(frlo), "+v"(frhi));
        const int hq = kvh * 2 + g;
        const float slope = __builtin_amdgcn_exp2f(-2.0f * (float)(hq + 1)) * LOG2E;
        const float sk = sink[hq] * LOG2E;
        bf16x8 qf[2];
#pragma unroll
        for (int kk = 0; kk < 2; ++kk) qf[kk] = *(const bf16x8*)(Z + (size_t)qrow * DIN + 1536 + hq * 64 + 32 * kk + 8 * fq);
        f32x4 sc[18];
#pragma unroll
        for (int kt = 0; kt < 18; ++kt) { f32x4 acc = (f32x4){0.f, 0.f, 0.f, 0.f};
#pragma unroll
            for (int kk = 0; kk < 2; ++kk) { const bf16x8 kf = *(const LAS bf16x8*)(Kl + ((16 * wid + 16 * kt + fr) * KV_PITCH + 32 * kk + 8 * fq) * 2);
                acc = __builtin_amdgcn_mfma_f32_16x16x32_bf16(kf, qf[kk], acc, 0, 0, 0); }
            sc[kt] = acc; if (kt & 1) __builtin_amdgcn_sched_barrier(0); }
        float mx = sk;
#pragma unroll
        for (int kt = 0; kt < 18; ++kt)
#pragma unroll
            for (int e = 0; e < 4; ++e) { const float t = frel0 - (float)(16 * kt + e);
                float v = __builtin_fmaf(__builtin_fabsf(t), -slope, sc[kt][e] * (0.125f * LOG2E));
                const float df = t - __builtin_amdgcn_fmed3f(t, frlo, frhi);
                v = __builtin_fmaf(__builtin_fabsf(df), -1e30f, v);
                sc[kt][e] = v; mx = fmaxf(mx, v); }
        mx = fmaxf(mx, __shfl_xor(mx, 16)); mx = fmaxf(mx, __shfl_xor(mx, 32));
        float sum = 0.f;
#pragma unroll
        for (int kt = 0; kt < 18; ++kt)
#pragma unroll
            for (int e = 0; e < 4; ++e) { const float p = __builtin_amdgcn_exp2f(sc[kt][e] - mx); sc[kt][e] = p; sum += p; }
        sum += __shfl_xor(sum, 16); sum += __shfl_xor(sum, 32);
        const float rden = __builtin_amdgcn_rcpf(sum + __builtin_amdgcn_exp2f(sk - mx));
        f32x4 o[4];
#pragma unroll
        for (int d = 0; d < 4; ++d) o[d] = (f32x4){0.f, 0.f, 0.f, 0.f};
#pragma unroll
        for (int j = 0; j < 9; ++j) {
            u32x4 pw; pw.x = cvt_pk_bf16(sc[2 * j][0], sc[2 * j][1]); pw.y = cvt_pk_bf16(sc[2 * j][2], sc[2 * j][3]); pw.z = cvt_pk_bf16(sc[2 * j + 1][0], sc[2 * j + 1][1]); pw.w = cvt_pk_bf16(sc[2 * j + 1][2], sc[2 * j + 1][3]);
            const bf16x8 pf = __builtin_bit_cast(bf16x8, pw);
#pragma unroll
            for (int d = 0; d < 4; ++d) { const LAS unsigned char* p = Vl + ((16 * wid + 32 * j + 4 * fq + tq) * KV_PITCH + 16 * d + 4 * tp) * 2;
                const s16x4 lo = tr_read(p), hi = tr_read(p + 16 * KV_PITCH * 2);
                const bf16x8 vf = (bf16x8){lo[0], lo[1], lo[2], lo[3], hi[0], hi[1], hi[2], hi[3]};
                o[d] = __builtin_amdgcn_mfma_f32_16x16x32_bf16(vf, pf, o[d], 0, 0, 0); }
            __builtin_amdgcn_sched_barrier(0);
        }
#pragma unroll
        for (int d = 0; d < 4; ++d) { u32x2 w; w.x = cvt_pk_bf16(o[d][0] * rden, o[d][1] * rden); w.y = cvt_pk_bf16(o[d][2] * rden, o[d][3] * rden);
            *(u32x2*)(BR + (size_t)qrow * DM + 768 + hq * 64 + 16 * d + 4 * fq) = w; }
    }
    __syncthreads();
}

#define XB_TMO      128
#define XB_XCNT(j)  (256  + 64 * (j))
#define XB_XSUB(j)  (1280 + 64 * (j))
#define XB_XGEN(j)  (2304 + 64 * (j))
#define XB_TOP      3328
#define XB_TOPGEN   3392
#define XCD_BAR_WORDS 3456
#define XB_SPIN_CAP (1u << 18)

__device__ __forceinline__ unsigned xb_ld(unsigned* p)              { return __hip_atomic_load(p, __ATOMIC_RELAXED, __HIP_MEMORY_SCOPE_AGENT); }
__device__ __forceinline__ unsigned xb_add(unsigned* p, unsigned v) { return __hip_atomic_fetch_add(p, v, __ATOMIC_RELAXED, __HIP_MEMORY_SCOPE_AGENT); }
__device__ __forceinline__ unsigned xb_xcc_id() { return (unsigned)__builtin_amdgcn_s_getreg((3 << 11) | 20) & 0xFu; }
#define XB_SPIN(cond, bar) do { unsigned _sp = 0; while (cond) { __builtin_amdgcn_s_sleep(1); \
    if ((++_sp & 255u) == 0u) { if (xb_ld(&(bar)[XB_TMO])) break; if (_sp > XB_SPIN_CAP) { atomicAdd(&(bar)[XB_TMO], 1u); break; } } } } while (0)

struct XcdBarrier {
    unsigned* bar; unsigned x;
    volatile LAS unsigned* st;
};

__device__ __forceinline__ XcdBarrier xcd_barrier_post(unsigned* bar, volatile LAS unsigned* st) {
    XcdBarrier b; b.bar = bar; b.x = xb_xcc_id(); b.st = st;
    if (threadIdx.x == 0) (void)xb_add(&bar[XB_XCNT(b.x)], 1u);
    return b;
}
__device__ __forceinline__ void xcd_barrier_complete(unsigned* bar, unsigned x, unsigned& nloc, unsigned& nx) {
    const unsigned G = gridDim.x * gridDim.y * gridDim.z;
    unsigned sum, cnt, mine, sp = 0u;
    for (;;) {
        sum = 0u; cnt = 0u; mine = 0u;
#pragma unroll
        for (unsigned j = 0; j < 16; ++j) { const unsigned c = xb_ld(&bar[XB_XCNT(j)]); sum += c; cnt += (c > 0u) ? 1u : 0u; mine = (j == x) ? c : mine; }
        if (sum == G) break;
        __builtin_amdgcn_s_sleep(1);
        if ((++sp & 255u) == 0u) { if (xb_ld(&bar[XB_TMO])) break; if (sp > XB_SPIN_CAP) { atomicAdd(&bar[XB_TMO], 1u); break; } }
    }
    nloc = mine > 0u ? mine : 1u; nx = cnt > 0u ? cnt : 1u;
}

__device__ __forceinline__ void xcd_barrier(const XcdBarrier& b) {
    asm volatile("s_waitcnt vmcnt(0)" ::: "memory");
    __syncthreads();
    if (threadIdx.x == 0) {
        unsigned* bar = b.bar;
        __builtin_amdgcn_s_waitcnt(0);
        unsigned nloc = b.st[0], nx = b.st[1];
        if (nloc == 0u) { xcd_barrier_complete(bar, b.x, nloc, nx); b.st[0] = nloc; b.st[1] = nx; }
        const unsigned old = xb_add(&bar[XB_XSUB(b.x)], 1u);
        const unsigned gen = old / nloc;
        if (old + 1u == (gen + 1u) * nloc) {
            __builtin_amdgcn_fence(__ATOMIC_RELEASE, "agent");
            asm volatile("s_waitcnt vmcnt(0)" ::: "memory");
            const unsigned og = xb_add(&bar[XB_TOP], 1u);
            const unsigned tg = og / nx;
            if (og + 1u == (tg + 1u) * nx) xb_add(&bar[XB_TOPGEN], 1u);
            else XB_SPIN(xb_ld(&bar[XB_TOPGEN]) == tg, bar);
            __builtin_amdgcn_fence(__ATOMIC_ACQUIRE, "agent");
            xb_add(&bar[XB_XGEN(b.x)], 1u);
            asm volatile("s_waitcnt vmcnt(0)" ::: "memory");
        } else {
            XB_SPIN(xb_ld(&bar[XB_XGEN(b.x)]) == gen, bar);
            __builtin_amdgcn_fence(__ATOMIC_ACQUIRE, "agent");
            asm volatile("s_waitcnt vmcnt(0)" ::: "memory");
        }
    }
    __syncthreads();
}


constexpr int LDS_BYTES = 131072 + 1024;
constexpr int N_PHASES = 1 + 8 * DEPTH;

__global__ void __launch_bounds__(NTHR) fwd_megakernel(Args a) {
    extern __shared__ __attribute__((aligned(16))) unsigned char lds_raw[];
    LAS unsigned char* lds = (LAS unsigned char*)lds_raw;
    cg::grid_group grid = cg::this_grid();
    const int tid = threadIdx.x, lane = tid & 63, wid = __builtin_amdgcn_readfirstlane(tid >> 6);
    const int G = gridDim.x, bx = blockIdx.x;
    unsigned char* ws = a.ws;
    bf16_t* H = (bf16_t*)(ws + WS_H); bf16_t* Z = (bf16_t*)(ws + WS_Z); bf16_t* BR = (bf16_t*)(ws + WS_BR);
    bf16_t* XB = (bf16_t*)(ws + WS_X); bf16_t* MERGED = (bf16_t*)(ws + WS_MERGED); bf16_t* Y = (bf16_t*)(ws + WS_Y); bf16_t* ACT = (bf16_t*)(ws + WS_ACT);
    const int lo = a.ph_lo, hi = a.ph_hi;
    volatile LAS unsigned* bst = (volatile LAS unsigned*)(lds + 131072);
    if (tid < 2) bst[tid] = 0u;
    __syncthreads();
    XcdBarrier xbar = xcd_barrier_post((unsigned*)(ws + WS_CTL), bst);
#define IN(k) (lo <= (k) && (k) < hi)
#define SEAM(k) do { if (a.coop && IN((k) + 1)) { if (a.coop == 2) grid.sync(); else xcd_barrier(xbar); } } while (0)

    if (lo == 99) {
        const bf16_t* src = (const bf16_t*)(ws + (size_t)a.pad * MiB);
        for (size_t i = (size_t)bx * NTHR + tid; i < (size_t)M_TOK * DM; i += (size_t)G * NTHR) a.out[i] = __uint_as_float((unsigned)src[i] << 16);
        return;
    }
    if (IN(0)) { phase_prologue(a, lds, wid, lane); SEAM(0); }

#pragma unroll 1
    for (int l = 0; l < DEPTH; ++l) {
        const int p0 = 1 + 8 * l;
        int tl = threadIdx.x; asm volatile("" : "+v"(tl)); const int lane = tl & 63, wid = __builtin_amdgcn_readfirstlane(tl >> 6);
        const unsigned char* wl = ws + WS_W + (size_t)l * W_LAYER;
        const bf16_t* Win = (const bf16_t*)(wl + W_IN); const bf16_t* Wg = (const bf16_t*)(wl + W_G); const bf16_t* Wb = (const bf16_t*)(wl + W_B);
        const bf16_t* Wout = (const bf16_t*)(wl + W_OUT); const bf16_t* Wfi = (const bf16_t*)(wl + W_FI); const bf16_t* Wfo = (const bf16_t*)(wl + W_FO);
        const bf16_t* sgw = (const bf16_t*)(wl + W_SG); const bf16_t* pwT = (const bf16_t*)(wl + W_PW);

        if (IN(p0 + 0)) {
            gm::SchedPlain S{H, Win, DM, M_TOK / 256, DIN / 256, DM / 64, G, bx}; gm::EpiStoreBf16 E{Z, DIN};
            gm::gemm_phase<true>(lds, DM, S, E);
            SEAM(p0 + 0);
        }
        if (IN(p0 + 1)) {
            for (int rep = 0; rep < PROBE_MIX_REPS; ++rep)
            for (int u = bx; u < 4 * 384; u += G) { const int part = u / 384, chunk = u % 384, row0 = chunk * 128;
                if (part == 0) mixer_conv_pool(Z, BR, a.conv_w + l * 768, pwT, a.pool_scale + l * 256, row0, wid, lane);
                else if (part == 1) mixer_spatial(Z, BR, a.sg_norm + l * 256, sgw, a.sg_b + l * 512, lds, row0, wid, lane);
                else mixer_attn(Z, BR, a.attn_sink + l * 4, lds, row0, part - 2, wid, lane);
            }
            SEAM(p0 + 1);
        }
        if (IN(p0 + 2)) {
            gm::SchedGate S{H, BR, Wg, Wb, M_TOK / 256, DM / 256, G, bx};
            unsigned char* scr = ws + WS_SCR + (size_t)bx * SCR_PER_CU;
            gm::EpiGate E{a.b_gate + l * 4 * DM, MERGED, (GAS unsigned char*)scr, (GAS unsigned char*)(scr + 128 * 1024)};
            for (int rep = 0; rep < PROBE_G2_REPS; ++rep) gm::gemm_phase<true>(lds, DM, S, E);
            SEAM(p0 + 2);
        }
        if (IN(p0 + 3)) {
            gm::SchedPlain S{MERGED, Wout, DM, M_TOK / 256, DM / 256, DM / 64, G, bx}; gm::EpiStoreBf16 E{Y, DM};
            gm::gemm_phase<true>(lds, DM, S, E);
            SEAM(p0 + 3);
        }
        if (IN(p0 + 4)) { phase_resnorm(a, Y, a.norm_mix_post + l * DM, a.norm_ffn_pre + l * DM, l == 0, false, XB, H, wid, lane); SEAM(p0 + 4); }
        if (IN(p0 + 5)) {
            gm::SchedPlain S{H, Wfi, DM, M_TOK / 256, NFI / 256, DM / 64, G, bx}; gm::EpiSwiGLU E{ACT};
            for (int rep = 0; rep < PROBE_G4_REPS; ++rep) gm::gemm_phase<true>(lds, DM, S, E);
            SEAM(p0 + 5);
        }
        if (IN(p0 + 6)) {
            gm::SchedPlain S{ACT, Wfo, DFF, M_TOK / 256, DM / 256, DFF / 64, G, bx}; gm::EpiStoreBf16 E{H, DM};
            gm::gemm_phase<true>(lds, DFF, S, E);
            SEAM(p0 + 6);
        }
        if (IN(p0 + 7)) { phase_resnorm(a, H, a.norm_ffn_post + l * DM, (l + 1 < DEPTH) ? a.norm_mix_pre + (l + 1) * DM : nullptr, false, l + 1 == DEPTH, XB, H, wid, lane); SEAM(p0 + 7); }
    }
#undef IN
#undef SEAM
}

extern "C" void kernel_launch(void* const* d_in, const int* in_sizes, int n_in, void* d_out, int out_size, void* d_ws, size_t ws_size, hipStream_t stream) {
    static int grid = 0;
    if (grid == 0) {
        if (n_in != 20 || out_size != M_TOK * DM || ws_size < WS_END) { fprintf(stderr, "kernel_launch: unexpected shapes (n_in %d out %d ws %zu)\n", n_in, out_size, ws_size); grid = -1; return; }
        int dev = 0, cus = 0, per_cu = 0;
        hipGetDevice(&dev); hipDeviceGetAttribute(&cus, hipDeviceAttributeMultiprocessorCount, dev);
        if (hipFuncSetAttribute((const void*)fwd_megakernel, hipFuncAttributeMaxDynamicSharedMemorySize, LDS_BYTES) != hipSuccess) { fprintf(stderr, "kernel_launch: hipFuncSetAttribute failed\n"); grid = -1; return; }
        if (hipOccupancyMaxActiveBlocksPerMultiprocessor(&per_cu, (const void*)fwd_megakernel, NTHR, LDS_BYTES) != hipSuccess || per_cu < 1) { fprintf(stderr, "kernel_launch: occupancy query says %d\n", per_cu); per_cu = 1; }
        (void)hipGetLastError();
        grid = cus * 1;
    }
    if (grid < 0) return;
    if (hipMemsetAsync((char*)d_ws + WS_CTL, 0, 16384, stream) != hipSuccess) { fprintf(stderr, "kernel_launch: memset of barrier words failed\n"); return; }
    Args a{};
    const float** fp = (const float**)&a;
    for (int i = 0; i < 20; ++i) fp[i] = (const float*)d_in[i];
    a.out = (float*)d_out; a.ws = (unsigned char*)d_ws; a.pad = 0;
#if MK_LAUNCH_PER_PHASE
#ifdef DUMP_AFTER
    for (int p = 0; p <= DUMP_AFTER; ++p) { a.ph_lo = p; a.ph_hi = p + 1; a.coop = 0;
        hipLaunchKernelGGL(fwd_megakernel, dim3(grid), dim3(NTHR), LDS_BYTES, stream, a); }
    a.ph_lo = 99; a.ph_hi = 100; a.pad = DUMP_MIB;
    hipLaunchKernelGGL(fwd_megakernel, dim3(grid), dim3(NTHR), LDS_BYTES, stream, a);
#else
    for (int p = 0; p < N_PHASES; ++p) { a.ph_lo = p; a.ph_hi = p + 1; a.coop = 0;
        hipLaunchKernelGGL(fwd_megakernel, dim3(grid), dim3(NTHR), LDS_BYTES, stream, a); }
#endif
#else
    a.ph_lo = 0; a.ph_hi = N_PHASES; a.coop = 1;
    void* args[] = {&a};
    hipError_t e = hipLaunchCooperativeKernel((const void*)fwd_megakernel, dim3(grid), dim3(NTHR), args, LDS_BYTES, stream);
    if (e != hipSuccess) fprintf(stderr, "cooperative launch failed: %s (grid %d)\n", hipGetErrorString(e), grid);
#endif
}
```

```cpp
#include <hip/hip_runtime.h>
#include <hip/hip_cooperative_groups.h>
#include <cstdio>
#include <cstdint>
namespace cg = cooperative_groups;

#ifndef PROBE_MIX_REPS
#define PROBE_MIX_REPS 1
#endif
#ifndef PROBE_G4_REPS
#define PROBE_G4_REPS 1
#endif
#ifndef PROBE_G2_REPS
#define PROBE_G2_REPS 1
#endif
#ifndef MK_LAUNCH_PER_PHASE
#define MK_LAUNCH_PER_PHASE 0
#endif

#define LAS __attribute__((address_space(3)))
typedef unsigned short bf16_t;
typedef short bf16x8 __attribute__((ext_vector_type(8)));
typedef short s16x4 __attribute__((ext_vector_type(4)));
typedef float f32x4 __attribute__((ext_vector_type(4)));
typedef unsigned u32x4 __attribute__((ext_vector_type(4)));
typedef unsigned u32x2 __attribute__((ext_vector_type(2)));

constexpr int M_TOK = 49152, M_PROMPT = 32768, DM = 1024, DIN = 2048, DFF = 2816, NFI = 5632, DEPTH = 2;
constexpr int NWAVES = 8, NTHR = 512;
constexpr float EPS = 1e-6f;
constexpr float LOG2E = 1.4426950408889634f;

constexpr size_t MiB = 1u << 20;
constexpr size_t W_IN = 0, W_G = 4 * MiB, W_B = 12 * MiB, W_OUT = 14 * MiB, W_FI = 16 * MiB, W_FO = 27 * MiB, W_SG = 32 * MiB + 512 * 1024, W_PW = W_SG + 128 * 1024, W_LAYER = 33 * MiB;
constexpr size_t WS_W = 0, WS_H = 66 * MiB, WS_Z = 162 * MiB, WS_BR = 354 * MiB, WS_X = 450 * MiB, WS_CTL = 546 * MiB, WS_END = 547 * MiB;
constexpr size_t WS_MERGED = WS_Z, WS_SCR = WS_Z + 96 * MiB, WS_Y = WS_Z + 96 * MiB, WS_ACT = WS_Z;
constexpr size_t SCR_PER_CU = 256 * 1024;

typedef float f32x2_t __attribute__((ext_vector_type(2))); typedef __bf16 bf16x2_t __attribute__((ext_vector_type(2)));
__device__ __forceinline__ unsigned cvt_pk_bf16(float lo, float hi) { f32x2_t v = {lo, hi}; bf16x2_t b = __builtin_convertvector(v, bf16x2_t); return __builtin_bit_cast(unsigned, b); }
__device__ __forceinline__ float bflo(unsigned w) { return __uint_as_float(w << 16); }
__device__ __forceinline__ float bfhi(unsigned w) { return __uint_as_float(w & 0xffff0000u); }
__device__ __forceinline__ float wave_sum(float v) {
#pragma unroll
    for (int o = 1; o < 64; o <<= 1) v += __shfl_xor(v, o);
    return v;
}
__device__ __forceinline__ float sigmoidf_(float x) { return __builtin_amdgcn_rcpf(1.0f + __builtin_amdgcn_exp2f(-x * LOG2E)); }
__device__ __forceinline__ float sig2_(float t) { return __builtin_amdgcn_rcpf(1.0f + __builtin_amdgcn_exp2f(t)); }
__device__ __forceinline__ void seq_bounds(int row, int& s0, int& s1) { if (row < M_PROMPT) { s0 = row & ~4095; s1 = s0 + 4096; } else { s0 = M_PROMPT; s1 = M_TOK; } }
__device__ __forceinline__ s16x4 tr_read(const LAS unsigned char* p) { return __builtin_bit_cast(s16x4, __builtin_amdgcn_ds_read_tr16_b64_v4i16((LAS s16x4*)p)); }

namespace gm {
constexpr int BM = 256, BK = 64, HALF = 128, HTB = HALF * BK * 2, STAGE_BYTES = 8 * HTB, NXCD = 8, WGM = 8;
__host__ __device__ __forceinline__ int lds_byte(int r, int c) { const int st = (r >> 4) * 2 + (c >> 5), rr = r & 15, cc = c & 31, ob = rr * 64 + cc * 2; return st * 1024 + (ob ^ (((ob >> 9) & 1) << 5)); }
__host__ __device__ __forceinline__ void stage_rc(int b, int& R, int& C) { const int st = b / 1024, sb = b % 1024, swz = sb ^ (((sb >> 9) & 1) << 5); R = (st >> 1) * 16 + swz / 64; C = (st & 1) * 32 + (swz % 64) / 2; }
__host__ __device__ __forceinline__ int perm32(int rho) { const int n = rho >> 4, i = rho & 15; return 8 * (i >> 2) + 4 * n + (i & 3); }

struct Unit { const char* A; const char* B; int nt, pm, pn, tag; };

__device__ __forceinline__ void tile_of(int L, int nM, int nN, int& pm, int& pn) {
    const int nwg = nM * nN; int wgid = L;
    { const int q = nwg / NXCD, r = nwg % NXCD, xcd = wgid % NXCD, off = wgid / NXCD; wgid = (xcd < r ? xcd * (q + 1) : r * (q + 1) + (xcd - r) * q) + off; }
    const int nig = WGM * nN, gid = wgid / nig, fm = gid * WGM, gsz = (nM - fm) < WGM ? (nM - fm) : WGM;
    pm = fm + ((wgid % nig) % gsz); pn = (wgid % nig) / gsz;
}
struct SchedPlain {
    const bf16_t* A; const bf16_t* B; int pitch, nM, nN, nt, G, c;
    __device__ __forceinline__ bool next(int i, Unit& u) const {
        const int L = i * G + c; if (L >= nM * nN) return false;
        tile_of(L, nM, nN, u.pm, u.pn);
        u.A = (const char*)(A + (size_t)u.pm * BM * pitch); u.B = (const char*)(B + (size_t)u.pn * BM * pitch); u.nt = nt; u.tag = 0; return true;
    }
};
struct SchedGate {
    const bf16_t* H; const bf16_t* BR; const bf16_t* WG; const bf16_t* WB; int nM, nN, G, c;
    __device__ __forceinline__ bool next(int i, Unit& u) const {
        const int ti = i >> 3, sub = i & 7; const int L = ti * G + c; if (L >= nM * nN) return false;
        tile_of(L, nM, nN, u.pm, u.pn);
        const int b = sub >> 1; u.tag = sub;
        if ((sub & 1) == 0) { u.A = (const char*)(H + (size_t)u.pm * BM * DM); u.B = (const char*)(WG + (size_t)b * DM * DM + (size_t)u.pn * BM * DM); u.nt = 16; }
        else { u.A = (const char*)(BR + (size_t)u.pm * BM * DM + 256 * b); u.B = (const char*)(WB + (size_t)u.pn * BM * DM + 256 * b); u.nt = 4; }
        return true;
    }
};

struct EpiStoreBf16 {
    bf16_t* O; int ldc;
    __device__ __forceinline__ void operator()(const f32x4 (&acc)[2][2][4][2], const Unit& u, int wr, int wc, int fr, int fq) const {
        const int row0 = u.pm * BM + wr * 64 + fr, col0 = u.pn * BM + wc * 32 + 8 * fq;
#pragma unroll
        for (int ai = 0; ai < 2; ++ai)
#pragma unroll
            for (int m = 0; m < 4; ++m) { bf16_t* rowp = O + (size_t)(row0 + ai * HALF + m * 16) * ldc + col0;
#pragma unroll
                for (int bj = 0; bj < 2; ++bj) { const f32x4 v0 = acc[ai][bj][m][0], v1 = acc[ai][bj][m][1];
                    u32x4 w; w.x = cvt_pk_bf16(v0[0], v0[1]); w.y = cvt_pk_bf16(v0[2], v0[3]); w.z = cvt_pk_bf16(v1[0], v1[1]); w.w = cvt_pk_bf16(v1[2], v1[3]);
                    *(u32x4*)(rowp + bj * HALF) = w; } }
    }
};
struct EpiSwiGLU {
    bf16_t* O;
    __device__ __forceinline__ void operator()(const f32x4 (&acc)[2][2][4][2], const Unit& u, int wr, int wc, int fr, int fq) const {
        const int row0 = u.pm * BM + wr * 64 + fr, col0 = u.pn * 128 + wc * 32 + 8 * fq;
#pragma unroll
        for (int ai = 0; ai < 2; ++ai)
#pragma unroll
            for (int m = 0; m < 4; ++m) { bf16_t* rowp = O + (size_t)(row0 + ai * HALF + m * 16) * DFF + col0;
                f32x4 o[2];
#pragma unroll
                for (int n = 0; n < 2; ++n) { const f32x4 av = acc[ai][0][m][n], g = acc[ai][1][m][n];
#pragma unroll
                    for (int e = 0; e < 4; ++e) o[n][e] = av[e] * sigmoidf_(av[e]) * g[e]; }
                u32x4 w; w.x = cvt_pk_bf16(o[0][0], o[0][1]); w.y = cvt_pk_bf16(o[0][2], o[0][3]); w.z = cvt_pk_bf16(o[1][0], o[1][1]); w.w = cvt_pk_bf16(o[1][2], o[1][3]);
                *(u32x4*)rowp = w; }
    }
};
#define GAS __attribute__((address_space(1)))
struct EpiGate {
    const float* bgate; bf16_t* O; GAS unsigned char* gsc; GAS unsigned char* msc;
    __device__ __forceinline__ void operator()(const f32x4 (&acc)[2][2][4][2], const Unit& u, int wr, int wc, int fr, int fq) const {
        const int tid = threadIdx.x; const int b = u.tag >> 1, kind = u.tag & 1;
        const int row0 = u.pm * BM + wr * 64 + fr, col0 = u.pn * BM + wc * 32 + 8 * fq;
        unsigned off = (unsigned)tid * 32u;
        if (kind == 0) {
            f32x4 bv[2][2];
#pragma unroll
            for (int bj = 0; bj < 2; ++bj)
#pragma unroll
                for (int n = 0; n < 2; ++n) bv[bj][n] = *(const f32x4*)(bgate + b * DM + col0 + bj * HALF + 4 * n) * (-LOG2E);
#pragma unroll
            for (int ai = 0; ai < 2; ++ai)
#pragma unroll
                for (int m = 0; m < 4; ++m) {
                    asm volatile("" : "+v"(off));
#pragma unroll
                    for (int bj = 0; bj < 2; ++bj) { const f32x4 v0 = acc[ai][bj][m][0] * (-LOG2E) + bv[bj][0], v1 = acc[ai][bj][m][1] * (-LOG2E) + bv[bj][1];
                        u32x4 w; w.x = cvt_pk_bf16(sig2_(v0[0]), sig2_(v0[1])); w.y = cvt_pk_bf16(sig2_(v0[2]), sig2_(v0[3]));
                        w.z = cvt_pk_bf16(sig2_(v1[0]), sig2_(v1[1])); w.w = cvt_pk_bf16(sig2_(v1[2]), sig2_(v1[3]));
                        *(GAS u32x4*)(gsc + off + bj * 16) = w; }
                    off += 16384u; }
        } else {
#pragma unroll
            for (int ai = 0; ai < 2; ++ai) {
                asm volatile("" : "+v"(off));
                u32x4 gw[4][2], mw[4][2];
#pragma unroll
                for (int m = 0; m < 4; ++m)
#pragma unroll
                    for (int bj = 0; bj < 2; ++bj) gw[m][bj] = *(const GAS u32x4*)(gsc + off + m * 16384 + bj * 16);
                if (b != 0) {
#pragma unroll
                    for (int m = 0; m < 4; ++m)
#pragma unroll
                        for (int bj = 0; bj < 2; ++bj) mw[m][bj] = *(const GAS u32x4*)(msc + off + m * 16384 + bj * 16);
                } else {
#pragma unroll
                    for (int m = 0; m < 4; ++m)
#pragma unroll
                        for (int bj = 0; bj < 2; ++bj) mw[m][bj] = (u32x4){0u, 0u, 0u, 0u};
                }
#pragma unroll
                for (int m = 0; m < 4; ++m) { bf16_t* rowp = O + (size_t)(row0 + ai * HALF + m * 16) * DM + col0;
#pragma unroll
                    for (int bj = 0; bj < 2; ++bj) { const u32x4 g = gw[m][bj], q = mw[m][bj];
                        const f32x4 a0 = acc[ai][bj][m][0], a1 = acc[ai][bj][m][1];
                        u32x4 w;
                        w.x = cvt_pk_bf16(bflo(g.x) * a0[0] + bflo(q.x), bfhi(g.x) * a0[1] + bfhi(q.x)); w.y = cvt_pk_bf16(bflo(g.y) * a0[2] + bflo(q.y), bfhi(g.y) * a0[3] + bfhi(q.y));
                        w.z = cvt_pk_bf16(bflo(g.z) * a1[0] + bflo(q.z), bfhi(g.z) * a1[1] + bfhi(q.z)); w.w = cvt_pk_bf16(bflo(g.w) * a1[2] + bflo(q.w), bfhi(g.w) * a1[3] + bfhi(q.w));
                        if (b != 3) *(GAS u32x4*)(msc + off + m * 16384 + bj * 16) = w;
                        else *(u32x4*)(rowp + bj * HALF) = w; } }
                off += 65536u; }
        }
    }
};

template <bool PERM, class Sched, class Epi>
__device__ __forceinline__ void gemm_phase(LAS unsigned char* lds, const int K, const Sched& S, const Epi& E) {
    int tid_ = threadIdx.x; asm volatile("" : "+v"(tid_));
    const int tid = tid_, wid = __builtin_amdgcn_readfirstlane(tid >> 6), lane = tid & 63, wr = wid >> 2, wc = wid & 3, fr = lane & 15, fq = lane >> 4;
    unsigned voffA[2], voffB[2];
#pragma unroll
    for (int i = 0; i < 2; ++i) { int R, C; stage_rc(tid * 16 + i * 8192, R, C); const int Rb = PERM ? ((R & ~31) + perm32(R & 31)) : R;
        voffA[i] = (unsigned)(R * K + C) * 2u; voffB[i] = (unsigned)(Rb * K + C) * 2u; }
    const size_t kstep = (size_t)(BK * 2);
    const size_t hstep = (size_t)HALF * K * 2;
    const unsigned ldsw = (unsigned)wid * 1024u;
    const int aoff = lds_byte(wr * 64 + fr, fq * 8), boff = lds_byte(wc * 32 + fr, fq * 8);
#define PG8_SA(b, h) (((b) * 2 + (h)) * HTB)
#define PG8_SB(b, h) ((4 + (b) * 2 + (h)) * HTB)
#define PG8_STAGE(bufoff, gbase, voff) do { _Pragma("unroll") for (int _i = 0; _i < 2; ++_i) \
        __builtin_amdgcn_global_load_lds((const unsigned*)((const char*)(gbase) + (voff)[_i]), (LAS unsigned*)(lds + (bufoff) + ldsw + _i * 8192), 16, 0, 0); } while (0)
#define PG8_LDA(dst, b, h) do { _Pragma("unroll") for (int m = 0; m < 4; ++m) _Pragma("unroll") for (int k = 0; k < 2; ++k) dst[m][k] = *(const LAS bf16x8*)(lds + PG8_SA(b, h) + aoff + m * 2048 + k * 1024); } while (0)
#define PG8_LDB(dst, b, h) do { _Pragma("unroll") for (int n = 0; n < 2; ++n) _Pragma("unroll") for (int k = 0; k < 2; ++k) dst[n][k] = *(const LAS bf16x8*)(lds + PG8_SB(b, h) + boff + n * 2048 + k * 1024); } while (0)
#define PG8_MMA(ai, bj, At, Bt) do { __builtin_amdgcn_s_setprio(1); _Pragma("unroll") for (int m = 0; m < 4; ++m) _Pragma("unroll") for (int n = 0; n < 2; ++n) _Pragma("unroll") for (int k = 0; k < 2; ++k) \
        acc[ai][bj][m][n] = __builtin_amdgcn_mfma_f32_16x16x32_bf16(Bt[n][k], At[m][k], acc[ai][bj][m][n], 0, 0, 0); __builtin_amdgcn_s_setprio(0); } while (0)
#define PG8_WAIT_V(n) asm volatile("s_waitcnt vmcnt(" #n ")" ::: "memory")
#define PG8_WAIT_L(n) asm volatile("s_waitcnt lgkmcnt(" #n ")" ::: "memory")
#define PG8_BAR __builtin_amdgcn_s_barrier()
#define PG8_SCHED __builtin_amdgcn_sched_barrier(0)
    Unit cur, nxt; int ui = 0;
    if (!S.next(0, cur)) return;
    f32x4 acc[2][2][4][2];
#pragma unroll
    for (int a = 0; a < 2; ++a)
#pragma unroll
        for (int b = 0; b < 2; ++b)
#pragma unroll
            for (int m = 0; m < 4; ++m)
#pragma unroll
                for (int n = 0; n < 2; ++n) acc[a][b][m][n] = (f32x4){0.f, 0.f, 0.f, 0.f};
    bf16x8 At[4][2], B0[2][2], B1[2][2];
    const char* cA = cur.A; const char* cB = cur.B;
    PG8_STAGE(PG8_SB(0, 0), cB, voffB); PG8_STAGE(PG8_SB(0, 1), cB + hstep, voffB); PG8_STAGE(PG8_SA(0, 0), cA, voffA); PG8_STAGE(PG8_SA(0, 1), cA + hstep, voffA);
    if (wr == 1) PG8_BAR;
    PG8_WAIT_V(2); PG8_BAR;
    PG8_STAGE(PG8_SB(1, 0), cB + kstep, voffB); PG8_STAGE(PG8_SA(1, 0), cA + kstep, voffA); PG8_STAGE(PG8_SB(1, 1), cB + hstep + kstep, voffB);
    PG8_WAIT_V(6); PG8_BAR;
    for (;;) {
        const bool has_next = S.next(ui + 1, nxt);
        const char* nA = has_next ? nxt.A : cA; const char* nB = has_next ? nxt.B : cB;
        const int nt = cur.nt;
        for (int t = 0; t < nt; t += 2) {
            const bool last = (t == nt - 2);
            const char* a1 = cA + (size_t)(t + 1) * kstep;
            const char* a2 = last ? nA : cA + (size_t)(t + 2) * kstep; const char* b2 = last ? nB : cB + (size_t)(t + 2) * kstep;
            const char* a3 = a2 + kstep; const char* b3 = b2 + kstep;
            PG8_LDB(B0, 0, 0); PG8_LDB(B1, 0, 1); PG8_SCHED; PG8_LDA(At, 0, 0); PG8_STAGE(PG8_SA(1, 1), a1 + hstep, voffA);
            PG8_WAIT_V(8); PG8_WAIT_L(0); PG8_BAR; PG8_MMA(0, 0, At, B0); PG8_MMA(0, 1, At, B1); PG8_BAR; PG8_SCHED;
            PG8_LDA(At, 0, 1); PG8_STAGE(PG8_SB(0, 0), b2, voffB); PG8_STAGE(PG8_SB(0, 1), b2 + hstep, voffB); PG8_STAGE(PG8_SA(0, 0), a2, voffA);
            PG8_WAIT_V(8); PG8_WAIT_L(0); PG8_BAR; PG8_MMA(1, 0, At, B0); PG8_MMA(1, 1, At, B1); PG8_BAR; PG8_SCHED;
            PG8_LDB(B0, 1, 0); PG8_LDB(B1, 1, 1); PG8_SCHED; PG8_LDA(At, 1, 0); PG8_STAGE(PG8_SA(0, 1), a2 + hstep, voffA);
            PG8_WAIT_V(8); PG8_WAIT_L(0); PG8_BAR; PG8_MMA(0, 0, At, B0); PG8_MMA(0, 1, At, B1); PG8_BAR; PG8_SCHED;
            PG8_LDA(At, 1, 1); PG8_STAGE(PG8_SB(1, 0), b3, voffB); PG8_STAGE(PG8_SB(1, 1), b3 + hstep, voffB); PG8_STAGE(PG8_SA(1, 0), a3, voffA);
            PG8_WAIT_V(8); PG8_WAIT_L(0); PG8_BAR; PG8_MMA(1, 0, At, B0); PG8_MMA(1, 1, At, B1); PG8_BAR; PG8_SCHED;
        }
        if (wr == 0) PG8_BAR;
        E(acc, cur, wr, wc, fr, fq);
        if (!has_next) break;
#pragma unroll
        for (int a = 0; a < 2; ++a)
#pragma unroll
            for (int b = 0; b < 2; ++b)
#pragma unroll
                for (int m = 0; m < 4; ++m)
#pragma unroll
                    for (int n = 0; n < 2; ++n) acc[a][b][m][n] = (f32x4){0.f, 0.f, 0.f, 0.f};
        cur = nxt; cA = nA; cB = nB; ++ui;
        if (wr == 1) PG8_BAR;
    }
    PG8_WAIT_V(0);
    PG8_BAR;
#undef PG8_SA
#undef PG8_SB
#undef PG8_STAGE
#undef PG8_LDA
#undef PG8_LDB
#undef PG8_MMA
#undef PG8_WAIT_V
#undef PG8_WAIT_L
#undef PG8_BAR
#undef PG8_SCHED
}
}

struct Args {
    const float* x_prompt; const float* x_sample; const float* norm_mix_pre; const float* norm_mix_post; const float* norm_ffn_pre; const float* norm_ffn_post;
    const float* w_in; const float* conv_w; const float* pool_w; const float* pool_scale; const float* sg_norm; const float* sg_w; const float* sg_b; const float* attn_sink;
    const float* w_branch; const float* w_gate; const float* b_gate; const float* w_out; const float* w_ffn_in; const float* w_ffn_out;
    float* out; unsigned char* ws; int ph_lo, ph_hi, coop, pad;
};

template <int MODE>
__device__ __forceinline__ void transpose_item(const float* W, int ldw, int N, bf16_t* WT, int ldt, LAS float* scr, int item, int lane) {
    const int nblk = N / 32, kb = item / nblk, nb = item % nblk, k0 = 64 * kb, n0 = 32 * nb;
    float wv[32];
#pragma unroll
    for (int i = 0; i < 32; ++i) wv[i] = W[(size_t)(k0 + 2 * i + (lane >> 5)) * ldw + n0 + (lane & 31)];
#pragma unroll
    for (int i = 0; i < 32; ++i) scr[(2 * i + (lane >> 5)) * 33 + (lane & 31)] = wv[i];
    asm volatile("s_waitcnt lgkmcnt(0)" ::: "memory");
    const int c = lane & 7;
#pragma unroll
    for (int j = 0; j < 4; ++j) { const int n = (lane >> 3) + 8 * j; const LAS float* s = scr + (8 * c) * 33 + n;
        u32x4 o; o.x = cvt_pk_bf16(s[0 * 33], s[1 * 33]); o.y = cvt_pk_bf16(s[2 * 33], s[3 * 33]); o.z = cvt_pk_bf16(s[4 * 33], s[5 * 33]); o.w = cvt_pk_bf16(s[6 * 33], s[7 * 33]);
        int drow = n0 + n;
        if (MODE == 1) { const int sc = n0 + n, isg = sc >= DFF ? 1 : 0, f = sc - isg * DFF; drow = 256 * (f >> 7) + 128 * isg + (f & 127); }
        *(u32x4*)(WT + (size_t)drow * ldt + k0 + 8 * c) = o; }
    asm volatile("s_waitcnt lgkmcnt(0)" ::: "memory");
}

__device__ __forceinline__ void phase_prologue(const Args& a, LAS unsigned char* lds, int wid, int lane) {
    LAS float* scr = (LAS float*)(lds + wid * 16384);
    const int gw = blockIdx.x * NWAVES + wid, NGW = gridDim.x * NWAVES;
    constexpr int I_IN = 16 * 64, I_G = 16 * 32, I_B = 16 * 32, I_O = 16 * 32, I_FI = 16 * 176, I_FO = 44 * 32, I_PW = 2;
    constexpr int I_LAYER = I_IN + 4 * I_G + I_B + I_O + I_FI + I_FO + 4 * I_PW;
    for (int it = gw; it < DEPTH * I_LAYER; it += NGW) {
        const int l = it / I_LAYER; int r = it % I_LAYER;
        unsigned char* wl = a.ws + WS_W + (size_t)l * W_LAYER;
        if (r < I_IN) { transpose_item<0>(a.w_in + (size_t)l * DM * DIN, DIN, DIN, (bf16_t*)(wl + W_IN), DM, scr, r, lane); continue; } r -= I_IN;
        if (r < 4 * I_G) { const int b = r / I_G; transpose_item<0>(a.w_gate + ((size_t)l * 4 + b) * DM * DM, DM, DM, (bf16_t*)(wl + W_G) + (size_t)b * DM * DM, DM, scr, r % I_G, lane); continue; } r -= 4 * I_G;
        if (r < I_B) { transpose_item<0>(a.w_branch + (size_t)l * DM * DM, DM, DM, (bf16_t*)(wl + W_B), DM, scr, r, lane); continue; } r -= I_B;
        if (r < I_O) { transpose_item<0>(a.w_out + (size_t)l * DM * DM, DM, DM, (bf16_t*)(wl + W_OUT), DM, scr, r, lane); continue; } r -= I_O;
        if (r < I_FI) { transpose_item<1>(a.w_ffn_in + (size_t)l * DM * NFI, NFI, NFI, (bf16_t*)(wl + W_FI), DM, scr, r, lane); continue; } r -= I_FI;
        if (r < I_FO) { transpose_item<0>(a.w_ffn_out + (size_t)l * DFF * DM, DM, DM, (bf16_t*)(wl + W_FO), DFF, scr, r, lane); continue; } r -= I_FO;
        { const int g = r / I_PW; transpose_item<0>(a.pool_w + ((size_t)l * 4 + g) * 4096, 64, 64, (bf16_t*)(wl + W_PW) + g * 4096, 64, scr, r % I_PW, lane); }
    }
    const int gt = blockIdx.x * NTHR + threadIdx.x, NGT = gridDim.x * NTHR;
    for (int i = gt; i < DEPTH * 65536 / 4; i += NGT) { const int l = (i * 4) / 65536, o = (i * 4) % 65536;
        const f32x4 v = *(const f32x4*)(a.sg_w + (size_t)l * 65536 + o); u32x2 w; w.x = cvt_pk_bf16(v[0], v[1]); w.y = cvt_pk_bf16(v[2], v[3]);
        *(u32x2*)((bf16_t*)(a.ws + WS_W + (size_t)l * W_LAYER + W_SG) + o) = w; }
    bf16_t* H = (bf16_t*)(a.ws + WS_H);
    for (int row0 = gw; row0 < M_TOK; row0 += 3 * NGW) {
        f32x4 v[3][4];
#pragma unroll
        for (int r = 0; r < 3; ++r) { const int row = row0 + r * NGW; const float* xr = row < M_PROMPT ? a.x_prompt + (size_t)row * DM : a.x_sample + (size_t)(row - M_PROMPT) * DM;
#pragma unroll
            for (int j = 0; j < 4; ++j) v[r][j] = ((const f32x4*)xr)[lane + 64 * j]; }
#pragma unroll
        for (int r = 0; r < 3; ++r) { const int row = row0 + r * NGW; float ss = 0.f;
#pragma unroll
            for (int j = 0; j < 4; ++j) ss += (v[r][j][0] * v[r][j][0] + v[r][j][1] * v[r][j][1]) + (v[r][j][2] * v[r][j][2] + v[r][j][3] * v[r][j][3]);
            const float rstd = __builtin_amdgcn_rsqf(wave_sum(ss) * (1.f / DM) + EPS);
#pragma unroll
            for (int j = 0; j < 4; ++j) { const f32x4 g = ((const f32x4*)a.norm_mix_pre)[lane + 64 * j]; u32x2 w; w.x = cvt_pk_bf16(v[r][j][0] * rstd * g[0], v[r][j][1] * rstd * g[1]); w.y = cvt_pk_bf16(v[r][j][2] * rstd * g[2], v[r][j][3] * rstd * g[3]);
                ((u32x2*)(H + (size_t)row * DM))[lane + 64 * j] = w; } }
    }
}

__device__ __forceinline__ void phase_resnorm(const Args& a, const bf16_t* Y, const float* gpost, const float* gnext, bool first_x, bool last_x, bf16_t* X, bf16_t* H, int wid, int lane) {
    const int gw = blockIdx.x * NWAVES + wid, NGW = gridDim.x * NWAVES;
    constexpr int RB = 4;
    for (int row0 = gw; row0 < M_TOK; row0 += RB * NGW) {
        f32x4 xv[RB][4], yv[RB][4]; float ss[RB];
#pragma unroll
        for (int r = 0; r < RB; ++r) { const int row = min(row0 + r * NGW, M_TOK - 1); ss[r] = 0.f;
#pragma unroll
            for (int j = 0; j < 4; ++j) { const u32x2 w = ((const u32x2*)(Y + (size_t)row * DM))[lane + 64 * j]; yv[r][j] = (f32x4){bflo(w.x), bfhi(w.x), bflo(w.y), bfhi(w.y)}; }
            if (first_x) { const float* xr = row < M_PROMPT ? a.x_prompt + (size_t)row * DM : a.x_sample + (size_t)(row - M_PROMPT) * DM;
#pragma unroll
                for (int j = 0; j < 4; ++j) xv[r][j] = ((const f32x4*)xr)[lane + 64 * j];
            } else {
#pragma unroll
                for (int j = 0; j < 4; ++j) { const u32x2 w = ((const u32x2*)(X + (size_t)row * DM))[lane + 64 * j]; xv[r][j] = (f32x4){bflo(w.x), bfhi(w.x), bflo(w.y), bfhi(w.y)}; }
            } }
#pragma unroll
        for (int r = 0; r < RB; ++r) { const int row = row0 + r * NGW; if (row >= M_TOK) break;
#pragma unroll
            for (int j = 0; j < 4; ++j) ss[r] += (yv[r][j][0] * yv[r][j][0] + yv[r][j][1] * yv[r][j][1]) + (yv[r][j][2] * yv[r][j][2] + yv[r][j][3] * yv[r][j][3]);
            const float rstd = __builtin_amdgcn_rsqf(wave_sum(ss[r]) * (1.f / DM) + EPS);
            float sx = 0.f;
#pragma unroll
            for (int j = 0; j < 4; ++j) { const f32x4 g = ((const f32x4*)gpost)[lane + 64 * j]; xv[r][j] = xv[r][j] + yv[r][j] * rstd * g;
                sx += (xv[r][j][0] * xv[r][j][0] + xv[r][j][1] * xv[r][j][1]) + (xv[r][j][2] * xv[r][j][2] + xv[r][j][3] * xv[r][j][3]); }
            if (last_x) {
#pragma unroll
                for (int j = 0; j < 4; ++j) ((f32x4*)(a.out + (size_t)row * DM))[lane + 64 * j] = xv[r][j];
            } else {
#pragma unroll
                for (int j = 0; j < 4; ++j) { u32x2 w; w.x = cvt_pk_bf16(xv[r][j][0], xv[r][j][1]); w.y = cvt_pk_bf16(xv[r][j][2], xv[r][j][3]); ((u32x2*)(X + (size_t)row * DM))[lane + 64 * j] = w; }
            }
            if (gnext) {
                const float rx = __builtin_amdgcn_rsqf(wave_sum(sx) * (1.f / DM) + EPS);
#pragma unroll
                for (int j = 0; j < 4; ++j) { const f32x4 g = ((const f32x4*)gnext)[lane + 64 * j]; u32x2 w; w.x = cvt_pk_bf16(xv[r][j][0] * rx * g[0], xv[r][j][1] * rx * g[1]); w.y = cvt_pk_bf16(xv[r][j][2] * rx * g[2], xv[r][j][3] * rx * g[3]);
                    ((u32x2*)(H + (size_t)row * DM))[lane + 64 * j] = w; }
            }
        }
    }
}

constexpr int PL_PITCH = 264;
template <int GI>
__device__ __forceinline__ void pool_group(const LAS unsigned char* P, bf16_t* BR, const bf16_t* pwT, const float* pool_scale, int t, int row, int s0, int s1, int fr, int fq) {
    constexpr int half = 1 << GI, W = 2 * half;
    const int lo = max(row - half, s0), hi = min(row + half, s1); const float inv = 1.0f / (float)(hi - lo);
    f32x4 acc[4];
#pragma unroll
    for (int d = 0; d < 4; ++d) acc[d] = (f32x4){0.f, 0.f, 0.f, 0.f};
    bf16x8 af[2][4]; f32x4 scl[4];
#pragma unroll
    for (int kk = 0; kk < 2; ++kk)
#pragma unroll
        for (int d = 0; d < 4; ++d) af[kk][d] = *(const bf16x8*)(pwT + GI * 4096 + (16 * d + fr) * 64 + 32 * kk + 8 * fq);
#pragma unroll
    for (int d = 0; d < 4; ++d) scl[d] = *(const f32x4*)(pool_scale + 64 * GI + 16 * d + 4 * fq);
#pragma unroll
    for (int kk = 0; kk < 2; ++kk) {
        const int c = 64 * GI + 32 * kk + 8 * fq;
        float s[8];
#pragma unroll
        for (int j = 0; j < 8; ++j) s[j] = 0.f;
#pragma unroll
        for (int i = 0; i < W; ++i) { const u32x4 v = *(const LAS u32x4*)(P + ((t + 8 - half + i) * PL_PITCH + c) * 2);
#pragma unroll
            for (int q = 0; q < 4; ++q) { s[2 * q] += bflo(v[q]); s[2 * q + 1] += bfhi(v[q]); } }
        const u32x4 sv = *(const LAS u32x4*)(P + ((t + 8) * PL_PITCH + c) * 2);
        u32x4 pw;
#pragma unroll
        for (int q = 0; q < 4; ++q) pw[q] = cvt_pk_bf16(s[2 * q] * inv - bflo(sv[q]), s[2 * q + 1] * inv - bfhi(sv[q]));
        const bf16x8 bfrag = __builtin_bit_cast(bf16x8, pw);
#pragma unroll
        for (int d = 0; d < 4; ++d) acc[d] = __builtin_amdgcn_mfma_f32_16x16x32_bf16(af[kk][d], bfrag, acc[d], 0, 0, 0);
    }
#pragma unroll
    for (int d = 0; d < 4; ++d) { const int dc = 64 * GI + 16 * d + 4 * fq; const f32x4 sc = scl[d];
        u32x2 w; w.x = cvt_pk_bf16(acc[d][0] * sc[0], acc[d][1] * sc[1]); w.y = cvt_pk_bf16(acc[d][2] * sc[2], acc[d][3] * sc[3]);
        *(u32x2*)(BR + (size_t)row * DM + 256 + dc) = w; }
    __builtin_amdgcn_sched_barrier(0);
}
__device__ __forceinline__ void mixer_conv_pool(const bf16_t* Z, bf16_t* BR, const float* conv_w, const bf16_t* pwT, const float* pool_scale, LAS unsigned char* lds, int row0, int wid, int lane) {
    int s0, s1; seq_bounds(row0, s0, s1);
    const int tid = wid * 64 + lane;
    const char* Zb = (const char*)Z;
    {   u32x4 pv[9];
#pragma unroll
        for (int k = 0; k < 9; ++k) { const int it = tid + k * NTHR, r = it >> 5, c8 = (it & 31) * 8; const int grow = row0 - 8 + r, gc = min(max(grow, s0), s1 - 1);
            pv[k] = *(const u32x4*)(Zb + (unsigned)(gc * (DIN * 2) + (768 + c8) * 2)); }
#pragma unroll
        for (int k = 0; k < 9; ++k) { const int it = tid + k * NTHR, r = it >> 5, c8 = (it & 31) * 8; const int grow = row0 - 8 + r; const bool ok = grow >= s0 && grow < s1;
            *(LAS u32x4*)(lds + (r * PL_PITCH + c8) * 2) = ok ? pv[k] : (u32x4){0u, 0u, 0u, 0u}; } }
#pragma unroll 1
    for (int kb = 0; kb < 8; kb += 2) {
        u32x4 bg[2], cg[2][3], xv[2][3];
#pragma unroll
        for (int k = 0; k < 2; ++k) { const int it = tid + (kb + k) * NTHR; const int t = it >> 5, c8 = (it & 31) * 8, row = row0 + t;
            const int rm = max(row - 1, s0), rp = min(row + 1, s1 - 1);
            const unsigned o1 = (unsigned)(row * (DIN * 2) + c8 * 2), o0 = (unsigned)(rm * (DIN * 2) + c8 * 2), o2 = (unsigned)(rp * (DIN * 2) + c8 * 2);
            bg[k] = *(const u32x4*)(Zb + o1);
            cg[k][0] = *(const u32x4*)(Zb + o0 + 512); xv[k][0] = *(const u32x4*)(Zb + o0 + 1024);
            cg[k][1] = *(const u32x4*)(Zb + o1 + 512); xv[k][1] = *(const u32x4*)(Zb + o1 + 1024);
            cg[k][2] = *(const u32x4*)(Zb + o2 + 512); xv[k][2] = *(const u32x4*)(Zb + o2 + 1024); }
#pragma unroll
        for (int k = 0; k < 2; ++k) { const int it = tid + (kb + k) * NTHR; const int t = it >> 5, c8 = (it & 31) * 8, row = row0 + t;
            const float m0 = (row - 1 >= s0) ? 1.f : 0.f, m2 = (row + 1 < s1) ? 1.f : 0.f;
            float cv[8];
#pragma unroll
            for (int j = 0; j < 8; ++j) cv[j] = 0.f;
#pragma unroll
            for (int d = 0; d < 3; ++d) { const float mk = d == 0 ? m0 : (d == 2 ? m2 : 1.f);
                const f32x4 w0 = *(const f32x4*)(conv_w + d * 256 + c8) * mk, w1 = *(const f32x4*)(conv_w + d * 256 + c8 + 4) * mk;
#pragma unroll
                for (int q = 0; q < 4; ++q) { cv[2 * q] += (q < 2 ? w0[2 * q] : w1[2 * q - 4]) * bflo(cg[k][d][q]) * bflo(xv[k][d][q]); cv[2 * q + 1] += (q < 2 ? w0[2 * q + 1] : w1[2 * q - 3]) * bfhi(cg[k][d][q]) * bfhi(xv[k][d][q]); } }
            u32x4 o;
#pragma unroll
            for (int q = 0; q < 4; ++q) o[q] = cvt_pk_bf16(bflo(bg[k][q]) * cv[2 * q], bfhi(bg[k][q]) * cv[2 * q + 1]);
            *(u32x4*)(BR + (size_t)row * DM + c8) = o; }
    }
    __syncthreads();
    const int fr = lane & 15, fq = lane >> 4; const int t = 16 * wid + fr, row = row0 + t;
    pool_group<0>(lds, BR, pwT, pool_scale, t, row, s0, s1, fr, fq);
    pool_group<1>(lds, BR, pwT, pool_scale, t, row, s0, s1, fr, fq);
    pool_group<2>(lds, BR, pwT, pool_scale, t, row, s0, s1, fr, fq);
    pool_group<3>(lds, BR, pwT, pool_scale, t, row, s0, s1, fr, fq);
    __syncthreads();
}

constexpr int VLN_PITCH = 264;
__device__ __forceinline__ void mixer_spatial(const bf16_t* Z, bf16_t* BR, const float* sg_norm, const bf16_t* sgw, const float* sg_b, LAS unsigned char* lds, int row0, int wid, int lane) {
    const f32x4 gn = *(const f32x4*)(sg_norm + 4 * lane);
    u32x2 wv[16];
#pragma unroll
    for (int i = 0; i < 16; ++i) wv[i] = *(const u32x2*)(Z + (size_t)(row0 + 16 * wid + i) * DIN + 1280 + 4 * lane);
#pragma unroll
    for (int i = 0; i < 16; ++i) { const int t = 16 * wid + i; const u32x2 w = wv[i];
        f32x4 v = (f32x4){bflo(w.x), bfhi(w.x), bflo(w.y), bfhi(w.y)};
        const float mean = wave_sum((v[0] + v[1]) + (v[2] + v[3])) * (1.f / 256.f); v = v - mean;
        const float var = wave_sum((v[0] * v[0] + v[1] * v[1]) + (v[2] * v[2] + v[3] * v[3])) * (1.f / 256.f);
        const float rstd = __builtin_amdgcn_rsqf(var + EPS);
        u32x2 o; o.x = cvt_pk_bf16(v[0] * rstd * gn[0], v[1] * rstd * gn[1]); o.y = cvt_pk_bf16(v[2] * rstd * gn[2], v[3] * rstd * gn[3]);
        *(LAS u32x2*)(lds + (t * VLN_PITCH + 4 * lane) * 2) = o; }
    __syncthreads();
    const int fr = lane & 15, fq = lane >> 4, l16 = lane & 15, tq = l16 >> 2, tp = l16 & 3;
    const int t = 16 * wid + fr, row = row0 + t;
#pragma unroll 1
    for (int g = 0; g < 4; ++g) {
        bf16x8 wf[4];
#pragma unroll
        for (int kk = 0; kk < 4; ++kk) wf[kk] = *(const bf16x8*)(sgw + g * 16384 + t * 128 + 32 * kk + 8 * fq);
        const float bias = sg_b[g * 128 + t];
#pragma unroll
        for (int ct = 0; ct < 4; ++ct) { const int c0 = 64 * g + 16 * ct; f32x4 acc = (f32x4){0.f, 0.f, 0.f, 0.f};
#pragma unroll
            for (int kk = 0; kk < 4; ++kk) { const LAS unsigned char* p = lds + ((32 * kk + 8 * fq + tq) * VLN_PITCH + c0 + 4 * tp) * 2;
                const s16x4 lo = tr_read(p), hi = tr_read(p + 4 * VLN_PITCH * 2);
                const bf16x8 af = (bf16x8){lo[0], lo[1], lo[2], lo[3], hi[0], hi[1], hi[2], hi[3]};
                acc = __builtin_amdgcn_mfma_f32_16x16x32_bf16(af, wf[kk], acc, 0, 0, 0); }
            const u32x2 uw = *(const u32x2*)(Z + (size_t)row * DIN + 1024 + c0 + 4 * fq);
            u32x2 o; o.x = cvt_pk_bf16(bflo(uw.x) * (acc[0] + bias), bfhi(uw.x) * (acc[1] + bias)); o.y = cvt_pk_bf16(bflo(uw.y) * (acc[2] + bias), bfhi(uw.y) * (acc[3] + bias));
            *(u32x2*)(BR + (size_t)row * DM + 512 + c0 + 4 * fq) = o; }
    }
    __syncthreads();
}

constexpr int KV_PITCH = 72, KV_ROWS = 448, KV_BYTES = KV_ROWS * KV_PITCH * 2;
__device__ __forceinline__ void mixer_attn(const bf16_t* Z, bf16_t* BR, const float* sink, LAS unsigned char* lds, int row0, int kvh, int wid, int lane) {
    int s0, s1; seq_bounds(row0, s0, s1);
    const int tid = wid * 64 + lane;
    LAS unsigned char* Kl = lds; LAS unsigned char* Vl = lds + KV_BYTES;
    {   u32x4 kv[7], vv[7];
#pragma unroll
        for (int k = 0; k < 7; ++k) { const int it = tid + k * NTHR, r = it >> 3, c8 = (it & 7) * 8; const int grow = row0 - 144 + r, gc = min(max(grow, s0), s1 - 1);
            kv[k] = *(const u32x4*)(Z + (size_t)gc * DIN + 1792 + kvh * 64 + c8); vv[k] = *(const u32x4*)(Z + (size_t)gc * DIN + 1920 + kvh * 64 + c8); }
#pragma unroll
        for (int k = 0; k < 7; ++k) { const int it = tid + k * NTHR, r = it >> 3, c8 = (it & 7) * 8; const int grow = row0 - 144 + r; const bool ok = grow >= s0 && grow < s1;
            const u32x4 z4 = (u32x4){0u, 0u, 0u, 0u};
            *(LAS u32x4*)(Kl + (r * KV_PITCH + c8) * 2) = ok ? kv[k] : z4; *(LAS u32x4*)(Vl + (r * KV_PITCH + c8) * 2) = ok ? vv[k] : z4; } }
    __syncthreads();
    const int fr = lane & 15, fq = lane >> 4, tq = fr >> 2, tp = fr & 3;
    const int qrow = row0 + 16 * wid + fr;
    float frel0 = (float)(fr + 144 - 4 * fq), frlo = (float)max(-128, qrow - s1 + 1), frhi = (float)min(128, qrow - s0);
#pragma unroll 1
    for (int g = 0; g < 2; ++g) {
        asm volatile("" : "+v"(frel0), "+v"(frlo), "+v"(frhi));
        const int hq = kvh * 2 + g;
        const float slope = __builtin_amdgcn_exp2f(-2.0f * (float)(hq + 1)) * LOG2E;
        const float sk = sink[hq] * LOG2E;
        bf16x8 qf[2];
#pragma unroll
        for (int kk = 0; kk < 2; ++kk) qf[kk] = *(const bf16x8*)(Z + (size_t)qrow * DIN + 1536 + hq * 64 + 32 * kk + 8 * fq);
        f32x4 sc[18];
#pragma unroll
        for (int kt = 0; kt < 18; ++kt) { f32x4 acc = (f32x4){0.f, 0.f, 0.f, 0.f};
#pragma unroll
            for (int kk = 0; kk < 2; ++kk) { const bf16x8 kf = *(const LAS bf16x8*)(Kl + ((16 * wid + 16 * kt + fr) * KV_PITCH + 32 * kk + 8 * fq) * 2);
                acc = __builtin_amdgcn_mfma_f32_16x16x32_bf16(kf, qf[kk], acc, 0, 0, 0); }
            sc[kt] = acc; if (kt & 1) __builtin_amdgcn_sched_barrier(0); }
        float mx = sk;
#pragma unroll
        for (int kt = 0; kt < 18; ++kt)
#pragma unroll
            for (int e = 0; e < 4; ++e) { const float t = frel0 - (float)(16 * kt + e);
                float v = __builtin_fmaf(__builtin_fabsf(t), -slope, sc[kt][e] * (0.125f * LOG2E));
                const float df = t - __builtin_amdgcn_fmed3f(t, frlo, frhi);
                v = __builtin_fmaf(__builtin_fabsf(df), -1e30f, v);
                sc[kt][e] = v; mx = fmaxf(mx, v); }
        mx = fmaxf(mx, __shfl_xor(mx, 16)); mx = fmaxf(mx, __shfl_xor(mx, 32));
        float sum = 0.f;
#pragma unroll
        for (int kt = 0; kt < 18; ++kt)
#pragma unroll
            for (int e = 0; e < 4; ++e) { const float p = __builtin_amdgcn_exp2f(sc[kt][e] - mx); sc[kt][e] = p; sum += p; }
        sum += __shfl_xor(sum, 16); sum += __shfl_xor(sum, 32);
        const float rden = __builtin_amdgcn_rcpf(sum + __builtin_amdgcn_exp2f(sk - mx));
        f32x4 o[4];
#pragma unroll
        for (int d = 0; d < 4; ++d) o[d] = (f32x4){0.f, 0.f, 0.f, 0.f};
#pragma unroll
        for (int j = 0; j < 9; ++j) {
            u32x4 pw; pw.x = cvt_pk_bf16(sc[2 * j][0], sc[2 * j][1]); pw.y = cvt_pk_bf16(sc[2 * j][2], sc[2 * j][3]); pw.z = cvt_pk_bf16(sc[2 * j + 1][0], sc[2 * j + 1][1]); pw.w = cvt_pk_bf16(sc[2 * j + 1][2], sc[2 * j + 1][3]);
            const bf16x8 pf = __builtin_bit_cast(bf16x8, pw);
#pragma unroll
            for (int d = 0; d < 4; ++d) { const LAS unsigned char* p = Vl + ((16 * wid + 32 * j + 4 * fq + tq) * KV_PITCH + 16 * d + 4 * tp) * 2;
                const s16x4 lo = tr_read(p), hi = tr_read(p + 16 * KV_PITCH * 2);
                const bf16x8 vf = (bf16x8){lo[0], lo[1], lo[2], lo[3], hi[0], hi[1], hi[2], hi[3]};
                o[d] = __builtin_amdgcn_mfma_f32_16x16x32_bf16(vf, pf, o[d], 0, 0, 0); }
            __builtin_amdgcn_sched_barrier(0);
        }
#pragma unroll
        for (int d = 0; d < 4; ++d) { u32x2 w; w.x = cvt_pk_bf16(o[d][0] * rden, o[d][1] * rden); w.y = cvt_pk_bf16(o[d][2] * rden, o[d][3] * rden);
            *(u32x2*)(BR + (size_t)qrow * DM + 768 + hq * 64 + 16 * d + 4 * fq) = w; }
    }
    __syncthreads();
}

__device__ __forceinline__ void mixer_prefetch(const bf16_t* Z, int part, int row0, int tid, unsigned (&pf)[5]) {
    const char* Zb = (const char*)Z;
#pragma unroll
    for (int k = 0; k < 5; ++k) { int li = tid + k * NTHR; int r, boff;
        if (part == 0) { li = min(li, 2303); r = row0 - 8 + (li >> 4); boff = (li & 15) * 128; }
        else if (part == 1) { li = min(li, 1023); r = row0 + (li >> 3); boff = 2048 + (li & 7) * 128; }
        else { const int kvh = part - 2; li = min(li, 1055);
            if (li < 800) { r = row0 - 144 + (li >> 1); boff = ((li & 1) ? 3840 : 3584) + kvh * 128; }
            else { const int q = li - 800; r = row0 + (q >> 1); boff = 3072 + kvh * 256 + (q & 1) * 128; } }
        r = min(max(r, 0), M_TOK - 1);
        pf[k] = *(const unsigned*)(Zb + (unsigned)(r * (DIN * 2) + boff)); }
}

#define XB_TMO      128
#define XB_XCNT(j)  (256  + 64 * (j))
#define XB_XSUB(j)  (1280 + 64 * (j))
#define XB_XGEN(j)  (2304 + 64 * (j))
#define XB_TOP      3328
#define XB_TOPGEN   3392
#define XCD_BAR_WORDS 3456
#define XB_SPIN_CAP (1u << 18)

__device__ __forceinline__ unsigned xb_ld(unsigned* p)              { return __hip_atomic_load(p, __ATOMIC_RELAXED, __HIP_MEMORY_SCOPE_AGENT); }
__device__ __forceinline__ unsigned xb_add(unsigned* p, unsigned v) { return __hip_atomic_fetch_add(p, v, __ATOMIC_RELAXED, __HIP_MEMORY_SCOPE_AGENT); }
__device__ __forceinline__ unsigned xb_xcc_id() { return (unsigned)__builtin_amdgcn_s_getreg((3 << 11) | 20) & 0xFu; }
#define XB_SPIN(cond, bar) do { unsigned _sp = 0; while (cond) { __builtin_amdgcn_s_sleep(1); \
    if ((++_sp & 255u) == 0u) { if (xb_ld(&(bar)[XB_TMO])) break; if (_sp > XB_SPIN_CAP) { atomicAdd(&(bar)[XB_TMO], 1u); break; } } } } while (0)

struct XcdBarrier {
    unsigned* bar; unsigned x;
    volatile LAS unsigned* st;
};

__device__ __forceinline__ XcdBarrier xcd_barrier_post(unsigned* bar, volatile LAS unsigned* st) {
    XcdBarrier b; b.bar = bar; b.x = xb_xcc_id(); b.st = st;
    if (threadIdx.x == 0) (void)xb_add(&bar[XB_XCNT(b.x)], 1u);
    return b;
}
__device__ __forceinline__ void xcd_barrier_complete(unsigned* bar, unsigned x, unsigned& nloc, unsigned& nx) {
    const unsigned G = gridDim.x * gridDim.y * gridDim.z;
    unsigned sum, cnt, mine, sp = 0u;
    for (;;) {
        sum = 0u; cnt = 0u; mine = 0u;
#pragma unroll
        for (unsigned j = 0; j < 16; ++j) { const unsigned c = xb_ld(&bar[XB_XCNT(j)]); sum += c; cnt += (c > 0u) ? 1u : 0u; mine = (j == x) ? c : mine; }
        if (sum == G) break;
        __builtin_amdgcn_s_sleep(1);
        if ((++sp & 255u) == 0u) { if (xb_ld(&bar[XB_TMO])) break; if (sp > XB_SPIN_CAP) { atomicAdd(&bar[XB_TMO], 1u); break; } }
    }
    nloc = mine > 0u ? mine : 1u; nx = cnt > 0u ? cnt : 1u;
}

__device__ __forceinline__ void xcd_barrier(const XcdBarrier& b) {
    asm volatile("s_waitcnt vmcnt(0)" ::: "memory");
    __syncthreads();
    if (threadIdx.x == 0) {
        unsigned* bar = b.bar;
        __builtin_amdgcn_s_waitcnt(0);
        unsigned nloc = b.st[0], nx = b.st[1];
        if (nloc == 0u) { xcd_barrier_complete(bar, b.x, nloc, nx); b.st[0] = nloc; b.st[1] = nx; }
        const unsigned old = xb_add(&bar[XB_XSUB(b.x)], 1u);
        const unsigned gen = old / nloc;
        if (old + 1u == (gen + 1u) * nloc) {
            __builtin_amdgcn_fence(__ATOMIC_RELEASE, "agent");
            asm volatile("s_waitcnt vmcnt(0)" ::: "memory");
            const unsigned og = xb_add(&bar[XB_TOP], 1u);
            const unsigned tg = og / nx;
            if (og + 1u == (tg + 1u) * nx) xb_add(&bar[XB_TOPGEN], 1u);
            else XB_SPIN(xb_ld(&bar[XB_TOPGEN]) == tg, bar);
            __builtin_amdgcn_fence(__ATOMIC_ACQUIRE, "agent");
            xb_add(&bar[XB_XGEN(b.x)], 1u);
            asm volatile("s_waitcnt vmcnt(0)" ::: "memory");
        } else {
            XB_SPIN(xb_ld(&bar[XB_XGEN(b.x)]) == gen, bar);
            __builtin_amdgcn_fence(__ATOMIC_ACQUIRE, "agent");
            asm volatile("s_waitcnt vmcnt(0)" ::: "memory");
        }
    }
    __syncthreads();
}


constexpr int LDS_BYTES = 131072 + 1024;
constexpr int N_PHASES = 1 + 8 * DEPTH;

__global__ void __launch_bounds__(NTHR) fwd_megakernel(Args a) {
    extern __shared__ __attribute__((aligned(16))) unsigned char lds_raw[];
    LAS unsigned char* lds = (LAS unsigned char*)lds_raw;
    cg::grid_group grid = cg::this_grid();
    const int tid = threadIdx.x, lane = tid & 63, wid = __builtin_amdgcn_readfirstlane(tid >> 6);
    const int G = gridDim.x, bx = blockIdx.x;
    unsigned char* ws = a.ws;
    bf16_t* H = (bf16_t*)(ws + WS_H); bf16_t* Z = (bf16_t*)(ws + WS_Z); bf16_t* BR = (bf16_t*)(ws + WS_BR);
    bf16_t* XB = (bf16_t*)(ws + WS_X); bf16_t* MERGED = (bf16_t*)(ws + WS_MERGED); bf16_t* Y = (bf16_t*)(ws + WS_Y); bf16_t* ACT = (bf16_t*)(ws + WS_ACT);
    const int lo = a.ph_lo, hi = a.ph_hi;
    volatile LAS unsigned* bst = (volatile LAS unsigned*)(lds + 131072);
    if (tid < 2) bst[tid] = 0u;
    __syncthreads();
    XcdBarrier xbar = xcd_barrier_post((unsigned*)(ws + WS_CTL), bst);
#define IN(k) (lo <= (k) && (k) < hi)
#define SEAM(k) do { if (a.coop && IN((k) + 1)) { if (a.coop == 2) grid.sync(); else xcd_barrier(xbar); } } while (0)

    if (lo == 99) {
        const bf16_t* src = (const bf16_t*)(ws + (size_t)a.pad * MiB);
        for (size_t i = (size_t)bx * NTHR + tid; i < (size_t)M_TOK * DM; i += (size_t)G * NTHR) a.out[i] = __uint_as_float((unsigned)src[i] << 16);
        return;
    }
    if (IN(0)) { phase_prologue(a, lds, wid, lane); SEAM(0); }

#pragma unroll 1
    for (int l = 0; l < DEPTH; ++l) {
        const int p0 = 1 + 8 * l;
        int tl = threadIdx.x; asm volatile("" : "+v"(tl)); const int lane = tl & 63, wid = __builtin_amdgcn_readfirstlane(tl >> 6);
        const unsigned char* wl = ws + WS_W + (size_t)l * W_LAYER;
        const bf16_t* Win = (const bf16_t*)(wl + W_IN); const bf16_t* Wg = (const bf16_t*)(wl + W_G); const bf16_t* Wb = (const bf16_t*)(wl + W_B);
        const bf16_t* Wout = (const bf16_t*)(wl + W_OUT); const bf16_t* Wfi = (const bf16_t*)(wl + W_FI); const bf16_t* Wfo = (const bf16_t*)(wl + W_FO);
        const bf16_t* sgw = (const bf16_t*)(wl + W_SG); const bf16_t* pwT = (const bf16_t*)(wl + W_PW);

        if (IN(p0 + 0)) {
            gm::SchedPlain S{H, Win, DM, M_TOK / 256, DIN / 256, DM / 64, G, bx}; gm::EpiStoreBf16 E{Z, DIN};
            gm::gemm_phase<true>(lds, DM, S, E);
            SEAM(p0 + 0);
        }
        if (IN(p0 + 1)) {
            for (int rep = 0; rep < PROBE_MIX_REPS; ++rep)
            for (int u = bx; u < 4 * 384; u += G) { const int part = u / 384, chunk = u % 384, row0 = chunk * 128;
                int tu = threadIdx.x; asm volatile("" : "+v"(tu)); const int lane = tu & 63, wid = __builtin_amdgcn_readfirstlane(tu >> 6);
                unsigned pf[5] = {0u, 0u, 0u, 0u, 0u};
                if (u + G < 4 * 384) mixer_prefetch(Z, (u + G) / 384, ((u + G) % 384) * 128, tu, pf);
                if (part == 0) mixer_conv_pool(Z, BR, a.conv_w + l * 768, pwT, a.pool_scale + l * 256, lds, row0, wid, lane);
                else if (part == 1) mixer_spatial(Z, BR, a.sg_norm + l * 256, sgw, a.sg_b + l * 512, lds, row0, wid, lane);
                else mixer_attn(Z, BR, a.attn_sink + l * 4, lds, row0, part - 2, wid, lane);
                asm volatile("" :: "v"(pf[0]), "v"(pf[1]), "v"(pf[2]), "v"(pf[3]), "v"(pf[4]));
            }
            SEAM(p0 + 1);
        }
        if (IN(p0 + 2)) {
            gm::SchedGate S{H, BR, Wg, Wb, M_TOK / 256, DM / 256, G, bx};
            unsigned char* scr = ws + WS_SCR + (size_t)bx * SCR_PER_CU;
            gm::EpiGate E{a.b_gate + l * 4 * DM, MERGED, (GAS unsigned char*)scr, (GAS unsigned char*)(scr + 128 * 1024)};
            for (int rep = 0; rep < PROBE_G2_REPS; ++rep) gm::gemm_phase<true>(lds, DM, S, E);
            SEAM(p0 + 2);
        }
        if (IN(p0 + 3)) {
            gm::SchedPlain S{MERGED, Wout, DM, M_TOK / 256, DM / 256, DM / 64, G, bx}; gm::EpiStoreBf16 E{Y, DM};
            gm::gemm_phase<true>(lds, DM, S, E);
            SEAM(p0 + 3);
        }
        if (IN(p0 + 4)) { phase_resnorm(a, Y, a.norm_mix_post + l * DM, a.norm_ffn_pre + l * DM, l == 0, false, XB, H, wid, lane); SEAM(p0 + 4); }
        if (IN(p0 + 5)) {
            gm::SchedPlain S{H, Wfi, DM, M_TOK / 256, NFI / 256, DM / 64, G, bx}; gm::EpiSwiGLU E{ACT};
            for (int rep = 0; rep < PROBE_G4_REPS; ++rep) gm::gemm_phase<true>(lds, DM, S, E);
            SEAM(p0 + 5);
        }
        if (IN(p0 + 6)) {
            gm::SchedPlain S{ACT, Wfo, DFF, M_TOK / 256, DM / 256, DFF / 64, G, bx}; gm::EpiStoreBf16 E{H, DM};
            gm::gemm_phase<true>(lds, DFF, S, E);
            SEAM(p0 + 6);
        }
        if (IN(p0 + 7)) { phase_resnorm(a, H, a.norm_ffn_post + l * DM, (l + 1 < DEPTH) ? a.norm_mix_pre + (l + 1) * DM : nullptr, false, l + 1 == DEPTH, XB, H, wid, lane); SEAM(p0 + 7); }
    }
#undef IN
#undef SEAM
}

extern "C" void kernel_launch(void* const* d_in, const int* in_sizes, int n_in, void* d_out, int out_size, void* d_ws, size_t ws_size, hipStream_t stream) {
    static int grid = 0;
    if (grid == 0) {
        if (n_in != 20 || out_size != M_TOK * DM || ws_size < WS_END) { fprintf(stderr, "kernel_launch: unexpected shapes (n_in %d out %d ws %zu)\n", n_in, out_size, ws_size); grid = -1; return; }
        int dev = 0, cus = 0, per_cu = 0;
        hipGetDevice(&dev); hipDeviceGetAttribute(&cus, hipDeviceAttributeMultiprocessorCount, dev);
        if (hipFuncSetAttribute((const void*)fwd_megakernel, hipFuncAttributeMaxDynamicSharedMemorySize, LDS_BYTES) != hipSuccess) { fprintf(stderr, "kernel_launch: hipFuncSetAttribute failed\n"); grid = -1; return; }
        if (hipOccupancyMaxActiveBlocksPerMultiprocessor(&per_cu, (const void*)fwd_megakernel, NTHR, LDS_BYTES) != hipSuccess || per_cu < 1) { fprintf(stderr, "kernel_launch: occupancy query says %d\n", per_cu); per_cu = 1; }
        (void)hipGetLastError();
        grid = cus * 1;
    }
    if (grid < 0) return;
    if (hipMemsetAsync((char*)d_ws + WS_CTL, 0, 16384, stream) != hipSuccess) { fprintf(stderr, "kernel_launch: memset of barrier words failed\n"); return; }
    Args a{};
    const float** fp = (const float**)&a;
    for (int i = 0; i < 20; ++i) fp[i] = (const float*)d_in[i];
    a.out = (float*)d_out; a.ws = (unsigned char*)d_ws; a.pad = 0;
#if MK_LAUNCH_PER_PHASE
#ifdef DUMP_AFTER
    for (int p = 0; p <= DUMP_AFTER; ++p) { a.ph_lo = p; a.ph_hi = p + 1; a.coop = 0;
        hipLaunchKernelGGL(fwd_megakernel, dim3(grid), dim3(NTHR), LDS_BYTES, stream, a); }
    a.ph_lo = 99; a.ph_hi = 100; a.pad = DUMP_MIB;
    hipLaunchKernelGGL(fwd_megakernel, dim3(grid), dim3(NTHR), LDS_BYTES, stream, a);
#else
    for (int p = 0; p < N_PHASES; ++p) { a.ph_lo = p; a.ph_hi = p + 1; a.coop = 0;
        hipLaunchKernelGGL(fwd_megakernel, dim3(grid), dim3(NTHR), LDS_BYTES, stream, a); }
#endif
#else
    a.ph_lo = 0; a.ph_hi = N_PHASES; a.coop = 1;
    void* args[] = {&a};
    hipError_t e = hipLaunchCooperativeKernel((const void*)fwd_megakernel, dim3(grid), dim3(NTHR), args, LDS_BYTES, stream);
    if (e != hipSuccess) fprintf(stderr, "cooperative launch failed: %s (grid %d)\n", hipGetErrorString(e), grid);
#endif
}
```

```cpp
#include <hip/hip_runtime.h>
#include <hip/hip_cooperative_groups.h>
#include <cstdio>
#include <cstdint>
namespace cg = cooperative_groups;

#ifndef PROBE_MIX_REPS
#define PROBE_MIX_REPS 1
#endif
#ifndef PROBE_G4_REPS
#define PROBE_G4_REPS 1
#endif
#ifndef PROBE_G2_REPS
#define PROBE_G2_REPS 1
#endif
#ifndef MK_LAUNCH_PER_PHASE
#define MK_LAUNCH_PER_PHASE 0
#endif

#define LAS __attribute__((address_space(3)))
typedef unsigned short bf16_t;
typedef short bf16x8 __attribute__((ext_vector_type(8)));
typedef short s16x4 __attribute__((ext_vector_type(4)));
typedef float f32x4 __attribute__((ext_vector_type(4)));
typedef unsigned u32x4 __attribute__((ext_vector_type(4)));
typedef unsigned u32x2 __attribute__((ext_vector_type(2)));

constexpr int M_TOK = 49152, M_PROMPT = 32768, DM = 1024, DIN = 2048, DFF = 2816, NFI = 5632, DEPTH = 2;
constexpr int NWAVES = 8, NTHR = 512;
constexpr float EPS = 1e-6f;
constexpr float LOG2E = 1.4426950408889634f;

constexpr size_t MiB = 1u << 20;
constexpr size_t W_IN = 0, W_G = 4 * MiB, W_B = 12 * MiB, W_OUT = 14 * MiB, W_FI = 16 * MiB, W_FO = 27 * MiB, W_SG = 32 * MiB + 512 * 1024, W_PW = W_SG + 128 * 1024, W_LAYER = 33 * MiB;
constexpr size_t WS_W = 0, WS_H = 66 * MiB, WS_Z = 162 * MiB, WS_BR = 354 * MiB, WS_X = 450 * MiB, WS_CTL = 546 * MiB, WS_END = 547 * MiB;
constexpr size_t WS_MERGED = WS_Z, WS_SCR = WS_Z + 96 * MiB, WS_Y = WS_Z + 96 * MiB, WS_ACT = WS_Z;
constexpr size_t SCR_PER_CU = 256 * 1024;

typedef float f32x2_t __attribute__((ext_vector_type(2))); typedef __bf16 bf16x2_t __attribute__((ext_vector_type(2)));
__device__ __forceinline__ unsigned cvt_pk_bf16(float lo, float hi) { f32x2_t v = {lo, hi}; bf16x2_t b = __builtin_convertvector(v, bf16x2_t); return __builtin_bit_cast(unsigned, b); }
__device__ __forceinline__ float bflo(unsigned w) { return __uint_as_float(w << 16); }
__device__ __forceinline__ float bfhi(unsigned w) { return __uint_as_float(w & 0xffff0000u); }
template <int CTRL> __device__ __forceinline__ float dpp_(float x) { return __builtin_bit_cast(float, __builtin_amdgcn_mov_dpp(__builtin_bit_cast(int, x), CTRL, 0xf, 0xf, true)); }
__device__ __forceinline__ float wave_sum(float v) {
    v += dpp_<0xB1>(v); v += dpp_<0x4E>(v); v += dpp_<0x141>(v); v += dpp_<0x128>(v);
    const int iv = __builtin_bit_cast(int, v);
    const float r0 = __builtin_bit_cast(float, __builtin_amdgcn_readlane(iv, 0)), r1 = __builtin_bit_cast(float, __builtin_amdgcn_readlane(iv, 16));
    const float r2 = __builtin_bit_cast(float, __builtin_amdgcn_readlane(iv, 32)), r3 = __builtin_bit_cast(float, __builtin_amdgcn_readlane(iv, 48));
    return (r0 + r1) + (r2 + r3);
}
__device__ __forceinline__ float sigmoidf_(float x) { return __builtin_amdgcn_rcpf(1.0f + __builtin_amdgcn_exp2f(-x * LOG2E)); }
__device__ __forceinline__ float sig2_(float t) { return __builtin_amdgcn_rcpf(1.0f + __builtin_amdgcn_exp2f(t)); }
__device__ __forceinline__ void seq_bounds(int row, int& s0, int& s1) { if (row < M_PROMPT) { s0 = row & ~4095; s1 = s0 + 4096; } else { s0 = M_PROMPT; s1 = M_TOK; } }
__device__ __forceinline__ s16x4 tr_read(const LAS unsigned char* p) { return __builtin_bit_cast(s16x4, __builtin_amdgcn_ds_read_tr16_b64_v4i16((LAS s16x4*)p)); }

namespace gm {
constexpr int BM = 256, BK = 64, HALF = 128, HTB = HALF * BK * 2, STAGE_BYTES = 8 * HTB, NXCD = 8, WGM = 8;
__host__ __device__ __forceinline__ int lds_byte(int r, int c) { const int st = (r >> 4) * 2 + (c >> 5), rr = r & 15, cc = c & 31, ob = rr * 64 + cc * 2; return st * 1024 + (ob ^ (((ob >> 9) & 1) << 5)); }
__host__ __device__ __forceinline__ void stage_rc(int b, int& R, int& C) { const int st = b / 1024, sb = b % 1024, swz = sb ^ (((sb >> 9) & 1) << 5); R = (st >> 1) * 16 + swz / 64; C = (st & 1) * 32 + (swz % 64) / 2; }
__host__ __device__ __forceinline__ int perm32(int rho) { const int n = rho >> 4, i = rho & 15; return 8 * (i >> 2) + 4 * n + (i & 3); }

struct Unit { const char* A; const char* B; int nt, pm, pn, tag; };

__device__ __forceinline__ void tile_of(int L, int nM, int nN, int& pm, int& pn) {
    const int nwg = nM * nN; int wgid = L;
    { const int q = nwg / NXCD, r = nwg % NXCD, xcd = wgid % NXCD, off = wgid / NXCD; wgid = (xcd < r ? xcd * (q + 1) : r * (q + 1) + (xcd - r) * q) + off; }
    const int nig = WGM * nN, gid = wgid / nig, fm = gid * WGM, gsz = (nM - fm) < WGM ? (nM - fm) : WGM;
    pm = fm + ((wgid % nig) % gsz); pn = (wgid % nig) / gsz;
}
struct SchedPlain {
    const bf16_t* A; const bf16_t* B; int pitch, nM, nN, nt, G, c;
    __device__ __forceinline__ bool next(int i, Unit& u) const {
        const int L = i * G + c; if (L >= nM * nN) return false;
        tile_of(L, nM, nN, u.pm, u.pn);
        u.A = (const char*)(A + (size_t)u.pm * BM * pitch); u.B = (const char*)(B + (size_t)u.pn * BM * pitch); u.nt = nt; u.tag = 0; return true;
    }
};
struct SchedGate {
    const bf16_t* H; const bf16_t* BR; const bf16_t* WG; const bf16_t* WB; int nM, nN, G, c;
    __device__ __forceinline__ bool next(int i, Unit& u) const {
        const int ti = i >> 3, sub = i & 7; const int L = ti * G + c; if (L >= nM * nN) return false;
        tile_of(L, nM, nN, u.pm, u.pn);
        const int b = sub >> 1; u.tag = sub;
        if ((sub & 1) == 0) { u.A = (const char*)(H + (size_t)u.pm * BM * DM); u.B = (const char*)(WG + (size_t)b * DM * DM + (size_t)u.pn * BM * DM); u.nt = 16; }
        else { u.A = (const char*)(BR + (size_t)u.pm * BM * DM + 256 * b); u.B = (const char*)(WB + (size_t)u.pn * BM * DM + 256 * b); u.nt = 4; }
        return true;
    }
};

struct EpiStoreBf16 {
    bf16_t* O; int ldc;
    __device__ __forceinline__ void operator()(const f32x4 (&acc)[2][2][4][2], const Unit& u, int wr, int wc, int fr, int fq) const {
        const int row0 = u.pm * BM + wr * 64 + fr, col0 = u.pn * BM + wc * 32 + 8 * fq;
#pragma unroll
        for (int ai = 0; ai < 2; ++ai)
#pragma unroll
            for (int m = 0; m < 4; ++m) { bf16_t* rowp = O + (size_t)(row0 + ai * HALF + m * 16) * ldc + col0;
#pragma unroll
                for (int bj = 0; bj < 2; ++bj) { const f32x4 v0 = acc[ai][bj][m][0], v1 = acc[ai][bj][m][1];
                    u32x4 w; w.x = cvt_pk_bf16(v0[0], v0[1]); w.y = cvt_pk_bf16(v0[2], v0[3]); w.z = cvt_pk_bf16(v1[0], v1[1]); w.w = cvt_pk_bf16(v1[2], v1[3]);
                    *(u32x4*)(rowp + bj * HALF) = w; } }
    }
};
struct EpiSwiGLU {
    bf16_t* O;
    __device__ __forceinline__ void operator()(const f32x4 (&acc)[2][2][4][2], const Unit& u, int wr, int wc, int fr, int fq) const {
        const int row0 = u.pm * BM + wr * 64 + fr, col0 = u.pn * 128 + wc * 32 + 8 * fq;
#pragma unroll
        for (int ai = 0; ai < 2; ++ai)
#pragma unroll
            for (int m = 0; m < 4; ++m) { bf16_t* rowp = O + (size_t)(row0 + ai * HALF + m * 16) * DFF + col0;
                f32x4 o[2];
#pragma unroll
                for (int n = 0; n < 2; ++n) { const f32x4 av = acc[ai][0][m][n], g = acc[ai][1][m][n];
#pragma unroll
                    for (int e = 0; e < 4; ++e) o[n][e] = av[e] * sigmoidf_(av[e]) * g[e]; }
                u32x4 w; w.x = cvt_pk_bf16(o[0][0], o[0][1]); w.y = cvt_pk_bf16(o[0][2], o[0][3]); w.z = cvt_pk_bf16(o[1][0], o[1][1]); w.w = cvt_pk_bf16(o[1][2], o[1][3]);
                *(u32x4*)rowp = w; }
    }
};
#define GAS __attribute__((address_space(1)))
struct EpiGate {
    const float* bgate; bf16_t* O; GAS unsigned char* gsc; GAS unsigned char* msc;
    __device__ __forceinline__ void operator()(const f32x4 (&acc)[2][2][4][2], const Unit& u, int wr, int wc, int fr, int fq) const {
        const int tid = threadIdx.x; const int b = u.tag >> 1, kind = u.tag & 1;
        const int row0 = u.pm * BM + wr * 64 + fr, col0 = u.pn * BM + wc * 32 + 8 * fq;
        unsigned off = (unsigned)tid * 32u;
        if (kind == 0) {
            f32x4 bv[2][2];
#pragma unroll
            for (int bj = 0; bj < 2; ++bj)
#pragma unroll
                for (int n = 0; n < 2; ++n) bv[bj][n] = *(const f32x4*)(bgate + b * DM + col0 + bj * HALF + 4 * n) * (-LOG2E);
#pragma unroll
            for (int ai = 0; ai < 2; ++ai)
#pragma unroll
                for (int m = 0; m < 4; ++m) {
                    asm volatile("" : "+v"(off));
#pragma unroll
                    for (int bj = 0; bj < 2; ++bj) { const f32x4 v0 = acc[ai][bj][m][0] * (-LOG2E) + bv[bj][0], v1 = acc[ai][bj][m][1] * (-LOG2E) + bv[bj][1];
                        u32x4 w; w.x = cvt_pk_bf16(sig2_(v0[0]), sig2_(v0[1])); w.y = cvt_pk_bf16(sig2_(v0[2]), sig2_(v0[3]));
                        w.z = cvt_pk_bf16(sig2_(v1[0]), sig2_(v1[1])); w.w = cvt_pk_bf16(sig2_(v1[2]), sig2_(v1[3]));
                        *(GAS u32x4*)(gsc + off + bj * 16) = w; }
                    off += 16384u; }
        } else {
#pragma unroll
            for (int ai = 0; ai < 2; ++ai) {
                asm volatile("" : "+v"(off));
                u32x4 gw[4][2], mw[4][2];
#pragma unroll
                for (int m = 0; m < 4; ++m)
#pragma unroll
                    for (int bj = 0; bj < 2; ++bj) gw[m][bj] = *(const GAS u32x4*)(gsc + off + m * 16384 + bj * 16);
                if (b != 0) {
#pragma unroll
                    for (int m = 0; m < 4; ++m)
#pragma unroll
                        for (int bj = 0; bj < 2; ++bj) mw[m][bj] = *(const GAS u32x4*)(msc + off + m * 16384 + bj * 16);
                } else {
#pragma unroll
                    for (int m = 0; m < 4; ++m)
#pragma unroll
                        for (int bj = 0; bj < 2; ++bj) mw[m][bj] = (u32x4){0u, 0u, 0u, 0u};
                }
#pragma unroll
                for (int m = 0; m < 4; ++m) { bf16_t* rowp = O + (size_t)(row0 + ai * HALF + m * 16) * DM + col0;
#pragma unroll
                    for (int bj = 0; bj < 2; ++bj) { const u32x4 g = gw[m][bj], q = mw[m][bj];
                        const f32x4 a0 = acc[ai][bj][m][0], a1 = acc[ai][bj][m][1];
                        u32x4 w;
                        w.x = cvt_pk_bf16(bflo(g.x) * a0[0] + bflo(q.x), bfhi(g.x) * a0[1] + bfhi(q.x)); w.y = cvt_pk_bf16(bflo(g.y) * a0[2] + bflo(q.y), bfhi(g.y) * a0[3] + bfhi(q.y));
                        w.z = cvt_pk_bf16(bflo(g.z) * a1[0] + bflo(q.z), bfhi(g.z) * a1[1] + bfhi(q.z)); w.w = cvt_pk_bf16(bflo(g.w) * a1[2] + bflo(q.w), bfhi(g.w) * a1[3] + bfhi(q.w));
                        if (b != 3) *(GAS u32x4*)(msc + off + m * 16384 + bj * 16) = w;
                        else *(u32x4*)(rowp + bj * HALF) = w; } }
                off += 65536u; }
        }
    }
};

template <bool PERM, class Sched, class Epi>
__device__ __forceinline__ void gemm_phase(LAS unsigned char* lds, const int K, const Sched& S, const Epi& E) {
    int tid_ = threadIdx.x; asm volatile("" : "+v"(tid_));
    const int tid = tid_, wid = __builtin_amdgcn_readfirstlane(tid >> 6), lane = tid & 63, wr = wid >> 2, wc = wid & 3, fr = lane & 15, fq = lane >> 4;
    unsigned voffA[2], voffB[2];
#pragma unroll
    for (int i = 0; i < 2; ++i) { int R, C; stage_rc(tid * 16 + i * 8192, R, C); const int Rb = PERM ? ((R & ~31) + perm32(R & 31)) : R;
        voffA[i] = (unsigned)(R * K + C) * 2u; voffB[i] = (unsigned)(Rb * K + C) * 2u; }
    const size_t kstep = (size_t)(BK * 2);
    const size_t hstep = (size_t)HALF * K * 2;
    const unsigned ldsw = (unsigned)wid * 1024u;
    const int aoff = lds_byte(wr * 64 + fr, fq * 8), boff = lds_byte(wc * 32 + fr, fq * 8);
#define PG8_SA(b, h) (((b) * 2 + (h)) * HTB)
#define PG8_SB(b, h) ((4 + (b) * 2 + (h)) * HTB)
#define PG8_STAGE(bufoff, gbase, voff) do { _Pragma("unroll") for (int _i = 0; _i < 2; ++_i) \
        __builtin_amdgcn_global_load_lds((const unsigned*)((const char*)(gbase) + (voff)[_i]), (LAS unsigned*)(lds + (bufoff) + ldsw + _i * 8192), 16, 0, 0); } while (0)
#define PG8_LDA(dst, b, h) do { _Pragma("unroll") for (int m = 0; m < 4; ++m) _Pragma("unroll") for (int k = 0; k < 2; ++k) dst[m][k] = *(const LAS bf16x8*)(lds + PG8_SA(b, h) + aoff + m * 2048 + k * 1024); } while (0)
#define PG8_LDB(dst, b, h) do { _Pragma("unroll") for (int n = 0; n < 2; ++n) _Pragma("unroll") for (int k = 0; k < 2; ++k) dst[n][k] = *(const LAS bf16x8*)(lds + PG8_SB(b, h) + boff + n * 2048 + k * 1024); } while (0)
#define PG8_MMA(ai, bj, At, Bt) do { __builtin_amdgcn_s_setprio(1); _Pragma("unroll") for (int m = 0; m < 4; ++m) _Pragma("unroll") for (int n = 0; n < 2; ++n) _Pragma("unroll") for (int k = 0; k < 2; ++k) \
        acc[ai][bj][m][n] = __builtin_amdgcn_mfma_f32_16x16x32_bf16(Bt[n][k], At[m][k], acc[ai][bj][m][n], 0, 0, 0); __builtin_amdgcn_s_setprio(0); } while (0)
#define PG8_WAIT_V(n) asm volatile("s_waitcnt vmcnt(" #n ")" ::: "memory")
#define PG8_WAIT_L(n) asm volatile("s_waitcnt lgkmcnt(" #n ")" ::: "memory")
#define PG8_BAR __builtin_amdgcn_s_barrier()
#define PG8_SCHED __builtin_amdgcn_sched_barrier(0)
    Unit cur, nxt; int ui = 0;
    if (!S.next(0, cur)) return;
    f32x4 acc[2][2][4][2];
#pragma unroll
    for (int a = 0; a < 2; ++a)
#pragma unroll
        for (int b = 0; b < 2; ++b)
#pragma unroll
            for (int m = 0; m < 4; ++m)
#pragma unroll
                for (int n = 0; n < 2; ++n) acc[a][b][m][n] = (f32x4){0.f, 0.f, 0.f, 0.f};
    bf16x8 At[4][2], B0[2][2], B1[2][2];
    const char* cA = cur.A; const char* cB = cur.B;
    PG8_STAGE(PG8_SB(0, 0), cB, voffB); PG8_STAGE(PG8_SB(0, 1), cB + hstep, voffB); PG8_STAGE(PG8_SA(0, 0), cA, voffA); PG8_STAGE(PG8_SA(0, 1), cA + hstep, voffA);
    if (wr == 1) PG8_BAR;
    PG8_WAIT_V(2); PG8_BAR;
    PG8_STAGE(PG8_SB(1, 0), cB + kstep, voffB); PG8_STAGE(PG8_SA(1, 0), cA + kstep, voffA); PG8_STAGE(PG8_SB(1, 1), cB + hstep + kstep, voffB);
    PG8_WAIT_V(6); PG8_BAR;
    for (;;) {
        const bool has_next = S.next(ui + 1, nxt);
        const char* nA = has_next ? nxt.A : cA; const char* nB = has_next ? nxt.B : cB;
        const int nt = cur.nt;
        for (int t = 0; t < nt; t += 2) {
            const bool last = (t == nt - 2);
            const char* a1 = cA + (size_t)(t + 1) * kstep;
            const char* a2 = last ? nA : cA + (size_t)(t + 2) * kstep; const char* b2 = last ? nB : cB + (size_t)(t + 2) * kstep;
            const char* a3 = a2 + kstep; const char* b3 = b2 + kstep;
            PG8_LDB(B0, 0, 0); PG8_LDB(B1, 0, 1); PG8_SCHED; PG8_LDA(At, 0, 0); PG8_STAGE(PG8_SA(1, 1), a1 + hstep, voffA);
            PG8_WAIT_V(8); PG8_WAIT_L(0); PG8_BAR; PG8_MMA(0, 0, At, B0); PG8_MMA(0, 1, At, B1); PG8_BAR; PG8_SCHED;
            PG8_LDA(At, 0, 1); PG8_STAGE(PG8_SB(0, 0), b2, voffB); PG8_STAGE(PG8_SB(0, 1), b2 + hstep, voffB); PG8_STAGE(PG8_SA(0, 0), a2, voffA);
            PG8_WAIT_V(8); PG8_WAIT_L(0); PG8_BAR; PG8_MMA(1, 0, At, B0); PG8_MMA(1, 1, At, B1); PG8_BAR; PG8_SCHED;
            PG8_LDB(B0, 1, 0); PG8_LDB(B1, 1, 1); PG8_SCHED; PG8_LDA(At, 1, 0); PG8_STAGE(PG8_SA(0, 1), a2 + hstep, voffA);
            PG8_WAIT_V(8); PG8_WAIT_L(0); PG8_BAR; PG8_MMA(0, 0, At, B0); PG8_MMA(0, 1, At, B1); PG8_BAR; PG8_SCHED;
            PG8_LDA(At, 1, 1); PG8_STAGE(PG8_SB(1, 0), b3, voffB); PG8_STAGE(PG8_SB(1, 1), b3 + hstep, voffB); PG8_STAGE(PG8_SA(1, 0), a3, voffA);
            PG8_WAIT_V(8); PG8_WAIT_L(0); PG8_BAR; PG8_MMA(1, 0, At, B0); PG8_MMA(1, 1, At, B1); PG8_BAR; PG8_SCHED;
        }
        if (wr == 0) PG8_BAR;
        E(acc, cur, wr, wc, fr, fq);
        if (!has_next) break;
#pragma unroll
        for (int a = 0; a < 2; ++a)
#pragma unroll
            for (int b = 0; b < 2; ++b)
#pragma unroll
                for (int m = 0; m < 4; ++m)
#pragma unroll
                    for (int n = 0; n < 2; ++n) acc[a][b][m][n] = (f32x4){0.f, 0.f, 0.f, 0.f};
        cur = nxt; cA = nA; cB = nB; ++ui;
        if (wr == 1) PG8_BAR;
    }
    PG8_WAIT_V(0);
    PG8_BAR;
#undef PG8_SA
#undef PG8_SB
#undef PG8_STAGE
#undef PG8_LDA
#undef PG8_LDB
#undef PG8_MMA
#undef PG8_WAIT_V
#undef PG8_WAIT_L
#undef PG8_BAR
#undef PG8_SCHED
}
}

struct Args {
    const float* x_prompt; const float* x_sample; const float* norm_mix_pre; const float* norm_mix_post; const float* norm_ffn_pre; const float* norm_ffn_post;
    const float* w_in; const float* conv_w; const float* pool_w; const float* pool_scale; const float* sg_norm; const float* sg_w; const float* sg_b; const float* attn_sink;
    const float* w_branch; const float* w_gate; const float* b_gate; const float* w_out; const float* w_ffn_in; const float* w_ffn_out;
    float* out; unsigned char* ws; int ph_lo, ph_hi, coop, pad;
};

template <int MODE>
__device__ __forceinline__ void transpose_item(const float* W, int ldw, int N, bf16_t* WT, int ldt, LAS float* scr, int item, int lane) {
    const int nblk = N / 32, kb = item / nblk, nb = item % nblk, k0 = 64 * kb, n0 = 32 * nb;
    float wv[32];
#pragma unroll
    for (int i = 0; i < 32; ++i) wv[i] = W[(size_t)(k0 + 2 * i + (lane >> 5)) * ldw + n0 + (lane & 31)];
#pragma unroll
    for (int i = 0; i < 32; ++i) scr[(2 * i + (lane >> 5)) * 33 + (lane & 31)] = wv[i];
    asm volatile("s_waitcnt lgkmcnt(0)" ::: "memory");
    const int c = lane & 7;
#pragma unroll
    for (int j = 0; j < 4; ++j) { const int n = (lane >> 3) + 8 * j; const LAS float* s = scr + (8 * c) * 33 + n;
        u32x4 o; o.x = cvt_pk_bf16(s[0 * 33], s[1 * 33]); o.y = cvt_pk_bf16(s[2 * 33], s[3 * 33]); o.z = cvt_pk_bf16(s[4 * 33], s[5 * 33]); o.w = cvt_pk_bf16(s[6 * 33], s[7 * 33]);
        int drow = n0 + n;
        if (MODE == 1) { const int sc = n0 + n, isg = sc >= DFF ? 1 : 0, f = sc - isg * DFF; drow = 256 * (f >> 7) + 128 * isg + (f & 127); }
        *(u32x4*)(WT + (size_t)drow * ldt + k0 + 8 * c) = o; }
    asm volatile("s_waitcnt lgkmcnt(0)" ::: "memory");
}

__device__ __forceinline__ void phase_prologue(const Args& a, LAS unsigned char* lds, int wid, int lane) {
    LAS float* scr = (LAS float*)(lds + wid * 16384);
    const int gw = blockIdx.x * NWAVES + wid, NGW = gridDim.x * NWAVES;
    constexpr int I_IN = 16 * 64, I_G = 16 * 32, I_B = 16 * 32, I_O = 16 * 32, I_FI = 16 * 176, I_FO = 44 * 32, I_PW = 2;
    constexpr int I_LAYER = I_IN + 4 * I_G + I_B + I_O + I_FI + I_FO + 4 * I_PW;
    for (int it = gw; it < DEPTH * I_LAYER; it += NGW) {
        const int l = it / I_LAYER; int r = it % I_LAYER;
        unsigned char* wl = a.ws + WS_W + (size_t)l * W_LAYER;
        if (r < I_IN) { transpose_item<0>(a.w_in + (size_t)l * DM * DIN, DIN, DIN, (bf16_t*)(wl + W_IN), DM, scr, r, lane); continue; } r -= I_IN;
        if (r < 4 * I_G) { const int b = r / I_G; transpose_item<0>(a.w_gate + ((size_t)l * 4 + b) * DM * DM, DM, DM, (bf16_t*)(wl + W_G) + (size_t)b * DM * DM, DM, scr, r % I_G, lane); continue; } r -= 4 * I_G;
        if (r < I_B) { transpose_item<0>(a.w_branch + (size_t)l * DM * DM, DM, DM, (bf16_t*)(wl + W_B), DM, scr, r, lane); continue; } r -= I_B;
        if (r < I_O) { transpose_item<0>(a.w_out + (size_t)l * DM * DM, DM, DM, (bf16_t*)(wl + W_OUT), DM, scr, r, lane); continue; } r -= I_O;
        if (r < I_FI) { transpose_item<1>(a.w_ffn_in + (size_t)l * DM * NFI, NFI, NFI, (bf16_t*)(wl + W_FI), DM, scr, r, lane); continue; } r -= I_FI;
        if (r < I_FO) { transpose_item<0>(a.w_ffn_out + (size_t)l * DFF * DM, DM, DM, (bf16_t*)(wl + W_FO), DFF, scr, r, lane); continue; } r -= I_FO;
        { const int g = r / I_PW; transpose_item<0>(a.pool_w + ((size_t)l * 4 + g) * 4096, 64, 64, (bf16_t*)(wl + W_PW) + g * 4096, 64, scr, r % I_PW, lane); }
    }
    const int gt = blockIdx.x * NTHR + threadIdx.x, NGT = gridDim.x * NTHR;
    for (int i = gt; i < DEPTH * 65536 / 4; i += NGT) { const int l = (i * 4) / 65536, o = (i * 4) % 65536;
        const f32x4 v = *(const f32x4*)(a.sg_w + (size_t)l * 65536 + o); u32x2 w; w.x = cvt_pk_bf16(v[0], v[1]); w.y = cvt_pk_bf16(v[2], v[3]);
        *(u32x2*)((bf16_t*)(a.ws + WS_W + (size_t)l * W_LAYER + W_SG) + o) = w; }
    bf16_t* H = (bf16_t*)(a.ws + WS_H);
    for (int row0 = gw; row0 < M_TOK; row0 += 3 * NGW) {
        f32x4 v[3][4];
#pragma unroll
        for (int r = 0; r < 3; ++r) { const int row = row0 + r * NGW; const float* xr = row < M_PROMPT ? a.x_prompt + (size_t)row * DM : a.x_sample + (size_t)(row - M_PROMPT) * DM;
#pragma unroll
            for (int j = 0; j < 4; ++j) v[r][j] = ((const f32x4*)xr)[lane + 64 * j]; }
#pragma unroll
        for (int r = 0; r < 3; ++r) { const int row = row0 + r * NGW; float ss = 0.f;
#pragma unroll
            for (int j = 0; j < 4; ++j) ss += (v[r][j][0] * v[r][j][0] + v[r][j][1] * v[r][j][1]) + (v[r][j][2] * v[r][j][2] + v[r][j][3] * v[r][j][3]);
            const float rstd = __builtin_amdgcn_rsqf(wave_sum(ss) * (1.f / DM) + EPS);
#pragma unroll
            for (int j = 0; j < 4; ++j) { const f32x4 g = ((const f32x4*)a.norm_mix_pre)[lane + 64 * j]; u32x2 w; w.x = cvt_pk_bf16(v[r][j][0] * rstd * g[0], v[r][j][1] * rstd * g[1]); w.y = cvt_pk_bf16(v[r][j][2] * rstd * g[2], v[r][j][3] * rstd * g[3]);
                ((u32x2*)(H + (size_t)row * DM))[lane + 64 * j] = w; } }
    }
}

__device__ __forceinline__ void phase_resnorm(const Args& a, const bf16_t* Y, const float* gpost, const float* gnext, bool first_x, bool last_x, bf16_t* X, bf16_t* H, int wid, int lane) {
    const int gw = blockIdx.x * NWAVES + wid, NGW = gridDim.x * NWAVES;
    constexpr int RB = 4;
    for (int row0 = gw; row0 < M_TOK; row0 += RB * NGW) {
        f32x4 xv[RB][4], yv[RB][4]; float ss[RB];
#pragma unroll
        for (int r = 0; r < RB; ++r) { const int row = min(row0 + r * NGW, M_TOK - 1); ss[r] = 0.f;
#pragma unroll
            for (int j = 0; j < 4; ++j) { const u32x2 w = ((const u32x2*)(Y + (size_t)row * DM))[lane + 64 * j]; yv[r][j] = (f32x4){bflo(w.x), bfhi(w.x), bflo(w.y), bfhi(w.y)}; }
            if (first_x) { const float* xr = row < M_PROMPT ? a.x_prompt + (size_t)row * DM : a.x_sample + (size_t)(row - M_PROMPT) * DM;
#pragma unroll
                for (int j = 0; j < 4; ++j) xv[r][j] = ((const f32x4*)xr)[lane + 64 * j];
            } else {
#pragma unroll
                for (int j = 0; j < 4; ++j) { const u32x2 w = ((const u32x2*)(X + (size_t)row * DM))[lane + 64 * j]; xv[r][j] = (f32x4){bflo(w.x), bfhi(w.x), bflo(w.y), bfhi(w.y)}; }
            } }
#pragma unroll
        for (int r = 0; r < RB; ++r) { const int row = row0 + r * NGW; if (row >= M_TOK) break;
#pragma unroll
            for (int j = 0; j < 4; ++j) ss[r] += (yv[r][j][0] * yv[r][j][0] + yv[r][j][1] * yv[r][j][1]) + (yv[r][j][2] * yv[r][j][2] + yv[r][j][3] * yv[r][j][3]);
            const float rstd = __builtin_amdgcn_rsqf(wave_sum(ss[r]) * (1.f / DM) + EPS);
            float sx = 0.f;
#pragma unroll
            for (int j = 0; j < 4; ++j) { const f32x4 g = ((const f32x4*)gpost)[lane + 64 * j]; xv[r][j] = xv[r][j] + yv[r][j] * rstd * g;
                sx += (xv[r][j][0] * xv[r][j][0] + xv[r][j][1] * xv[r][j][1]) + (xv[r][j][2] * xv[r][j][2] + xv[r][j][3] * xv[r][j][3]); }
            if (last_x) {
#pragma unroll
                for (int j = 0; j < 4; ++j) ((f32x4*)(a.out + (size_t)row * DM))[lane + 64 * j] = xv[r][j];
            } else {
#pragma unroll
                for (int j = 0; j < 4; ++j) { u32x2 w; w.x = cvt_pk_bf16(xv[r][j][0], xv[r][j][1]); w.y = cvt_pk_bf16(xv[r][j][2], xv[r][j][3]); ((u32x2*)(X + (size_t)row * DM))[lane + 64 * j] = w; }
            }
            if (gnext) {
                const float rx = __builtin_amdgcn_rsqf(wave_sum(sx) * (1.f / DM) + EPS);
#pragma unroll
                for (int j = 0; j < 4; ++j) { const f32x4 g = ((const f32x4*)gnext)[lane + 64 * j]; u32x2 w; w.x = cvt_pk_bf16(xv[r][j][0] * rx * g[0], xv[r][j][1] * rx * g[1]); w.y = cvt_pk_bf16(xv[r][j][2] * rx * g[2], xv[r][j][3] * rx * g[3]);
                    ((u32x2*)(H + (size_t)row * DM))[lane + 64 * j] = w; }
            }
        }
    }
}

constexpr int PL_PITCH = 264;
template <int GI>
__device__ __forceinline__ void pool_group(const LAS unsigned char* P, bf16_t* BR, const bf16_t* pwT, const float* pool_scale, int t, int row, int s0, int s1, int fr, int fq) {
    constexpr int half = 1 << GI, W = 2 * half;
    const int lo = max(row - half, s0), hi = min(row + half, s1); const float inv = 1.0f / (float)(hi - lo);
    f32x4 acc[4];
#pragma unroll
    for (int d = 0; d < 4; ++d) acc[d] = (f32x4){0.f, 0.f, 0.f, 0.f};
    bf16x8 af[2][4]; f32x4 scl[4];
#pragma unroll
    for (int kk = 0; kk < 2; ++kk)
#pragma unroll
        for (int d = 0; d < 4; ++d) af[kk][d] = *(const bf16x8*)(pwT + GI * 4096 + (16 * d + fr) * 64 + 32 * kk + 8 * fq);
#pragma unroll
    for (int d = 0; d < 4; ++d) scl[d] = *(const f32x4*)(pool_scale + 64 * GI + 16 * d + 4 * fq);
#pragma unroll
    for (int kk = 0; kk < 2; ++kk) {
        const int c = 64 * GI + 32 * kk + 8 * fq;
        float s[8];
#pragma unroll
        for (int j = 0; j < 8; ++j) s[j] = 0.f;
#pragma unroll
        for (int i = 0; i < W; ++i) { const u32x4 v = *(const LAS u32x4*)(P + ((t + 8 - half + i) * PL_PITCH + c) * 2);
#pragma unroll
            for (int q = 0; q < 4; ++q) { s[2 * q] += bflo(v[q]); s[2 * q + 1] += bfhi(v[q]); } }
        const u32x4 sv = *(const LAS u32x4*)(P + ((t + 8) * PL_PITCH + c) * 2);
        u32x4 pw;
#pragma unroll
        for (int q = 0; q < 4; ++q) pw[q] = cvt_pk_bf16(s[2 * q] * inv - bflo(sv[q]), s[2 * q + 1] * inv - bfhi(sv[q]));
        const bf16x8 bfrag = __builtin_bit_cast(bf16x8, pw);
#pragma unroll
        for (int d = 0; d < 4; ++d) acc[d] = __builtin_amdgcn_mfma_f32_16x16x32_bf16(af[kk][d], bfrag, acc[d], 0, 0, 0);
    }
#pragma unroll
    for (int d = 0; d < 4; ++d) { const int dc = 64 * GI + 16 * d + 4 * fq; const f32x4 sc = scl[d];
        u32x2 w; w.x = cvt_pk_bf16(acc[d][0] * sc[0], acc[d][1] * sc[1]); w.y = cvt_pk_bf16(acc[d][2] * sc[2], acc[d][3] * sc[3]);
        *(u32x2*)(BR + (size_t)row * DM + 256 + dc) = w; }
    __builtin_amdgcn_sched_barrier(0);
}
__device__ __forceinline__ void mixer_conv_pool(const bf16_t* Z, bf16_t* BR, const float* conv_w, const bf16_t* pwT, const float* pool_scale, LAS unsigned char* lds, int row0, int wid, int lane) {
    int s0, s1; seq_bounds(row0, s0, s1);
    const int tid = wid * 64 + lane;
    const char* Zb = (const char*)Z;
    {   u32x4 pv[9];
#pragma unroll
        for (int k = 0; k < 9; ++k) { const int it = tid + k * NTHR, r = it >> 5, c8 = (it & 31) * 8; const int grow = row0 - 8 + r, gc = min(max(grow, s0), s1 - 1);
            pv[k] = *(const u32x4*)(Zb + (unsigned)(gc * (DIN * 2) + (768 + c8) * 2)); }
#pragma unroll
        for (int k = 0; k < 9; ++k) { const int it = tid + k * NTHR, r = it >> 5, c8 = (it & 31) * 8; const int grow = row0 - 8 + r; const bool ok = grow >= s0 && grow < s1;
            *(LAS u32x4*)(lds + (r * PL_PITCH + c8) * 2) = ok ? pv[k] : (u32x4){0u, 0u, 0u, 0u}; } }
#pragma unroll 1
    for (int kb = 0; kb < 8; kb += 2) {
        u32x4 bg[2], cg[2][3], xv[2][3];
#pragma unroll
        for (int k = 0; k < 2; ++k) { const int it = tid + (kb + k) * NTHR; const int t = it >> 5, c8 = (it & 31) * 8, row = row0 + t;
            const int rm = max(row - 1, s0), rp = min(row + 1, s1 - 1);
            const unsigned o1 = (unsigned)(row * (DIN * 2) + c8 * 2), o0 = (unsigned)(rm * (DIN * 2) + c8 * 2), o2 = (unsigned)(rp * (DIN * 2) + c8 * 2);
            bg[k] = *(const u32x4*)(Zb + o1);
            cg[k][0] = *(const u32x4*)(Zb + o0 + 512); xv[k][0] = *(const u32x4*)(Zb + o0 + 1024);
            cg[k][1] = *(const u32x4*)(Zb + o1 + 512); xv[k][1] = *(const u32x4*)(Zb + o1 + 1024);
            cg[k][2] = *(const u32x4*)(Zb + o2 + 512); xv[k][2] = *(const u32x4*)(Zb + o2 + 1024); }
#pragma unroll
        for (int k = 0; k < 2; ++k) { const int it = tid + (kb + k) * NTHR; const int t = it >> 5, c8 = (it & 31) * 8, row = row0 + t;
            const float m0 = (row - 1 >= s0) ? 1.f : 0.f, m2 = (row + 1 < s1) ? 1.f : 0.f;
            float cv[8];
#pragma unroll
            for (int j = 0; j < 8; ++j) cv[j] = 0.f;
#pragma unroll
            for (int d = 0; d < 3; ++d) { const float mk = d == 0 ? m0 : (d == 2 ? m2 : 1.f);
                const f32x4 w0 = *(const f32x4*)(conv_w + d * 256 + c8) * mk, w1 = *(const f32x4*)(conv_w + d * 256 + c8 + 4) * mk;
#pragma unroll
                for (int q = 0; q < 4; ++q) { cv[2 * q] += (q < 2 ? w0[2 * q] : w1[2 * q - 4]) * bflo(cg[k][d][q]) * bflo(xv[k][d][q]); cv[2 * q + 1] += (q < 2 ? w0[2 * q + 1] : w1[2 * q - 3]) * bfhi(cg[k][d][q]) * bfhi(xv[k][d][q]); } }
            u32x4 o;
#pragma unroll
            for (int q = 0; q < 4; ++q) o[q] = cvt_pk_bf16(bflo(bg[k][q]) * cv[2 * q], bfhi(bg[k][q]) * cv[2 * q + 1]);
            *(u32x4*)(BR + (size_t)row * DM + c8) = o; }
    }
    __syncthreads();
    const int fr = lane & 15, fq = lane >> 4; const int t = 16 * wid + fr, row = row0 + t;
    pool_group<0>(lds, BR, pwT, pool_scale, t, row, s0, s1, fr, fq);
    pool_group<1>(lds, BR, pwT, pool_scale, t, row, s0, s1, fr, fq);
    pool_group<2>(lds, BR, pwT, pool_scale, t, row, s0, s1, fr, fq);
    pool_group<3>(lds, BR, pwT, pool_scale, t, row, s0, s1, fr, fq);
    __syncthreads();
}

constexpr int VLN_PITCH = 264;
__device__ __forceinline__ void mixer_spatial(const bf16_t* Z, bf16_t* BR, const float* sg_norm, const bf16_t* sgw, const float* sg_b, LAS unsigned char* lds, int row0, int wid, int lane) {
    const f32x4 gn = *(const f32x4*)(sg_norm + 4 * lane);
    u32x2 wv[16];
#pragma unroll
    for (int i = 0; i < 16; ++i) wv[i] = *(const u32x2*)(Z + (size_t)(row0 + 16 * wid + i) * DIN + 1280 + 4 * lane);
#pragma unroll
    for (int i = 0; i < 16; ++i) { const int t = 16 * wid + i; const u32x2 w = wv[i];
        f32x4 v = (f32x4){bflo(w.x), bfhi(w.x), bflo(w.y), bfhi(w.y)};
        const float mean = wave_sum((v[0] + v[1]) + (v[2] + v[3])) * (1.f / 256.f); v = v - mean;
        const float var = wave_sum((v[0] * v[0] + v[1] * v[1]) + (v[2] * v[2] + v[3] * v[3])) * (1.f / 256.f);
        const float rstd = __builtin_amdgcn_rsqf(var + EPS);
        u32x2 o; o.x = cvt_pk_bf16(v[0] * rstd * gn[0], v[1] * rstd * gn[1]); o.y = cvt_pk_bf16(v[2] * rstd * gn[2], v[3] * rstd * gn[3]);
        *(LAS u32x2*)(lds + (t * VLN_PITCH + 4 * lane) * 2) = o; }
    __syncthreads();
    const int fr = lane & 15, fq = lane >> 4, l16 = lane & 15, tq = l16 >> 2, tp = l16 & 3;
    const int t = 16 * wid + fr, row = row0 + t;
#pragma unroll 1
    for (int g = 0; g < 4; ++g) {
        bf16x8 wf[4];
#pragma unroll
        for (int kk = 0; kk < 4; ++kk) wf[kk] = *(const bf16x8*)(sgw + g * 16384 + t * 128 + 32 * kk + 8 * fq);
        const float bias = sg_b[g * 128 + t];
#pragma unroll
        for (int ct = 0; ct < 4; ++ct) { const int c0 = 64 * g + 16 * ct; f32x4 acc = (f32x4){0.f, 0.f, 0.f, 0.f};
#pragma unroll
            for (int kk = 0; kk < 4; ++kk) { const LAS unsigned char* p = lds + ((32 * kk + 8 * fq + tq) * VLN_PITCH + c0 + 4 * tp) * 2;
                const s16x4 lo = tr_read(p), hi = tr_read(p + 4 * VLN_PITCH * 2);
                const bf16x8 af = (bf16x8){lo[0], lo[1], lo[2], lo[3], hi[0], hi[1], hi[2], hi[3]};
                acc = __builtin_amdgcn_mfma_f32_16x16x32_bf16(af, wf[kk], acc, 0, 0, 0); }
            const u32x2 uw = *(const u32x2*)(Z + (size_t)row * DIN + 1024 + c0 + 4 * fq);
            u32x2 o; o.x = cvt_pk_bf16(bflo(uw.x) * (acc[0] + bias), bfhi(uw.x) * (acc[1] + bias)); o.y = cvt_pk_bf16(bflo(uw.y) * (acc[2] + bias), bfhi(uw.y) * (acc[3] + bias));
            *(u32x2*)(BR + (size_t)row * DM + 512 + c0 + 4 * fq) = o; }
    }
    __syncthreads();
}

constexpr int KV_PITCH = 72, KV_ROWS = 448, KV_BYTES = KV_ROWS * KV_PITCH * 2;
__device__ __forceinline__ void mixer_attn(const bf16_t* Z, bf16_t* BR, const float* sink, LAS unsigned char* lds, int row0, int kvh, int wid, int lane) {
    int s0, s1; seq_bounds(row0, s0, s1);
    const int tid = wid * 64 + lane;
    LAS unsigned char* Kl = lds; LAS unsigned char* Vl = lds + KV_BYTES;
    {   u32x4 kv[7], vv[7];
#pragma unroll
        for (int k = 0; k < 7; ++k) { const int it = tid + k * NTHR, r = it >> 3, c8 = (it & 7) * 8; const int grow = row0 - 144 + r, gc = min(max(grow, s0), s1 - 1);
            kv[k] = *(const u32x4*)(Z + (size_t)gc * DIN + 1792 + kvh * 64 + c8); vv[k] = *(const u32x4*)(Z + (size_t)gc * DIN + 1920 + kvh * 64 + c8); }
#pragma unroll
        for (int k = 0; k < 7; ++k) { const int it = tid + k * NTHR, r = it >> 3, c8 = (it & 7) * 8; const int grow = row0 - 144 + r; const bool ok = grow >= s0 && grow < s1;
            const u32x4 z4 = (u32x4){0u, 0u, 0u, 0u};
            *(LAS u32x4*)(Kl + (r * KV_PITCH + c8) * 2) = ok ? kv[k] : z4; *(LAS u32x4*)(Vl + (r * KV_PITCH + c8) * 2) = ok ? vv[k] : z4; } }
    __syncthreads();
    const int fr = lane & 15, fq = lane >> 4, tq = fr >> 2, tp = fr & 3;
    const int qrow = row0 + 16 * wid + fr;
    float frel0 = (float)(fr + 144 - 4 * fq), frlo = (float)max(-128, qrow - s1 + 1), frhi = (float)min(128, qrow - s0);
#pragma unroll 1
    for (int g = 0; g < 2; ++g) {
        asm volatile("" : "+v"(frel0), "+v"(frlo), "+v"(frhi));
        const int hq = kvh * 2 + g;
        const float slope = __builtin_amdgcn_exp2f(-2.0f * (float)(hq + 1)) * LOG2E;
        const float sk = sink[hq] * LOG2E;
        bf16x8 qf[2];
#pragma unroll
        for (int kk = 0; kk < 2; ++kk) qf[kk] = *(const bf16x8*)(Z + (size_t)qrow * DIN + 1536 + hq * 64 + 32 * kk + 8 * fq);
        f32x4 sc[18];
#pragma unroll
        for (int kt = 0; kt < 18; ++kt) { f32x4 acc = (f32x4){0.f, 0.f, 0.f, 0.f};
#pragma unroll
            for (int kk = 0; kk < 2; ++kk) { const bf16x8 kf = *(const LAS bf16x8*)(Kl + ((16 * wid + 16 * kt + fr) * KV_PITCH + 32 * kk + 8 * fq) * 2);
                acc = __builtin_amdgcn_mfma_f32_16x16x32_bf16(kf, qf[kk], acc, 0, 0, 0); }
            sc[kt] = acc; if (kt & 1) __builtin_amdgcn_sched_barrier(0); }
        float mx = sk;
#pragma unroll
        for (int kt = 0; kt < 18; ++kt)
#pragma unroll
            for (int e = 0; e < 4; ++e) { const float t = frel0 - (float)(16 * kt + e);
                float v = __builtin_fmaf(__builtin_fabsf(t), -slope, sc[kt][e] * (0.125f * LOG2E));
                const float df = t - __builtin_amdgcn_fmed3f(t, frlo, frhi);
                v = __builtin_fmaf(__builtin_fabsf(df), -1e30f, v);
                sc[kt][e] = v; mx = fmaxf(mx, v); }
        mx = fmaxf(mx, __shfl_xor(mx, 16)); mx = fmaxf(mx, __shfl_xor(mx, 32));
        float sum = 0.f;
#pragma unroll
        for (int kt = 0; kt < 18; ++kt)
#pragma unroll
            for (int e = 0; e < 4; ++e) { const float p = __builtin_amdgcn_exp2f(sc[kt][e] - mx); sc[kt][e] = p; sum += p; }
        sum += __shfl_xor(sum, 16); sum += __shfl_xor(sum, 32);
        const float rden = __builtin_amdgcn_rcpf(sum + __builtin_amdgcn_exp2f(sk - mx));
        f32x4 o[4];
#pragma unroll
        for (int d = 0; d < 4; ++d) o[d] = (f32x4){0.f, 0.f, 0.f, 0.f};
#pragma unroll
        for (int j = 0; j < 9; ++j) {
            u32x4 pw; pw.x = cvt_pk_bf16(sc[2 * j][0], sc[2 * j][1]); pw.y = cvt_pk_bf16(sc[2 * j][2], sc[2 * j][3]); pw.z = cvt_pk_bf16(sc[2 * j + 1][0], sc[2 * j + 1][1]); pw.w = cvt_pk_bf16(sc[2 * j + 1][2], sc[2 * j + 1][3]);
            const bf16x8 pf = __builtin_bit_cast(bf16x8, pw);
#pragma unroll
            for (int d = 0; d < 4; ++d) { const LAS unsigned char* p = Vl + ((16 * wid + 32 * j + 4 * fq + tq) * KV_PITCH + 16 * d + 4 * tp) * 2;
                const s16x4 lo = tr_read(p), hi = tr_read(p + 16 * KV_PITCH * 2);
                const bf16x8 vf = (bf16x8){lo[0], lo[1], lo[2], lo[3], hi[0], hi[1], hi[2], hi[3]};
                o[d] = __builtin_amdgcn_mfma_f32_16x16x32_bf16(vf, pf, o[d], 0, 0, 0); }
            __builtin_amdgcn_sched_barrier(0);
        }
#pragma unroll
        for (int d = 0; d < 4; ++d) { u32x2 w; w.x = cvt_pk_bf16(o[d][0] * rden, o[d][1] * rden); w.y = cvt_pk_bf16(o[d][2] * rden, o[d][3] * rden);
            *(u32x2*)(BR + (size_t)qrow * DM + 768 + hq * 64 + 16 * d + 4 * fq) = w; }
    }
    __syncthreads();
}

__device__ __forceinline__ void mixer_prefetch(const bf16_t* Z, int part, int row0, int tid, unsigned (&pf)[5]) {
    const char* Zb = (const char*)Z;
#pragma unroll
    for (int k = 0; k < 5; ++k) { int li = tid + k * NTHR; int r, boff;
        if (part == 0) { li = min(li, 2303); r = row0 - 8 + (li >> 4); boff = (li & 15) * 128; }
        else if (part == 1) { li = min(li, 1023); r = row0 + (li >> 3); boff = 2048 + (li & 7) * 128; }
        else { const int kvh = part - 2; li = min(li, 1055);
            if (li < 800) { r = row0 - 144 + (li >> 1); boff = ((li & 1) ? 3840 : 3584) + kvh * 128; }
            else { const int q = li - 800; r = row0 + (q >> 1); boff = 3072 + kvh * 256 + (q & 1) * 128; } }
        r = min(max(r, 0), M_TOK - 1);
        pf[k] = *(const unsigned*)(Zb + (unsigned)(r * (DIN * 2) + boff)); }
}

#define XB_TMO      128
#define XB_XCNT(j)  (256  + 64 * (j))
#define XB_XSUB(j)  (1280 + 64 * (j))
#define XB_XGEN(j)  (2304 + 64 * (j))
#define XB_TOP      3328
#define XB_TOPGEN   3392
#define XCD_BAR_WORDS 3456
#define XB_SPIN_CAP (1u << 18)

__device__ __forceinline__ unsigned xb_ld(unsigned* p)              { return __hip_atomic_load(p, __ATOMIC_RELAXED, __HIP_MEMORY_SCOPE_AGENT); }
__device__ __forceinline__ unsigned xb_add(unsigned* p, unsigned v) { return __hip_atomic_fetch_add(p, v, __ATOMIC_RELAXED, __HIP_MEMORY_SCOPE_AGENT); }
__device__ __forceinline__ unsigned xb_xcc_id() { return (unsigned)__builtin_amdgcn_s_getreg((3 << 11) | 20) & 0xFu; }
#define XB_SPIN(cond, bar) do { unsigned _sp = 0; while (cond) { __builtin_amdgcn_s_sleep(1); \
    if ((++_sp & 255u) == 0u) { if (xb_ld(&(bar)[XB_TMO])) break; if (_sp > XB_SPIN_CAP) { atomicAdd(&(bar)[XB_TMO], 1u); break; } } } } while (0)

struct XcdBarrier {
    unsigned* bar; unsigned x;
    volatile LAS unsigned* st;
};

__device__ __forceinline__ XcdBarrier xcd_barrier_post(unsigned* bar, volatile LAS unsigned* st) {
    XcdBarrier b; b.bar = bar; b.x = xb_xcc_id(); b.st = st;
    if (threadIdx.x == 0) (void)xb_add(&bar[XB_XCNT(b.x)], 1u);
    return b;
}
__device__ __forceinline__ void xcd_barrier_complete(unsigned* bar, unsigned x, unsigned& nloc, unsigned& nx) {
    const unsigned G = gridDim.x * gridDim.y * gridDim.z;
    unsigned sum, cnt, mine, sp = 0u;
    for (;;) {
        sum = 0u; cnt = 0u; mine = 0u;
#pragma unroll
        for (unsigned j = 0; j < 16; ++j) { const unsigned c = xb_ld(&bar[XB_XCNT(j)]); sum += c; cnt += (c > 0u) ? 1u : 0u; mine = (j == x) ? c : mine; }
        if (sum == G) break;
        __builtin_amdgcn_s_sleep(1);
        if ((++sp & 255u) == 0u) { if (xb_ld(&bar[XB_TMO])) break; if (sp > XB_SPIN_CAP) { atomicAdd(&bar[XB_TMO], 1u); break; } }
    }
    nloc = mine > 0u ? mine : 1u; nx = cnt > 0u ? cnt : 1u;
}

__device__ __forceinline__ void xcd_barrier(const XcdBarrier& b) {
    asm volatile("s_waitcnt vmcnt(0)" ::: "memory");
    __syncthreads();
    if (threadIdx.x == 0) {
        unsigned* bar = b.bar;
        __builtin_amdgcn_s_waitcnt(0);
        unsigned nloc = b.st[0], nx = b.st[1];
        if (nloc == 0u) { xcd_barrier_complete(bar, b.x, nloc, nx); b.st[0] = nloc; b.st[1] = nx; }
        const unsigned old = xb_add(&bar[XB_XSUB(b.x)], 1u);
        const unsigned gen = old / nloc;
        if (old + 1u == (gen + 1u) * nloc) {
            __builtin_amdgcn_fence(__ATOMIC_RELEASE, "agent");
            asm volatile("s_waitcnt vmcnt(0)" ::: "memory");
            const unsigned og = xb_add(&bar[XB_TOP], 1u);
            const unsigned tg = og / nx;
            if (og + 1u == (tg + 1u) * nx) xb_add(&bar[XB_TOPGEN], 1u);
            else XB_SPIN(xb_ld(&bar[XB_TOPGEN]) == tg, bar);
            __builtin_amdgcn_fence(__ATOMIC_ACQUIRE, "agent");
            xb_add(&bar[XB_XGEN(b.x)], 1u);
            asm volatile("s_waitcnt vmcnt(0)" ::: "memory");
        } else {
            XB_SPIN(xb_ld(&bar[XB_XGEN(b.x)]) == gen, bar);
            __builtin_amdgcn_fence(__ATOMIC_ACQUIRE, "agent");
            asm volatile("s_waitcnt vmcnt(0)" ::: "memory");
        }
    }
    __syncthreads();
}


constexpr int LDS_BYTES = 131072 + 1024;
constexpr int N_PHASES = 1 + 8 * DEPTH;

__global__ void __launch_bounds__(NTHR) fwd_megakernel(Args a) {
    extern __shared__ __attribute__((aligned(16))) unsigned char lds_raw[];
    LAS unsigned char* lds = (LAS unsigned char*)lds_raw;
    cg::grid_group grid = cg::this_grid();
    const int tid = threadIdx.x, lane = tid & 63, wid = __builtin_amdgcn_readfirstlane(tid >> 6);
    const int G = gridDim.x, bx = blockIdx.x;
    unsigned char* ws = a.ws;
    bf16_t* H = (bf16_t*)(ws + WS_H); bf16_t* Z = (bf16_t*)(ws + WS_Z); bf16_t* BR = (bf16_t*)(ws + WS_BR);
    bf16_t* XB = (bf16_t*)(ws + WS_X); bf16_t* MERGED = (bf16_t*)(ws + WS_MERGED); bf16_t* Y = (bf16_t*)(ws + WS_Y); bf16_t* ACT = (bf16_t*)(ws + WS_ACT);
    const int lo = a.ph_lo, hi = a.ph_hi;
    volatile LAS unsigned* bst = (volatile LAS unsigned*)(lds + 131072);
    if (tid < 2) bst[tid] = 0u;
    __syncthreads();
    XcdBarrier xbar = xcd_barrier_post((unsigned*)(ws + WS_CTL), bst);
#define IN(k) (lo <= (k) && (k) < hi)
#define SEAM(k) do { if (a.coop && IN((k) + 1)) { if (a.coop == 2) grid.sync(); else xcd_barrier(xbar); } } while (0)

    if (lo == 99) {
        const bf16_t* src = (const bf16_t*)(ws + (size_t)a.pad * MiB);
        for (size_t i = (size_t)bx * NTHR + tid; i < (size_t)M_TOK * DM; i += (size_t)G * NTHR) a.out[i] = __uint_as_float((unsigned)src[i] << 16);
        return;
    }
    if (IN(0)) { phase_prologue(a, lds, wid, lane); SEAM(0); }

#pragma unroll 1
    for (int l = 0; l < DEPTH; ++l) {
        const int p0 = 1 + 8 * l;
        int tl = threadIdx.x; asm volatile("" : "+v"(tl)); const int lane = tl & 63, wid = __builtin_amdgcn_readfirstlane(tl >> 6);
        const unsigned char* wl = ws + WS_W + (size_t)l * W_LAYER;
        const bf16_t* Win = (const bf16_t*)(wl + W_IN); const bf16_t* Wg = (const bf16_t*)(wl + W_G); const bf16_t* Wb = (const bf16_t*)(wl + W_B);
        const bf16_t* Wout = (const bf16_t*)(wl + W_OUT); const bf16_t* Wfi = (const bf16_t*)(wl + W_FI); const bf16_t* Wfo = (const bf16_t*)(wl + W_FO);
        const bf16_t* sgw = (const bf16_t*)(wl + W_SG); const bf16_t* pwT = (const bf16_t*)(wl + W_PW);

        if (IN(p0 + 0)) {
            gm::SchedPlain S{H, Win, DM, M_TOK / 256, DIN / 256, DM / 64, G, bx}; gm::EpiStoreBf16 E{Z, DIN};
            gm::gemm_phase<true>(lds, DM, S, E);
            SEAM(p0 + 0);
        }
        if (IN(p0 + 1)) {
            for (int rep = 0; rep < PROBE_MIX_REPS; ++rep)
            for (int u = bx; u < 4 * 384; u += G) { const int part = u / 384, chunk = u % 384, row0 = chunk * 128;
                int tu = threadIdx.x; asm volatile("" : "+v"(tu)); const int lane = tu & 63, wid = __builtin_amdgcn_readfirstlane(tu >> 6);
                unsigned pf[5] = {0u, 0u, 0u, 0u, 0u};
                if (u + G < 4 * 384) mixer_prefetch(Z, (u + G) / 384, ((u + G) % 384) * 128, tu, pf);
                if (part == 0) mixer_conv_pool(Z, BR, a.conv_w + l * 768, pwT, a.pool_scale + l * 256, lds, row0, wid, lane);
                else if (part == 1) mixer_spatial(Z, BR, a.sg_norm + l * 256, sgw, a.sg_b + l * 512, lds, row0, wid, lane);
                else mixer_attn(Z, BR, a.attn_sink + l * 4, lds, row0, part - 2, wid, lane);
                asm volatile("" :: "v"(pf[0]), "v"(pf[1]), "v"(pf[2]), "v"(pf[3]), "v"(pf[4]));
            }
            SEAM(p0 + 1);
        }
        if (IN(p0 + 2)) {
            gm::SchedGate S{H, BR, Wg, Wb, M_TOK / 256, DM / 256, G, bx};
            unsigned char* scr = ws + WS_SCR + (size_t)bx * SCR_PER_CU;
            gm::EpiGate E{a.b_gate + l * 4 * DM, MERGED, (GAS unsigned char*)scr, (GAS unsigned char*)(scr + 128 * 1024)};
            for (int rep = 0; rep < PROBE_G2_REPS; ++rep) gm::gemm_phase<true>(lds, DM, S, E);
            SEAM(p0 + 2);
        }
        if (IN(p0 + 3)) {
            gm::SchedPlain S{MERGED, Wout, DM, M_TOK / 256, DM / 256, DM / 64, G, bx}; gm::EpiStoreBf16 E{Y, DM};
            gm::gemm_phase<true>(lds, DM, S, E);
            SEAM(p0 + 3);
        }
        if (IN(p0 + 4)) { phase_resnorm(a, Y, a.norm_mix_post + l * DM, a.norm_ffn_pre + l * DM, l == 0, false, XB, H, wid, lane); SEAM(p0 + 4); }
        if (IN(p0 + 5)) {
            gm::SchedPlain S{H, Wfi, DM, M_TOK / 256, NFI / 256, DM / 64, G, bx}; gm::EpiSwiGLU E{ACT};
            for (int rep = 0; rep < PROBE_G4_REPS; ++rep) gm::gemm_phase<true>(lds, DM, S, E);
            SEAM(p0 + 5);
        }
        if (IN(p0 + 6)) {
            gm::SchedPlain S{ACT, Wfo, DFF, M_TOK / 256, DM / 256, DFF / 64, G, bx}; gm::EpiStoreBf16 E{H, DM};
            gm::gemm_phase<true>(lds, DFF, S, E);
            SEAM(p0 + 6);
        }
        if (IN(p0 + 7)) { phase_resnorm(a, H, a.norm_ffn_post + l * DM, (l + 1 < DEPTH) ? a.norm_mix_pre + (l + 1) * DM : nullptr, false, l + 1 == DEPTH, XB, H, wid, lane); SEAM(p0 + 7); }
    }
#undef IN
#undef SEAM
}

extern "C" void kernel_launch(void* const* d_in, const int* in_sizes, int n_in, void* d_out, int out_size, void* d_ws, size_t ws_size, hipStream_t stream) {
    static int grid = 0;
    if (grid == 0) {
        if (n_in != 20 || out_size != M_TOK * DM || ws_size < WS_END) { fprintf(stderr, "kernel_launch: unexpected shapes (n_in %d out %d ws %zu)\n", n_in, out_size, ws_size); grid = -1; return; }
        int dev = 0, cus = 0, per_cu = 0;
        hipGetDevice(&dev); hipDeviceGetAttribute(&cus, hipDeviceAttributeMultiprocessorCount, dev);
        if (hipFuncSetAttribute((const void*)fwd_megakernel, hipFuncAttributeMaxDynamicSharedMemorySize, LDS_BYTES) != hipSuccess) { fprintf(stderr, "kernel_launch: hipFuncSetAttribute failed\n"); grid = -1; return; }
        if (hipOccupancyMaxActiveBlocksPerMultiprocessor(&per_cu, (const void*)fwd_megakernel, NTHR, LDS_BYTES) != hipSuccess || per_cu < 1) { fprintf(stderr, "kernel_launch: occupancy query says %d\n", per_cu); per_cu = 1; }
        (void)hipGetLastError();
        grid = cus * 1;
    }
    if (grid < 0) return;
    if (hipMemsetAsync((char*)d_ws + WS_CTL, 0, 16384, stream) != hipSuccess) { fprintf(stderr, "kernel_launch: memset of barrier words failed\n"); return; }
    Args a{};
    const float** fp = (const float**)&a;
    for (int i = 0; i < 20; ++i) fp[i] = (const float*)d_in[i];
    a.out = (float*)d_out; a.ws = (unsigned char*)d_ws; a.pad = 0;
#if MK_LAUNCH_PER_PHASE
#ifdef DUMP_AFTER
    for (int p = 0; p <= DUMP_AFTER; ++p) { a.ph_lo = p; a.ph_hi = p + 1; a.coop = 0;
        hipLaunchKernelGGL(fwd_megakernel, dim3(grid), dim3(NTHR), LDS_BYTES, stream, a); }
    a.ph_lo = 99; a.ph_hi = 100; a.pad = DUMP_MIB;
    hipLaunchKernelGGL(fwd_megakernel, dim3(grid), dim3(NTHR), LDS_BYTES, stream, a);
#else
    for (int p = 0; p < N_PHASES; ++p) { a.ph_lo = p; a.ph_hi = p + 1; a.coop = 0;
        hipLaunchKernelGGL(fwd_megakernel, dim3(grid), dim3(NTHR), LDS_BYTES, stream, a); }
#endif
#else
    a.ph_lo = 0; a.ph_hi = N_PHASES; a.coop = 1;
    void* args[] = {&a};
    hipError_t e = hipLaunchCooperativeKernel((const void*)fwd_megakernel, dim3(grid), dim3(NTHR), args, LDS_BYTES, stream);
    if (e != hipSuccess) fprintf(stderr, "cooperative launch failed: %s (grid %d)\n", hipGetErrorString(e), grid);
#endif
}
```
